# Optimizing an MI355X kernel written in HIP

```python
import jax, jax.numpy as jnp
from jax import lax
import numpy as np

D_MODEL = 1024
BATCH = 8
SEQ = 2048
DEPTH = 2
DEC_BATCH = 32
DEC_SEQ = 4
PAST_LEN = 16384
PAGE_SIZE = 128

N_EVEN = (DEPTH + 1) // 2
N_ODD = DEPTH // 2
EPS = 1e-6
A_CH = 256
A_CONV = 31
B_HEAD_DIM = 64
B_HPG = 4
B_WINDOWS = (128, 512, 2048)
B_DILATIONS = (1, 4, 16)
B_GROUPS = 3
B_HEADS = B_GROUPS * B_HPG
B_SUB_WINDOW = 128
B_BLOCK = 128
N_BUCKETS = 32
MAX_DISTANCE = 2048
C_CH = 512
C_CONV = 3
D_CH = 512
D_GROUPS = 4
D_GROUP_CH = D_CH // D_GROUPS
D_CHUNK = 128
FFN_HIDDEN = -(-8 * D_MODEL // (3 * 256)) * 256
E_IN = 2 * A_CH + 3 * B_HEADS * B_HEAD_DIM
E_OUT_IN = A_CH + B_HPG * B_HEAD_DIM
O_IN = 3 * C_CH + 2 * D_CH
O_OUT_IN = C_CH + D_CH

kernel_name = "hybrid_confconv_dilattn_shortconv_gmlp_step"


def _rmsnorm(x, g):
    xf = x.astype(jnp.float32)
    y = xf * lax.rsqrt(jnp.mean(xf * xf, axis=-1, keepdims=True) + EPS)
    return (y * g.astype(jnp.float32)).astype(x.dtype)


def _layernorm(x, g, b):
    xf = x.astype(jnp.float32)
    mu = jnp.mean(xf, axis=-1, keepdims=True)
    var = jnp.mean(jnp.square(xf - mu), axis=-1, keepdims=True)
    y = (xf - mu) * lax.rsqrt(var + EPS)
    return (y * g.astype(jnp.float32) + b.astype(jnp.float32)).astype(x.dtype)


def _t5_bucket(dist):
    n = np.maximum(np.asarray(dist, dtype=np.int64), 0)
    max_exact = N_BUCKETS // 2
    large = max_exact + (np.log(np.maximum(n, 1) / max_exact) / np.log(MAX_DISTANCE / max_exact)
                         * (N_BUCKETS - max_exact)).astype(np.int32)
    return np.where(n < max_exact, n, np.minimum(large, N_BUCKETS - 1)).astype(np.int32)


def _group_bias(rel_bias_table, grp, dist):
    tab = rel_bias_table[:, grp * B_HPG:(grp + 1) * B_HPG]
    return jnp.moveaxis(tab[_t5_bucket(dist)], -1, 0).astype(jnp.float32)


def _causal_dwconv(x_ext, w, b):
    y = lax.conv_general_dilated(x_ext, w[:, None, :], window_strides=(1,), padding='VALID',
                                 dimension_numbers=('NWC', 'WIO', 'NWC'),
                                 feature_group_count=w.shape[1])
    return y + b


def _dilated_attn_prompt(q, k, v, d, rel_bias_table, grp):
    N, T, H, Dh = q.shape
    L = T // d
    nb = -(-L // B_BLOCK)
    Lp = nb * B_BLOCK

    def to_sub(x):
        x = x.reshape(N, L, d, H, Dh).transpose(0, 2, 1, 3, 4).reshape(N * d, L, H, Dh)
        x = jnp.pad(x, ((0, 0), (0, Lp - L), (0, 0), (0, 0)))
        return x.reshape(N * d, nb, B_BLOCK, H, Dh)

    def with_prev(xb):
        prev = jnp.pad(xb, ((0, 0), (1, 0), (0, 0), (0, 0), (0, 0)))[:, :-1]
        return jnp.concatenate([prev, xb], axis=2)

    qb = to_sub(q)
    kk = with_prev(to_sub(k))
    vv = with_prev(to_sub(v))
    qi = np.arange(B_BLOCK)[:, None]
    ki = np.arange(2 * B_BLOCK)[None, :]
    rel = qi + B_BLOCK - ki
    band = (rel >= 0) & (rel <= B_SUB_WINDOW)
    key_ok = (np.arange(nb)[:, None, None] > 0) | (ki >= B_BLOCK)[None]
    mask = band[None] & key_ok
    bias = _group_bias(rel_bias_table, grp, np.clip(rel, 0, None) * d)
    s = jnp.einsum('znqhd,znkhd->znhqk', qb, kk).astype(jnp.float32) * (Dh ** -0.5) + bias[None, None]
    s = jnp.where(mask[None, :, None], s, -jnp.inf)
    lse = jax.nn.logsumexp(s, axis=-1)
    p = jnp.exp(s - lse[..., None])
    o = jnp.einsum('znhqk,znkhd->znqhd', p.astype(v.dtype), vv)
    o = o.reshape(N * d, Lp, H, Dh)[:, :L].reshape(N, d, L, H, Dh).transpose(0, 2, 1, 3, 4).reshape(N, T, H, Dh)
    lse = lse.transpose(0, 1, 3, 2).reshape(N * d, Lp, H)[:, :L]
    lse = lse.reshape(N, d, L, H).transpose(0, 2, 1, 3).reshape(N, T, H)
    return o, lse


def _dilated_attn_sample(q, k_ext, v_ext, d, rel_bias_table, grp):
    N, S, H, Dh = q.shape
    Wb = k_ext.shape[1] - S
    steps = np.arange(B_SUB_WINDOW + 1)
    idx = Wb + np.arange(S)[:, None] - steps[None, :] * d
    valid = idx >= 0
    idx_c = np.maximum(idx, 0)
    kg = k_ext[:, idx_c]
    vg = v_ext[:, idx_c]
    bias = _group_bias(rel_bias_table, grp, steps * d)
    s = jnp.einsum('nshd,nskhd->nhsk', q, kg).astype(jnp.float32) * (Dh ** -0.5) + bias[None, :, None, :]
    s = jnp.where(valid[None, None], s, -jnp.inf)
    lse = jax.nn.logsumexp(s, axis=-1)
    p = jnp.exp(s - lse[..., None])
    o = jnp.einsum('nhsk,nskhd->nshd', p.astype(v_ext.dtype), vg)
    return o, lse.transpose(0, 2, 1)


def _even_mixer(h, P, e, a_buf, kv_bufs):
    N, T, _ = h.shape
    proj = h @ P['e_w_in'][e]
    a_in = proj[..., :2 * A_CH]
    qkv = proj[..., 2 * A_CH:].reshape(N, T, 3, B_GROUPS, B_HPG, B_HEAD_DIM)
    glu = a_in[..., :A_CH] * jax.nn.sigmoid(a_in[..., A_CH:])
    if a_buf is None:
        a_ext = jnp.pad(glu, ((0, 0), (A_CONV - 1, 0), (0, 0)))
    else:
        a_ext = jnp.concatenate([a_buf.astype(glu.dtype), glu], axis=1)
    a_state = a_ext[:, -(A_CONV - 1):]
    a = _causal_dwconv(a_ext, P['a_conv_w'][e], P['a_conv_b'][e])
    a = jax.nn.silu(_layernorm(a, P['a_ln_g'][e], P['a_ln_b'][e]))
    outs, lses, kv_states = [], [], []
    for grp in range(B_GROUPS):
        q, k, v = qkv[:, :, 0, grp], qkv[:, :, 1, grp], qkv[:, :, 2, grp]
        d = B_DILATIONS[grp]
        if kv_bufs is None:
            o, lse = _dilated_attn_prompt(q, k, v, d, P['rel_bias_table'], grp)
            kv_states.append(jnp.stack([k, v], axis=2)[:, -min(B_WINDOWS[grp], T):])
        else:
            kv_ext = jnp.concatenate([kv_bufs[grp].astype(q.dtype), jnp.stack([k, v], axis=2)], axis=1)
            o, lse = _dilated_attn_sample(q, kv_ext[:, :, 0], kv_ext[:, :, 1], d, P['rel_bias_table'], grp)
            kv_states.append(kv_ext[:, T:])
        outs.append(o)
        lses.append(lse)
    alpha = jax.nn.softmax(jnp.stack(lses, axis=0), axis=0)
    attn = jnp.sum(alpha[..., None] * jnp.stack(outs, axis=0).astype(jnp.float32), axis=0)
    attn = attn.astype(h.dtype).reshape(N, T, B_HPG * B_HEAD_DIM)
    out = jnp.concatenate([a, attn], axis=-1) @ P['e_w_out'][e]
    return out, a_state, kv_states


def _odd_mixer(h, P, oi, c_buf):
    N, T, _ = h.shape
    proj = h @ P['o_w_in'][oi]
    bg = proj[..., :C_CH]
    cg = proj[..., C_CH:2 * C_CH]
    xi = proj[..., 2 * C_CH:3 * C_CH]
    uv = jax.nn.gelu(proj[..., 3 * C_CH:])
    ci = cg * xi
    if c_buf is None:
        c_ext = jnp.pad(ci, ((0, 0), (C_CONV - 1, 0), (0, 0)))
    else:
        c_ext = jnp.concatenate([c_buf.astype(ci.dtype), ci], axis=1)
    c_state = c_ext[:, -(C_CONV - 1):]
    yc = bg * _causal_dwconv(c_ext, P['c_conv_w'][oi], P['c_conv_b'][oi])
    u = uv[..., :D_CH]
    v = _layernorm(uv[..., D_CH:], P['d_ln_g'][oi], P['d_ln_b'][oi])
    ws = jnp.where(np.tril(np.ones((D_CHUNK, D_CHUNK), dtype=bool))[None], P['d_spatial_w'][oi], 0)
    bs = P['d_spatial_b'][oi]
    if c_buf is None:
        vb = v.reshape(N, T // D_CHUNK, D_CHUNK, D_GROUPS, D_GROUP_CH)
        mix = jnp.einsum('gij,nkjgc->nkigc', ws, vb) + bs.T[None, None, :, :, None]
    else:
        vb = v.reshape(N, T, D_GROUPS, D_GROUP_CH)
        mix = jnp.einsum('gij,njgc->nigc', ws[:, :T, :T], vb) + bs.T[None, :T, :, None]
    yd = u * mix.reshape(N, T, D_CH)
    out = jnp.concatenate([yc, yd], axis=-1) @ P['o_w_out'][oi]
    return out, c_state, v


def _trunk(x, c, P, a_bufs, kv_bufs, c_bufs):
    N = x.shape[0]
    a_st, kv_st, c_st, d_st = [], [[] for _ in range(B_GROUPS)], [], []
    cs = jax.nn.silu(c)
    for layer in range(DEPTH):
        mod = (cs @ P['ada_w'][layer] + P['ada_b'][layer]).reshape(N, 6, 1, D_MODEL)
        h = _rmsnorm(x, P['norm_mix_g'][layer]) * (1 + mod[:, 1]) + mod[:, 0]
        if layer % 2 == 0:
            e = layer // 2
            mix, a_new, kv_new = _even_mixer(h, P, e, None if a_bufs is None else a_bufs[e],
                                             None if kv_bufs is None else [buf[e] for buf in kv_bufs])
            a_st.append(a_new)
            for grp in range(B_GROUPS):
                kv_st[grp].append(kv_new[grp])
        else:
            oi = layer // 2
            mix, c_new, v_new = _odd_mixer(h, P, oi, None if c_bufs is None else c_bufs[oi])
            c_st.append(c_new)
            d_st.append(v_new)
        x = x + mod[:, 2] * mix
        h = _rmsnorm(x, P['norm_ffn_g'][layer]) * (1 + mod[:, 4]) + mod[:, 3]
        gu = h @ P['ffn_w_gate_up'][layer]
        x = x + mod[:, 5] * ((jax.nn.silu(gu[..., :FFN_HIDDEN]) * gu[..., FFN_HIDDEN:]) @ P['ffn_w_down'][layer])
    y = _rmsnorm(x, P['final_norm_g'])
    return y, jnp.stack(a_st), [jnp.stack(s) for s in kv_st], jnp.stack(c_st), d_st


def setup_inputs(seed: int = 0) -> dict:
    key = jax.random.key(seed)
    ks = jax.random.split(key, 40)
    nrm = jax.random.normal
    f32 = jnp.float32
    out = {}
    out['x_prompt'] = nrm(ks[0], (BATCH, SEQ, D_MODEL), f32)
    out['x_sample'] = nrm(ks[1], (DEC_BATCH, DEC_SEQ, D_MODEL), f32)
    out['c_prompt'] = nrm(ks[2], (BATCH, D_MODEL), f32)
    out['c_sample'] = nrm(ks[3], (DEC_BATCH, D_MODEL), f32)
    out['state_a_conv'] = 0.5 * nrm(ks[4], (N_EVEN, DEC_BATCH, A_CONV - 1, A_CH), f32)
    for grp in range(B_GROUPS):
        wb = min(B_WINDOWS[grp], PAST_LEN)
        out['cache_b_kv%d' % grp] = nrm(ks[5 + grp], (N_EVEN, DEC_BATCH, wb, 2, B_HPG, B_HEAD_DIM), f32)
    out['state_c_conv'] = 0.5 * nrm(ks[8], (N_ODD, DEC_BATCH, C_CONV - 1, C_CH), f32)
    out['rel_bias_table'] = 0.3 * nrm(ks[9], (N_BUCKETS, B_HEADS), f32)
    out['ada_w'] = 0.5 * D_MODEL ** -0.5 * nrm(ks[10], (DEPTH, D_MODEL, 6 * D_MODEL), f32)
    out['ada_b'] = 0.02 * nrm(ks[11], (DEPTH, 6 * D_MODEL), f32)
    out['norm_mix_g'] = 1.0 + 0.1 * nrm(ks[12], (DEPTH, D_MODEL), f32)
    out['norm_ffn_g'] = 1.0 + 0.1 * nrm(ks[13], (DEPTH, D_MODEL), f32)
    out['ffn_w_gate_up'] = D_MODEL ** -0.5 * nrm(ks[14], (DEPTH, D_MODEL, 2 * FFN_HIDDEN), f32)
    out['ffn_w_down'] = FFN_HIDDEN ** -0.5 * nrm(ks[15], (DEPTH, FFN_HIDDEN, D_MODEL), f32)
    out['final_norm_g'] = 1.0 + 0.1 * nrm(ks[16], (D_MODEL,), f32)
    out['e_w_in'] = D_MODEL ** -0.5 * nrm(ks[17], (N_EVEN, D_MODEL, E_IN), f32)
    out['a_conv_w'] = A_CONV ** -0.5 * nrm(ks[18], (N_EVEN, A_CONV, A_CH), f32)
    out['a_conv_b'] = 0.02 * nrm(ks[19], (N_EVEN, A_CH), f32)
    out['a_ln_g'] = 1.0 + 0.1 * nrm(ks[20], (N_EVEN, A_CH), f32)
    out['a_ln_b'] = 0.02 * nrm(ks[21], (N_EVEN, A_CH), f32)
    out['e_w_out'] = E_OUT_IN ** -0.5 * nrm(ks[22], (N_EVEN, E_OUT_IN, D_MODEL), f32)
    out['o_w_in'] = D_MODEL ** -0.5 * nrm(ks[23], (N_ODD, D_MODEL, O_IN), f32)
    out['c_conv_w'] = C_CONV ** -0.5 * nrm(ks[24], (N_ODD, C_CONV, C_CH), f32)
    out['c_conv_b'] = 0.02 * nrm(ks[25], (N_ODD, C_CH), f32)
    out['d_ln_g'] = 1.0 + 0.1 * nrm(ks[26], (N_ODD, D_CH), f32)
    out['d_ln_b'] = 0.02 * nrm(ks[27], (N_ODD, D_CH), f32)
    out['d_spatial_w'] = D_CHUNK ** -0.5 * nrm(ks[28], (N_ODD, D_GROUPS, D_CHUNK, D_CHUNK), f32)
    out['d_spatial_b'] = 1.0 + 0.1 * nrm(ks[29], (N_ODD, D_GROUPS, D_CHUNK), f32)
    out['o_w_out'] = O_OUT_IN ** -0.5 * nrm(ks[30], (N_ODD, O_OUT_IN, D_MODEL), f32)
    return out


def reference(x_prompt, x_sample, c_prompt, c_sample, state_a_conv, cache_b_kv0, cache_b_kv1, cache_b_kv2,
              state_c_conv, rel_bias_table, ada_w, ada_b, norm_mix_g, norm_ffn_g, ffn_w_gate_up, ffn_w_down,
              final_norm_g, e_w_in, a_conv_w, a_conv_b, a_ln_g, a_ln_b, e_w_out, o_w_in, c_conv_w, c_conv_b,
              d_ln_g, d_ln_b, d_spatial_w, d_spatial_b, o_w_out):
    P = {'rel_bias_table': rel_bias_table, 'ada_w': ada_w, 'ada_b': ada_b, 'norm_mix_g': norm_mix_g,
         'norm_ffn_g': norm_ffn_g, 'ffn_w_gate_up': ffn_w_gate_up, 'ffn_w_down': ffn_w_down,
         'final_norm_g': final_norm_g, 'e_w_in': e_w_in, 'a_conv_w': a_conv_w, 'a_conv_b': a_conv_b,
         'a_ln_g': a_ln_g, 'a_ln_b': a_ln_b, 'e_w_out': e_w_out, 'o_w_in': o_w_in, 'c_conv_w': c_conv_w,
         'c_conv_b': c_conv_b, 'd_ln_g': d_ln_g, 'd_ln_b': d_ln_b, 'd_spatial_w': d_spatial_w,
         'd_spatial_b': d_spatial_b, 'o_w_out': o_w_out}
    y_prompt, a_p, kv_p, c_p, _ = _trunk(x_prompt, c_prompt, P, None, None, None)
    y_sample, a_s, kv_s, c_s, d_s = _trunk(x_sample, c_sample, P, state_a_conv,
                                           [cache_b_kv0, cache_b_kv1, cache_b_kv2], state_c_conv)
    return (y_prompt, y_sample, a_p, a_s, kv_p[0], kv_s[0], kv_p[1], kv_s[1], kv_p[2], kv_s[2],
            c_p, c_s, jnp.stack(d_s))
```

```cpp
#define MK_MULTI 0
#include <hip/hip_runtime.h>
#include <hip/hip_cooperative_groups.h>
#include <cstdio>
#include <cstdint>
namespace cg = cooperative_groups;

constexpr int D = 1024, BATCH = 8, SEQ = 2048, DEC_BATCH = 32, DEC_SEQ = 4, NB = BATCH + DEC_BATCH;
constexpr int TP = BATCH * SEQ;
constexpr int TS = DEC_BATCH * DEC_SEQ;
constexpr int MR = TP + TS;
constexpr int MP = 16640;
constexpr int E_IN = 2816, O_IN = 2560, FFN = 2816, MODW = 6 * D;
constexpr float EPS = 1e-6f;
namespace pg8 {
#define PG8_LAS __attribute__((address_space(3)))
typedef unsigned short bf16_t;
typedef short bf16x8 __attribute__((ext_vector_type(8)));
typedef float f32x4 __attribute__((ext_vector_type(4)));
typedef unsigned u32x4 __attribute__((ext_vector_type(4)));
constexpr int BM = 256, BK = 64, HALF = 128, HTB = HALF * BK * 2  , STAGE_BYTES = 8 * HTB, NXCD = 8, WGM = 8;

__host__ __device__ __forceinline__ int lds_byte(int r, int c) { const int st = (r >> 4) * 2 + (c >> 5), rr = r & 15, cc = c & 31, ob = rr * 64 + cc * 2; return st * 1024 + (ob ^ (((ob >> 9) & 1) << 5)); }
__host__ __device__ __forceinline__ void stage_rc(int b, int& R, int& C) { const int st = b / 1024, sb = b % 1024, swz = sb ^ (((sb >> 9) & 1) << 5); R = (st >> 1) * 16 + swz / 64; C = (st & 1) * 32 + (swz % 64) / 2; }
__host__ __device__ __forceinline__ int perm32(int rho) { const int n = rho >> 4, i = rho & 15; return 8 * (i >> 2) + 4 * n + (i & 3); }

struct Unit { int pm, pn; };
struct Gemm { const bf16_t* A; const bf16_t* Bt; int M, N, K; };

struct StaticOrder {
    int nM, nN, nwg, G, c;
    __host__ __device__ void init(int M, int N, int G_, int c_) { nM = M / BM; nN = N / BM; nwg = nM * nN; G = G_; c = c_; }
    __host__ __device__ bool next(int i, Unit& u) const {
        const long L = (long)i * G + c; if (L >= nwg) return false;
        int wgid = (int)L; { const int q = nwg / NXCD, r = nwg % NXCD, xcd = wgid % NXCD, off = wgid / NXCD; wgid = (xcd < r ? xcd * (q + 1) : r * (q + 1) + (xcd - r) * q) + off; }
        const int nig = WGM * nN, gid = wgid / nig, fm = gid * WGM, gsz = (nM - fm) < WGM ? (nM - fm) : WGM;
        u.pm = fm + ((wgid % nig) % gsz); u.pn = (wgid % nig) / gsz; return true;
    }
    __device__ __forceinline__ void a_ready(const Unit&) const {}
    __device__ __forceinline__ void done(const Unit&) const {}
};

__device__ __forceinline__ unsigned cvt_pk_bf16(float lo, float hi) { unsigned r; asm volatile("v_cvt_pk_bf16_f32 %0, %1, %2" : "=v"(r) : "v"(lo), "v"(hi)); return r; }
typedef float f32x2 __attribute__((ext_vector_type(2)));
__device__ __forceinline__ f32x2 gelu_pk(f32x2 v) {
    const f32x2 av = __builtin_elementwise_abs(v), d = av * 0.2316418882f + 1.0f;
    f32x2 t; t.x = __builtin_amdgcn_rcpf(d.x); t.y = __builtin_amdgcn_rcpf(d.y);
    f32x2 q = t * 0.5307027145f + (-0.7265760135f); q = q * t + 0.7107068705f; q = q * t + (-0.142248368f); q = q * t + 0.127414796f; q = q * t;
    const f32x2 s = (v * v) * (-0.72134752044f);
    f32x2 e; e.x = __builtin_amdgcn_exp2f(s.x); e.y = __builtin_amdgcn_exp2f(s.y);
    const f32x2 m = v * (q * e), r = v - m;
    f32x2 o; o.x = v.x < 0.f ? m.x : r.x; o.y = v.y < 0.f ? m.y : r.y; return o;
}

template <int ACT  > struct EpiBf16 {
    static constexpr bool PERM = true, AFTER_DRAIN = false; static_assert(ACT == 0 || ACT == 1, "EpiBf16: ACT is 0 (none) or 1 (gelu_pk)");
    bf16_t* O; int ldc; const float* bias; int split_cols; size_t split_stride; float scale0;
    __device__ __forceinline__ void operator()(const f32x4 (&acc)[2][2][4][2], const Unit& u, int wr, int wc, int fr, int fq) const {
        const int row0 = u.pm * BM + wr * 64 + fr; int colt = u.pn * BM; bf16_t* base = O;
        float sc = 1.f; if (split_cols) { const int t = colt / split_cols; base += (size_t)t * split_stride; colt -= t * split_cols; if (t == 0) sc = scale0; }
        const int col0 = colt + wc * 32 + 8 * fq, bcol0 = u.pn * BM + wc * 32 + 8 * fq;
        f32x4 bv[2][2];
#pragma unroll
        for (int bj = 0; bj < 2; ++bj)
#pragma unroll
            for (int n = 0; n < 2; ++n) bv[bj][n] = bias ? *(const f32x4*)(bias + bcol0 + bj * HALF + 4 * n) : (f32x4){0.f, 0.f, 0.f, 0.f};
#pragma unroll
        for (int ai = 0; ai < 2; ++ai)
#pragma unroll
            for (int m = 0; m < 4; ++m) { bf16_t* rowp = base + (size_t)(row0 + ai * HALF + m * 16) * ldc + col0;
#pragma unroll
                for (int bj = 0; bj < 2; ++bj) { f32x4 v0 = acc[ai][bj][m][0] + bv[bj][0], v1 = acc[ai][bj][m][1] + bv[bj][1];
                    if (ACT == 1) { f32x2 a = gelu_pk((f32x2){v0[0], v0[1]}), b = gelu_pk((f32x2){v0[2], v0[3]}), c = gelu_pk((f32x2){v1[0], v1[1]}), d = gelu_pk((f32x2){v1[2], v1[3]});
                        v0 = (f32x4){a.x, a.y, b.x, b.y}; v1 = (f32x4){c.x, c.y, d.x, d.y}; }
                    v0 = v0 * sc; v1 = v1 * sc; u32x4 w; w.x = cvt_pk_bf16(v0[0], v0[1]); w.y = cvt_pk_bf16(v0[2], v0[3]); w.z = cvt_pk_bf16(v1[0], v1[1]); w.w = cvt_pk_bf16(v1[2], v1[3]);
                    *(u32x4*)(rowp + bj * HALF) = w; } }
    }
};

__device__ __forceinline__ float gelu_tanh_f(float x) {
    const float y = 1.5957691216057308f * (x + 0.044715f * x * x * x);
    return x * __builtin_amdgcn_rcpf(1.0f + __builtin_amdgcn_exp2f(-1.4426950408889634f * y));
}
__device__ __forceinline__ float silu_f(float x) { return x * __builtin_amdgcn_rcpf(1.0f + __builtin_amdgcn_exp2f(-1.4426950408889634f * x)); }

struct EpiStoreBf16 {
    static constexpr bool PERM = true, AFTER_DRAIN = false;
    bf16_t* O; int ldc; int gelu_from;
    __device__ __forceinline__ void operator()(const f32x4 (&acc)[2][2][4][2], const Unit& u, int wr, int wc, int fr, int fq) const {
        const int row0 = u.pm * BM + wr * 64 + fr, col0 = u.pn * BM + wc * 32 + 8 * fq;
        const bool g = u.pn >= gelu_from;
#pragma unroll
        for (int ai = 0; ai < 2; ++ai)
#pragma unroll
            for (int m = 0; m < 4; ++m) { bf16_t* rowp = O + (size_t)(row0 + ai * HALF + m * 16) * ldc + col0;
#pragma unroll
                for (int bj = 0; bj < 2; ++bj) { f32x4 v0 = acc[ai][bj][m][0], v1 = acc[ai][bj][m][1];
                    if (g) {
#pragma unroll
                        for (int j = 0; j < 4; ++j) { v0[j] = gelu_tanh_f(v0[j]); v1[j] = gelu_tanh_f(v1[j]); } }
                    u32x4 w; w.x = cvt_pk_bf16(v0[0], v0[1]); w.y = cvt_pk_bf16(v0[2], v0[3]); w.z = cvt_pk_bf16(v1[0], v1[1]); w.w = cvt_pk_bf16(v1[2], v1[3]);
                    *(u32x4*)(rowp + bj * HALF) = w; } }
    }
};
struct EpiSwiGLU {
    static constexpr bool PERM = true, AFTER_DRAIN = false;
    bf16_t* O; int ldc;
    __device__ __forceinline__ void operator()(const f32x4 (&acc)[2][2][4][2], const Unit& u, int wr, int wc, int fr, int fq) const {
        const int row0 = u.pm * BM + wr * 64 + fr, col0 = (u.pn * BM + wc * 32 + 8 * fq) >> 1;
#pragma unroll
        for (int ai = 0; ai < 2; ++ai)
#pragma unroll
            for (int m = 0; m < 4; ++m) { bf16_t* rowp = O + (size_t)(row0 + ai * HALF + m * 16) * ldc + col0;
#pragma unroll
                for (int bj = 0; bj < 2; ++bj) { const f32x4 v0 = acc[ai][bj][m][0], v1 = acc[ai][bj][m][1];
                    const float a0 = silu_f(v0[0]) * v0[1], a1 = silu_f(v0[2]) * v0[3], a2 = silu_f(v1[0]) * v1[1], a3 = silu_f(v1[2]) * v1[3];
                    typedef unsigned u32x2 __attribute__((ext_vector_type(2)));
                    u32x2 w; w.x = cvt_pk_bf16(a0, a1); w.y = cvt_pk_bf16(a2, a3);
                    *(u32x2*)(rowp + bj * (HALF / 2)) = w; } }
    }
};
struct EpiResid {
    static constexpr bool PERM = false, AFTER_DRAIN = false;
    const float* xin_p; const float* xin_s; float* xout; const float* gate;
    __device__ __forceinline__ void operator()(const f32x4 (&acc)[2][2][4][2], const Unit& u, int wr, int wc, int fr, int fq) const {
        const int row0 = u.pm * BM + wr * 64 + fr, col0 = u.pn * BM + wc * 32 + 4 * fq;
#pragma unroll
        for (int ai = 0; ai < 2; ++ai)
#pragma unroll
            for (int m = 0; m < 4; ++m) { const int row = row0 + ai * HALF + m * 16;
                if (row < MR) {
                    const int nb = row < TP ? (row >> 11) : BATCH + ((row - TP) >> 2);
                    const float* gp = gate + (size_t)nb * MODW + col0;
                    const float* xi = (row < TP ? xin_p + (size_t)row * D : xin_s + (size_t)(row - TP) * D) + col0;
                    float* xo = xout + (size_t)row * D + col0;
#pragma unroll
                    for (int bj = 0; bj < 2; ++bj)
#pragma unroll
                        for (int n = 0; n < 2; ++n) { const int off = bj * HALF + n * 16;
                            const f32x4 gv = *(const f32x4*)(gp + off), xv = *(const f32x4*)(xi + off);
                            *(f32x4*)(xo + off) = xv + gv * acc[ai][bj][m][n]; } } }
    }
};
template <class Epi, class Sched, bool ALIGN_EPI = false, bool SP2 = false>
__device__ __forceinline__ void gemm_phase(PG8_LAS unsigned char* lds, const Gemm g, const Sched& S, const Epi& E) {
    const int tid = threadIdx.x, wid = __builtin_amdgcn_readfirstlane(tid >> 6), lane = tid & 63, wr = wid >> 2, wc = wid & 3, fr = lane & 15, fq = lane >> 4;
    const int K = g.K, nt = K / BK;
    unsigned voffA[2], voffB[2];
#pragma unroll
    for (int i = 0; i < 2; ++i) { int R, C; stage_rc(tid * 16 + i * 8192, R, C); const int Rb = Epi::PERM ? ((R & ~31) + perm32(R & 31)) : R;
        voffA[i] = (unsigned)(R * K + C) * 2u; voffB[i] = (unsigned)(Rb * K + C) * 2u; }
    const size_t kstep = (size_t)(BK * 2);
    const size_t hstep = (size_t)HALF * K * 2;
    const size_t tstep = 2 * hstep;
    const unsigned ldsw = (unsigned)wid * 1024u;
    const int aoff = lds_byte(wr * 64 + fr, fq * 8), boff = lds_byte(wc * 32 + fr, fq * 8);
#define PG8_SA(b, h) (((b) * 2 + (h)) * HTB)
#define PG8_SB(b, h) ((4 + (b) * 2 + (h)) * HTB)
#define PG8_STAGE(bufoff, gbase, voff) do { _Pragma("unroll") for (int _i = 0; _i < 2; ++_i) \
        __builtin_amdgcn_global_load_lds((const unsigned*)((const char*)(gbase) + (voff)[_i]), (PG8_LAS unsigned*)(lds + (bufoff) + ldsw + _i * 8192), 16, 0, 0); } while (0)
#define PG8_LDA(dst, b, h) do { _Pragma("unroll") for (int m = 0; m < 4; ++m) _Pragma("unroll") for (int k = 0; k < 2; ++k) dst[m][k] = *(const PG8_LAS bf16x8*)(lds + PG8_SA(b, h) + aoff + m * 2048 + k * 1024); } while (0)
#define PG8_LDB(dst, b, h) do { _Pragma("unroll") for (int n = 0; n < 2; ++n) _Pragma("unroll") for (int k = 0; k < 2; ++k) dst[n][k] = *(const PG8_LAS bf16x8*)(lds + PG8_SB(b, h) + boff + n * 2048 + k * 1024); } while (0)
#define PG8_MMA(ai, bj, At, Bt) do { __builtin_amdgcn_s_setprio(1); _Pragma("unroll") for (int m = 0; m < 4; ++m) _Pragma("unroll") for (int n = 0; n < 2; ++n) _Pragma("unroll") for (int k = 0; k < 2; ++k) \
        acc[ai][bj][m][n] = __builtin_amdgcn_mfma_f32_16x16x32_bf16(Bt[n][k], At[m][k], acc[ai][bj][m][n], 0, 0, 0); __builtin_amdgcn_s_setprio(0); } while (0)
#define PG8_WAIT_V(n) asm volatile("s_waitcnt vmcnt(" #n ")" ::: "memory")
#define PG8_WAIT_L(n) asm volatile("s_waitcnt lgkmcnt(" #n ")" ::: "memory")
#define PG8_BAR __builtin_amdgcn_s_barrier()
#define PG8_SCHED __builtin_amdgcn_sched_barrier(0)
    Unit cur, nxt; int ui = 0;
    if (!S.next(0, cur)) return;
    f32x4 acc[2][2][4][2];
#pragma unroll
    for (int a = 0; a < 2; ++a)
#pragma unroll
        for (int b = 0; b < 2; ++b)
#pragma unroll
            for (int m = 0; m < 4; ++m)
#pragma unroll
                for (int n = 0; n < 2; ++n) acc[a][b][m][n] = (f32x4){0.f, 0.f, 0.f, 0.f};
    bf16x8 At[4][2], B0[2][2], B1[2][2];
    const char* cA = (const char*)g.A + (size_t)cur.pm * tstep; const char* cB = (const char*)g.Bt + (size_t)cur.pn * tstep;
    S.a_ready(cur);
    if constexpr (SP2) {
        PG8_STAGE(PG8_SB(0, 0), cB, voffB); PG8_STAGE(PG8_SB(0, 1), cB + hstep, voffB); PG8_STAGE(PG8_SA(0, 0), cA, voffA); PG8_STAGE(PG8_SA(0, 1), cA + hstep, voffA);
        if (wr == 1) PG8_BAR;
        PG8_WAIT_V(2); PG8_BAR;
        PG8_STAGE(PG8_SB(1, 0), cB + kstep, voffB); PG8_STAGE(PG8_SA(1, 0), cA + kstep, voffA); PG8_STAGE(PG8_SB(1, 1), cB + hstep + kstep, voffB);
        PG8_WAIT_V(6); PG8_BAR;
    } else {
        PG8_STAGE(PG8_SB(0, 0), cB, voffB); PG8_STAGE(PG8_SA(0, 0), cA, voffA); PG8_STAGE(PG8_SB(0, 1), cB + hstep, voffB); PG8_STAGE(PG8_SA(0, 1), cA + hstep, voffA);
        if (wr == 1) PG8_BAR;
        PG8_WAIT_V(4); PG8_BAR;
        PG8_STAGE(PG8_SB(1, 0), cB + kstep, voffB); PG8_STAGE(PG8_SA(1, 0), cA + kstep, voffA); PG8_STAGE(PG8_SB(1, 1), cB + hstep + kstep, voffB);
        PG8_WAIT_V(6); PG8_BAR;
    }
    for (;;) {
        const bool has_next = S.next(ui + 1, nxt);
        const char* nA = has_next ? (const char*)g.A + (size_t)nxt.pm * tstep : cA; const char* nB = has_next ? (const char*)g.Bt + (size_t)nxt.pn * tstep : cB;
        for (int t = 0; t < nt; t += 2) {
            const bool last = (t == nt - 2);
            const char* a1 = cA + (size_t)(t + 1) * kstep;
            const char* a2 = last ? nA : cA + (size_t)(t + 2) * kstep; const char* b2 = last ? nB : cB + (size_t)(t + 2) * kstep;
            const char* a3 = a2 + kstep; const char* b3 = b2 + kstep;
            if (last && has_next) S.a_ready(nxt);
            if constexpr (SP2) {
            PG8_LDB(B0, 0, 0); PG8_LDB(B1, 0, 1); PG8_SCHED; PG8_LDA(At, 0, 0); PG8_STAGE(PG8_SA(1, 1), a1 + hstep, voffA);
            PG8_WAIT_V(8); PG8_WAIT_L(0); PG8_BAR; PG8_MMA(0, 0, At, B0); PG8_MMA(0, 1, At, B1); PG8_BAR; PG8_SCHED;
            PG8_LDA(At, 0, 1); PG8_STAGE(PG8_SB(0, 0), b2, voffB); PG8_STAGE(PG8_SB(0, 1), b2 + hstep, voffB); PG8_STAGE(PG8_SA(0, 0), a2, voffA);
            PG8_WAIT_V(8); PG8_WAIT_L(0); PG8_BAR; PG8_MMA(1, 0, At, B0); PG8_MMA(1, 1, At, B1); PG8_BAR; PG8_SCHED;
            PG8_LDB(B0, 1, 0); PG8_LDB(B1, 1, 1); PG8_SCHED; PG8_LDA(At, 1, 0); PG8_STAGE(PG8_SA(0, 1), a2 + hstep, voffA);
            PG8_WAIT_V(8); PG8_WAIT_L(0); PG8_BAR; PG8_MMA(0, 0, At, B0); PG8_MMA(0, 1, At, B1); PG8_BAR; PG8_SCHED;
            PG8_LDA(At, 1, 1); PG8_STAGE(PG8_SB(1, 0), b3, voffB); PG8_STAGE(PG8_SB(1, 1), b3 + hstep, voffB); PG8_STAGE(PG8_SA(1, 0), a3, voffA);
            PG8_WAIT_V(8); PG8_WAIT_L(0); PG8_BAR; PG8_MMA(1, 0, At, B0); PG8_MMA(1, 1, At, B1); PG8_BAR; PG8_SCHED;
            } else {
            PG8_LDB(B0, 0, 0); PG8_SCHED; PG8_LDA(At, 0, 0); PG8_STAGE(PG8_SA(1, 1), a1 + hstep, voffA);
            PG8_WAIT_L(8); PG8_BAR; PG8_WAIT_L(0); PG8_MMA(0, 0, At, B0); PG8_BAR; PG8_SCHED;
            PG8_LDB(B1, 0, 1); PG8_STAGE(PG8_SB(0, 0), b2, voffB);
            PG8_BAR; PG8_WAIT_L(0); PG8_MMA(0, 1, At, B1); PG8_BAR;
            PG8_LDA(At, 0, 1); PG8_STAGE(PG8_SA(0, 0), a2, voffA);
            PG8_BAR; PG8_WAIT_L(0); PG8_MMA(1, 0, At, B0); PG8_BAR; PG8_SCHED;
            PG8_STAGE(PG8_SB(0, 1), b2 + hstep, voffB);
            PG8_WAIT_V(6); PG8_BAR; PG8_MMA(1, 1, At, B1); PG8_BAR;
            PG8_LDB(B0, 1, 0); PG8_SCHED; PG8_LDA(At, 1, 0); PG8_STAGE(PG8_SA(0, 1), a2 + hstep, voffA);
            PG8_WAIT_L(8); PG8_BAR; PG8_WAIT_L(0); PG8_MMA(0, 0, At, B0); PG8_BAR; PG8_SCHED;
            PG8_LDB(B1, 1, 1); PG8_STAGE(PG8_SB(1, 0), b3, voffB);
            PG8_BAR; PG8_WAIT_L(0); PG8_MMA(0, 1, At, B1); PG8_BAR;
            PG8_LDA(At, 1, 1); PG8_STAGE(PG8_SA(1, 0), a3, voffA);
            PG8_BAR; PG8_WAIT_L(0); PG8_MMA(1, 0, At, B0); PG8_BAR; PG8_SCHED;
            PG8_STAGE(PG8_SB(1, 1), b3 + hstep, voffB);
            PG8_WAIT_V(6); PG8_BAR; PG8_MMA(1, 1, At, B1); PG8_BAR;
            }
        }
        if constexpr (ALIGN_EPI) { if (wr == 0) PG8_BAR; }
        if constexpr (!Epi::AFTER_DRAIN) { E(acc, cur, wr, wc, fr, fq); S.done(cur); }
        if (!has_next) break;
#pragma unroll
        for (int a = 0; a < 2; ++a)
#pragma unroll
            for (int b = 0; b < 2; ++b)
#pragma unroll
                for (int m = 0; m < 4; ++m)
#pragma unroll
                    for (int n = 0; n < 2; ++n) acc[a][b][m][n] = (f32x4){0.f, 0.f, 0.f, 0.f};
        cur = nxt; cA = nA; cB = nB; ++ui;
        if constexpr (ALIGN_EPI) { if (wr == 1) PG8_BAR; }
    }
    PG8_WAIT_V(0);
    if constexpr (!ALIGN_EPI) { if (wr == 0) PG8_BAR; }
    PG8_BAR;
    if constexpr (Epi::AFTER_DRAIN) { E.fused(acc, cur, wr, wc, fr, fq, lds, wid, lane); S.done(cur); }
#undef PG8_SA
#undef PG8_SB
#undef PG8_STAGE
#undef PG8_LDA
#undef PG8_LDB
#undef PG8_MMA
#undef PG8_WAIT_V
#undef PG8_WAIT_L
#undef PG8_BAR
#undef PG8_SCHED
}
}

#define GAS __attribute__((address_space(1)))
#define LAS __attribute__((address_space(3)))
typedef unsigned short bf16;
typedef float f32x4 __attribute__((ext_vector_type(4)));
typedef short bf16x8 __attribute__((ext_vector_type(8)));
typedef unsigned u32x4 __attribute__((ext_vector_type(4)));
typedef unsigned u32x2 __attribute__((ext_vector_type(2)));

constexpr int NWAVES = 8, NTHR = 512;
constexpr int LDS_BYTES = 147456;
constexpr int NPHASE = 17;

enum { I_XP = 0, I_XS, I_CP, I_CS, I_SA, I_KV0, I_KV1, I_KV2, I_SC, I_RB, I_ADAW, I_ADAB, I_NMG, I_NFG, I_WGU, I_WDN, I_FNG, I_EWIN, I_ACW, I_ACB,
       I_ALG, I_ALB, I_EWOUT, I_OWIN, I_CCW, I_CCB, I_DLG, I_DLB, I_DSW, I_DSB, I_OWOUT, N_IN };
constexpr size_t O_YP = 0, O_YS = O_YP + (size_t)TP * D, O_AP = O_YS + (size_t)TS * D, O_AS = O_AP + (size_t)BATCH * 30 * 256,
    O_KV0P = O_AS + (size_t)DEC_BATCH * 30 * 256, O_KV0S = O_KV0P + (size_t)BATCH * 128 * 512, O_KV1P = O_KV0S + (size_t)DEC_BATCH * 128 * 512,
    O_KV1S = O_KV1P + (size_t)BATCH * 512 * 512, O_KV2P = O_KV1S + (size_t)DEC_BATCH * 512 * 512, O_KV2S = O_KV2P + (size_t)BATCH * 2048 * 512,
    O_CP = O_KV2S + (size_t)DEC_BATCH * 2048 * 512, O_CS = O_CP + (size_t)BATCH * 2 * 512, O_DV = O_CS + (size_t)DEC_BATCH * 2 * 512,
    O_END = O_DV + (size_t)DEC_BATCH * 4 * 512;
static_assert(O_END == 72372224, "output size");
constexpr size_t al256(size_t x) { return (x + 255) & ~(size_t)255; }
constexpr size_t WS_CTL = 0, WS_CTL_BYTES = 1u << 20;
constexpr size_t WS_WEIN = WS_CTL + WS_CTL_BYTES;
constexpr size_t WS_WEOUT = WS_WEIN + (size_t)E_IN * D * 2;
constexpr size_t WS_WGU0 = WS_WEOUT + (size_t)D * 512 * 2;
constexpr size_t WS_WGU1 = WS_WGU0 + (size_t)2 * FFN * D * 2;
constexpr size_t WS_WDN0 = WS_WGU1 + (size_t)2 * FFN * D * 2;
constexpr size_t WS_WDN1 = WS_WDN0 + (size_t)D * FFN * 2;
constexpr size_t WS_WOIN = WS_WDN1 + (size_t)D * FFN * 2;
constexpr size_t WS_WOOUT = WS_WOIN + (size_t)O_IN * D * 2;
constexpr size_t WS_MOD = WS_WOOUT + (size_t)D * D * 2;
constexpr size_t WS_X = al256(WS_MOD + (size_t)2 * NB * MODW * 4);
constexpr size_t WS_H = WS_X + (size_t)MP * D * 4;
constexpr size_t WS_PROJ = WS_H + (size_t)MP * D * 2;
constexpr size_t WS_MIX = WS_PROJ + (size_t)MP * E_IN * 2;
constexpr size_t WS_ACT = WS_MIX + (size_t)MP * D * 2;
constexpr size_t WS_OG = WS_ACT + (size_t)MP * FFN * 2;
constexpr size_t WS_LSE = WS_OG + (size_t)3 * MR * 256 * 4;
constexpr size_t WS_END = al256(WS_LSE + (size_t)3 * MR * 4 * 4);

struct Params { const float* in[N_IN]; float* out; unsigned char* ws; int ph_lo, ph_hi; };
static_assert(sizeof(Params) == 8 * N_IN + 8 + 8 + 8, "Params has no padding");

__device__ const unsigned char BUCKET[3][132] = {
 {0,1,2,3,4,5,6,7,8,9,10,11,12,13,14,15,16,16,16,16,16,16,17,17,17,17,17,17,17,17,18,18,18,18,18,18,18,18,18,18,19,19,19,19,19,19,19,19,19,19,19,19,19,19,20,20,20,20,20,20,20,20,20,20,20,20,20,20,20,20,20,20,20,21,21,21,21,21,21,21,21,21,21,21,21,21,21,21,21,21,21,21,21,21,21,21,21,21,21,22,22,22,22,22,22,22,22,22,22,22,22,22,22,22,22,22,22,22,22,22,22,22,22,22,22,22,22,22,22,0,0,0},
 {0,4,8,12,16,16,17,17,18,18,19,19,19,19,20,20,20,20,20,21,21,21,21,21,21,22,22,22,22,22,22,22,22,22,23,23,23,23,23,23,23,23,23,23,23,23,24,24,24,24,24,24,24,24,24,24,24,24,24,24,24,24,25,25,25,25,25,25,25,25,25,25,25,25,25,25,25,25,25,25,25,25,25,26,26,26,26,26,26,26,26,26,26,26,26,26,26,26,26,26,26,26,26,26,26,26,26,26,26,26,26,26,26,27,27,27,27,27,27,27,27,27,27,27,27,27,27,27,27,0,0,0},
 {0,16,18,19,20,21,21,22,22,23,23,23,24,24,24,24,25,25,25,25,25,26,26,26,26,26,26,26,26,27,27,27,27,27,27,27,27,27,27,28,28,28,28,28,28,28,28,28,28,28,28,28,29,29,29,29,29,29,29,29,29,29,29,29,29,29,29,29,29,29,30,30,30,30,30,30,30,30,30,30,30,30,30,30,30,30,30,30,30,30,30,30,30,30,30,31,31,31,31,31,31,31,31,31,31,31,31,31,31,31,31,31,31,31,31,31,31,31,31,31,31,31,31,31,31,31,31,31,31,0,0,0}};

__device__ __forceinline__ float bf2f(unsigned b) { return __uint_as_float(b << 16); }
__device__ __forceinline__ unsigned f2bf(float f) { unsigned u = __float_as_uint(f); return (u + 0x7fffu + ((u >> 16) & 1u)) >> 16; }
__device__ __forceinline__ unsigned pk2(float lo, float hi) { return f2bf(lo) | (f2bf(hi) << 16); }
__device__ __forceinline__ float wave_sum(float v) {
#pragma unroll
    for (int o = 1; o < 64; o <<= 1) v += __shfl_xor(v, o);
    return v;
}
__device__ __forceinline__ float wave_max(float v) {
#pragma unroll
    for (int o = 1; o < 64; o <<= 1) v = fmaxf(v, __shfl_xor(v, o));
    return v;
}
__device__ __forceinline__ void unpack8(const u32x4 w, float (&f)[8]) {
    f[0] = bf2f(w.x & 0xffffu); f[1] = bf2f(w.x >> 16); f[2] = bf2f(w.y & 0xffffu); f[3] = bf2f(w.y >> 16);
    f[4] = bf2f(w.z & 0xffffu); f[5] = bf2f(w.z >> 16); f[6] = bf2f(w.w & 0xffffu); f[7] = bf2f(w.w >> 16);
}
__device__ __forceinline__ int batch_of(int row) { return row < TP ? (row >> 11) : BATCH + ((row - TP) >> 2); }
#define LDS_WAIT() asm volatile("s_waitcnt lgkmcnt(0)" ::: "memory")

__device__ __forceinline__ void transpose_item(const float* W, int K, int N, bf16* WT, bool ilv, LAS float* scr, int item, int lane) {
    const int nblk = N / 32, kb = item / nblk, nb = item % nblk, k0 = 64 * kb, n0 = 32 * nb;
#pragma unroll 8
    for (int i = 0; i < 32; ++i) { const int kk = 2 * i + (lane >> 5); scr[kk * 33 + (lane & 31)] = W[(size_t)(k0 + kk) * N + n0 + (lane & 31)]; }
    LDS_WAIT();
    const int c = lane & 7;
#pragma unroll
    for (int j = 0; j < 4; ++j) { const int n = (lane >> 3) + 8 * j; const LAS float* s = scr + (8 * c) * 33 + n;
        u32x4 o; o.x = pk2(s[0 * 33], s[1 * 33]); o.y = pk2(s[2 * 33], s[3 * 33]); o.z = pk2(s[4 * 33], s[5 * 33]); o.w = pk2(s[6 * 33], s[7 * 33]);
        const int col = n0 + n; const int orow = ilv ? (col < FFN ? 2 * col : 2 * (col - FFN) + 1) : col;
        *(u32x4*)(WT + (size_t)orow * K + k0 + 8 * c) = o; }
    LDS_WAIT();
}

__device__ __forceinline__ void adaln_item(const Params& p, LAS unsigned char* lds, int it) {
    int tid = threadIdx.x; asm volatile("" : "+v"(tid));
    const int lane = tid & 63, wave = tid >> 6;
    const int l = it / 96, j0 = (it % 96) * 64;
    LAS float* s = (LAS float*)lds;
    const float* cp = p.in[I_CP]; const float* cs = p.in[I_CS];
    float* mod = (float*)(p.ws + WS_MOD);
    float acc[NB];
#pragma unroll
    for (int n = 0; n < NB; ++n) acc[n] = 0.f;
    for (int kh = 0; kh < 2; ++kh) {
        __syncthreads();
        for (int idx = tid; idx < NB * 512; idx += NTHR) { const int n = idx >> 9, k = idx & 511;
            const float c = n < BATCH ? cp[n * D + kh * 512 + k] : cs[(n - BATCH) * D + kh * 512 + k];
            s[idx] = c / (1.0f + expf(-c)); }
        __syncthreads();
        const float* wp = p.in[I_ADAW] + ((size_t)l * D + kh * 512 + wave * 64) * MODW + j0 + lane;
#pragma unroll 2
        for (int k4 = 0; k4 < 16; ++k4) {
            const float w0 = wp[(size_t)(4 * k4 + 0) * MODW], w1 = wp[(size_t)(4 * k4 + 1) * MODW], w2 = wp[(size_t)(4 * k4 + 2) * MODW], w3 = wp[(size_t)(4 * k4 + 3) * MODW];
#pragma unroll
            for (int n = 0; n < NB; ++n) { const f32x4 sv = *(const LAS f32x4*)(s + n * 512 + wave * 64 + 4 * k4);
                acc[n] += sv.x * w0 + sv.y * w1 + sv.z * w2 + sv.w * w3; }
        }
    }
    __syncthreads();
    LAS float* red = (LAS float*)lds;
#pragma unroll
    for (int n = 0; n < NB; ++n) red[(wave * NB + n) * 64 + lane] = acc[n];
    __syncthreads();
    for (int idx = tid; idx < NB * 64; idx += NTHR) { const int n = idx >> 6, j = idx & 63; float t = 0.f;
#pragma unroll
        for (int w = 0; w < NWAVES; ++w) t += red[(w * NB + n) * 64 + j];
        mod[((size_t)l * NB + n) * MODW + j0 + j] = t + p.in[I_ADAB][l * MODW + j0 + j]; }
    __syncthreads();
}

__device__ __forceinline__ void phase0(const Params& p, LAS unsigned char* lds) {
    const int tid = threadIdx.x, lane = tid & 63, wave = tid >> 6;
    for (int it = blockIdx.x; it < 192; it += gridDim.x) adaln_item(p, lds, it);
    __syncthreads();
    {
        LAS float* scr = (LAS float*)(lds + wave * 16384);
        const int gw = blockIdx.x * NWAVES + wave, NGW = gridDim.x * NWAVES;
        constexpr int I0 = (D / 64) * (E_IN / 32), I1 = (512 / 64) * (D / 32), I2 = (D / 64) * (2 * FFN / 32), I3 = (FFN / 64) * (D / 32), I4 = (D / 64) * (O_IN / 32), I5 = (D / 64) * (D / 32);
        constexpr int NIT = I0 + I1 + 2 * I2 + 2 * I3 + I4 + I5;
        for (int it = gw; it < NIT; it += NGW) {
            int r = it;
            if (r < I0) { transpose_item(p.in[I_EWIN], D, E_IN, (bf16*)(p.ws + WS_WEIN), false, scr, r, lane); continue; } r -= I0;
            if (r < I1) { transpose_item(p.in[I_EWOUT], 512, D, (bf16*)(p.ws + WS_WEOUT), false, scr, r, lane); continue; } r -= I1;
            if (r < I2) { transpose_item(p.in[I_WGU], D, 2 * FFN, (bf16*)(p.ws + WS_WGU0), true, scr, r, lane); continue; } r -= I2;
            if (r < I2) { transpose_item(p.in[I_WGU] + (size_t)D * 2 * FFN, D, 2 * FFN, (bf16*)(p.ws + WS_WGU1), true, scr, r, lane); continue; } r -= I2;
            if (r < I3) { transpose_item(p.in[I_WDN], FFN, D, (bf16*)(p.ws + WS_WDN0), false, scr, r, lane); continue; } r -= I3;
            if (r < I3) { transpose_item(p.in[I_WDN] + (size_t)FFN * D, FFN, D, (bf16*)(p.ws + WS_WDN1), false, scr, r, lane); continue; } r -= I3;
            if (r < I4) { transpose_item(p.in[I_OWIN], D, O_IN, (bf16*)(p.ws + WS_WOIN), false, scr, r, lane); continue; } r -= I4;
            transpose_item(p.in[I_OWOUT], D, D, (bf16*)(p.ws + WS_WOOUT), false, scr, r, lane);
        }
    }
    {
        const size_t gt = (size_t)blockIdx.x * NTHR + tid, NGT = (size_t)gridDim.x * NTHR;
#pragma unroll
        for (int g = 0; g < 3; ++g) {
            const int Wb = 128 << (2 * g);
            const f32x4* src = (const f32x4*)p.in[I_KV0 + g];
            f32x4* dst = (f32x4*)(p.out + (g == 0 ? O_KV0S : g == 1 ? O_KV1S : O_KV2S));
            const size_t cnt = (size_t)(Wb - 4) * 128, total = (size_t)DEC_BATCH * cnt;
            for (size_t i = gt; i < total; i += NGT) { const size_t n = i / cnt, r = i - n * cnt;
                dst[n * Wb * 128 + r] = src[(n * Wb + 4) * 128 + r]; }
        }
    }
}

template <bool FINAL>
__device__ __forceinline__ void norm_phase(const float* xp, const float* xs, const float* g, const float* shift, const float* scale, bf16* H, float* outp, float* outs) {
    const int tid = threadIdx.x, lane = tid & 63, wave = tid >> 6;
    const int gw = blockIdx.x * NWAVES + wave, NGW = gridDim.x * NWAVES;
    f32x4 gv[4];
#pragma unroll
    for (int j = 0; j < 4; ++j) gv[j] = ((const f32x4*)g)[lane + 64 * j];
    for (int row = gw; row < (FINAL ? MR : MP); row += NGW) {
        if (!FINAL && row >= MR) {
#pragma unroll
            for (int j = 0; j < 4; ++j) *(u32x2*)(H + (size_t)row * D + 4 * lane + 256 * j) = (u32x2){0u, 0u};
            continue;
        }
        const float* xr = row < TP ? xp + (size_t)row * D : xs + (size_t)(row - TP) * D;
        f32x4 v[4]; float ss = 0.f;
#pragma unroll
        for (int j = 0; j < 4; ++j) { v[j] = ((const f32x4*)xr)[lane + 64 * j]; ss += (v[j].x * v[j].x + v[j].y * v[j].y) + (v[j].z * v[j].z + v[j].w * v[j].w); }
        const float rstd = 1.0f / sqrtf(wave_sum(ss) * (1.0f / D) + EPS);
        if (FINAL) {
            float* o = row < TP ? outp + (size_t)row * D : outs + (size_t)(row - TP) * D;
#pragma unroll
            for (int j = 0; j < 4; ++j) ((f32x4*)o)[lane + 64 * j] = v[j] * rstd * gv[j];
        } else {
            const int nb = batch_of(row);
            const f32x4* sh = (const f32x4*)(shift + (size_t)nb * MODW); const f32x4* sc = (const f32x4*)(scale + (size_t)nb * MODW);
#pragma unroll
            for (int j = 0; j < 4; ++j) { const f32x4 y = v[j] * rstd * gv[j] * (sc[lane + 64 * j] + 1.0f) + sh[lane + 64 * j];
                *(u32x2*)(H + (size_t)row * D + 4 * lane + 256 * j) = (u32x2){pk2(y.x, y.y), pk2(y.z, y.w)}; }
        }
    }
}

#ifndef DBG_P3
#define DBG_P3 31
#endif
constexpr int QCOL = 512, KCOL = 1280, VCOL = 2048;
constexpr int VT_PITCH = 264;
constexpr int AT_VT = 0, AT_P = 64 * VT_PITCH * 2, AT_PW = 16 * VT_PITCH * 2, AT_BIAS = AT_P + NWAVES * AT_PW;
static_assert(AT_BIAS + 132 * 4 <= 131072, "attention LDS");

__device__ __forceinline__ void attn_unit(const Params& p, LAS unsigned char* lds, int u) {
    int tid = threadIdx.x; asm volatile("" : "+v"(tid));
    const int lane = tid & 63, wave = tid >> 6, fr = lane & 15, fq = lane >> 4;
    const int b = u / 192, v_ = u % 192, g = v_ / 64, w_ = v_ % 64, h = w_ / 16, x_ = w_ % 16;
    const int dl = 2 * g, d = 1 << dl, nblk = 16 >> dl, r = x_ / nblk, i = x_ % nblk;
    const bf16* PROJ = (const bf16*)(p.ws + WS_PROJ);
    LAS bf16* Vt = (LAS bf16*)(lds + AT_VT);
    LAS bf16* Pw = (LAS bf16*)(lds + AT_P + wave * AT_PW);
    LAS float* biasl = (LAS float*)(lds + AT_BIAS);
    const int kt0 = (i == 0) ? 8 : 0;
    const size_t rowbase = (size_t)b * SEQ;
    {
        const int kl = tid & 255, half = tid >> 8; const int mk = 128 * (i - 1) + kl;
        u32x4 w[4];
        if (mk >= 0) { const bf16* vp = PROJ + (rowbase + (size_t)mk * d + r) * E_IN + VCOL + g * 256 + h * 64 + 32 * half;
#pragma unroll
            for (int c = 0; c < 4; ++c) w[c] = *(const u32x4*)(vp + 8 * c);
        } else {
#pragma unroll
            for (int c = 0; c < 4; ++c) w[c] = (u32x4){0u, 0u, 0u, 0u};
        }
#pragma unroll
        for (int c = 0; c < 4; ++c) { const unsigned ww[4] = {w[c].x, w[c].y, w[c].z, w[c].w};
#pragma unroll
            for (int e = 0; e < 4; ++e) { const int dd = 32 * half + 8 * c + 2 * e;
                Vt[dd * VT_PITCH + kl] = (bf16)(ww[e] & 0xffffu); Vt[(dd + 1) * VT_PITCH + kl] = (bf16)(ww[e] >> 16); } }
        if (tid < 129) biasl[tid] = p.in[I_RB][BUCKET[g][tid] * 12 + g * 4 + h];
    }
    bf16x8 qa[2];
    {
        const int mq = 128 * i + 16 * wave + fr;
        const bf16* qp = PROJ + (rowbase + (size_t)mq * d + r) * E_IN + QCOL + g * 256 + h * 64 + 8 * fq;
        qa[0] = *(const bf16x8*)qp; qa[1] = *(const bf16x8*)(qp + 32);
    }
    f32x4 sacc[16];
#pragma unroll
    for (int kt = 0; kt < 16; ++kt) {
        sacc[kt] = (f32x4){0.f, 0.f, 0.f, 0.f};
        if (kt >= kt0) {
            const int mk = 128 * (i - 1) + 16 * kt + fr;
            const bf16* kp = PROJ + (rowbase + (size_t)mk * d + r) * E_IN + KCOL + g * 256 + h * 64 + 8 * fq;
            const bf16x8 k0 = *(const bf16x8*)kp, k1 = *(const bf16x8*)(kp + 32);
            sacc[kt] = __builtin_amdgcn_mfma_f32_16x16x32_bf16(qa[0], k0, sacc[kt], 0, 0, 0);
            sacc[kt] = __builtin_amdgcn_mfma_f32_16x16x32_bf16(qa[1], k1, sacc[kt], 0, 0, 0);
        }
    }
    __syncthreads();
    float mx[4] = {-INFINITY, -INFINITY, -INFINITY, -INFINITY};
#pragma unroll
    for (int kt = 0; kt < 16; ++kt) {
#pragma unroll
        for (int rg = 0; rg < 4; ++rg) {
            const int rel = (16 * wave + 4 * fq + rg) + 128 - (16 * kt + fr);
            const bool ok = (kt >= kt0) && rel >= 0 && rel <= 128;
            const float sv = ok ? sacc[kt][rg] * 0.125f + biasl[ok ? rel : 0] : -INFINITY;
            sacc[kt][rg] = sv; mx[rg] = fmaxf(mx[rg], sv);
        }
    }
#pragma unroll
    for (int rg = 0; rg < 4; ++rg) {
#pragma unroll
        for (int o = 1; o < 16; o <<= 1) mx[rg] = fmaxf(mx[rg], __shfl_xor(mx[rg], o));
    }
    float ls[4] = {0.f, 0.f, 0.f, 0.f};
#pragma unroll
    for (int kt = 0; kt < 16; ++kt) {
#pragma unroll
        for (int rg = 0; rg < 4; ++rg) {
            const float e = __builtin_amdgcn_exp2f((sacc[kt][rg] - mx[rg]) * 1.4426950408889634f);
            ls[rg] += e;
            Pw[(4 * fq + rg) * VT_PITCH + 16 * kt + fr] = (bf16)f2bf(e);
        }
    }
#pragma unroll
    for (int rg = 0; rg < 4; ++rg) {
#pragma unroll
        for (int o = 1; o < 16; o <<= 1) ls[rg] += __shfl_xor(ls[rg], o);
    }
    __syncthreads();
    f32x4 oacc[4];
#pragma unroll
    for (int nd = 0; nd < 4; ++nd) oacc[nd] = (f32x4){0.f, 0.f, 0.f, 0.f};
#pragma unroll
    for (int ks = 0; ks < 8; ++ks) {
        if (2 * ks >= kt0) {
            const bf16x8 pa = *(const LAS bf16x8*)(Pw + fr * VT_PITCH + 32 * ks + 8 * fq);
#pragma unroll
            for (int nd = 0; nd < 4; ++nd) {
                const bf16x8 vb = *(const LAS bf16x8*)(Vt + (16 * nd + fr) * VT_PITCH + 32 * ks + 8 * fq);
                oacc[nd] = __builtin_amdgcn_mfma_f32_16x16x32_bf16(pa, vb, oacc[nd], 0, 0, 0);
            }
        }
    }
    float* OG = (float*)(p.ws + WS_OG) + (size_t)g * MR * 256;
    float* LSE = (float*)(p.ws + WS_LSE) + (size_t)g * MR * 4;
#pragma unroll
    for (int rg = 0; rg < 4; ++rg) {
        const int mq = 128 * i + 16 * wave + 4 * fq + rg; const size_t row = rowbase + (size_t)mq * d + r;
        const float inv = 1.0f / ls[rg];
#pragma unroll
        for (int nd = 0; nd < 4; ++nd) OG[row * 256 + h * 64 + 16 * nd + fr] = oacc[nd][rg] * inv;
        if (fr == 0) LSE[row * 4 + h] = mx[rg] + logf(ls[rg]);
    }
    __syncthreads();
}

constexpr int CA_GLU = 0, CA_Y = 62 * 256 * 4;
__device__ __forceinline__ void conva_item(const Params& p, LAS unsigned char* lds, bool sample, int bn, int t0) {
    int tid = threadIdx.x; asm volatile("" : "+v"(tid));
    const int lane = tid & 63, wave = tid >> 6;
    const bf16* PROJ = (const bf16*)(p.ws + WS_PROJ);
    bf16* MIX = (bf16*)(p.ws + WS_MIX);
    LAS float* glu = (LAS float*)(lds + CA_GLU); LAS float* ys = (LAS float*)(lds + CA_Y);
    const int c = tid & 255, th = tid >> 8;
    const int RR = sample ? 34 : 62, NT = sample ? 4 : 32;
    for (int rr = th; rr < RR; rr += 2) {
        float v;
        if (sample) {
            if (rr < 30) v = p.in[I_SA][((size_t)bn * 30 + rr) * 256 + c];
            else { const bf16* pr = PROJ + (size_t)(TP + 4 * bn + rr - 30) * E_IN; const float a = bf2f(pr[c]), gt = bf2f(pr[256 + c]); v = a / (1.0f + expf(-gt)); }
        } else {
            const int t = t0 - 30 + rr;
            if (t < 0) v = 0.f;
            else { const bf16* pr = PROJ + ((size_t)bn * SEQ + t) * E_IN; const float a = bf2f(pr[c]), gt = bf2f(pr[256 + c]); v = a / (1.0f + expf(-gt)); }
        }
        glu[rr * 256 + c] = v;
    }
    __syncthreads();
    if (sample) { float* o = p.out + O_AS + (size_t)bn * 30 * 256; for (int j = th; j < 30; j += 2) o[j * 256 + c] = glu[(j + 4) * 256 + c]; }
    else if (t0 == SEQ - 32) { float* o = p.out + O_AP + (size_t)bn * 30 * 256; for (int j = th; j < 30; j += 2) o[j * 256 + c] = glu[(j + 32) * 256 + c]; }
    {
        float win[46];
#pragma unroll
        for (int q = 0; q < 46; ++q) { const int rr = 16 * th + q; win[q] = rr < RR ? glu[rr * 256 + c] : 0.f; }
        float y[16]; const float bb = p.in[I_ACB][c];
#pragma unroll
        for (int q = 0; q < 16; ++q) y[q] = bb;
#pragma unroll
        for (int k = 0; k < 31; ++k) { const float wk = p.in[I_ACW][k * 256 + c];
#pragma unroll
            for (int q = 0; q < 16; ++q) y[q] += wk * win[q + k]; }
#pragma unroll
        for (int q = 0; q < 16; ++q) ys[(16 * th + q) * 256 + c] = y[q];
    }
    __syncthreads();
    const f32x4 lg = ((const f32x4*)p.in[I_ALG])[lane], lb = ((const f32x4*)p.in[I_ALB])[lane];
#pragma unroll
    for (int q = 0; q < 4; ++q) { const int tl = 4 * wave + q;
        if (tl < NT) {
            const f32x4 v = *(const LAS f32x4*)(ys + tl * 256 + 4 * lane);
            const float mu = wave_sum((v.x + v.y) + (v.z + v.w)) * (1.0f / 256.0f);
            const f32x4 dv = v - mu;
            const float var = wave_sum((dv.x * dv.x + dv.y * dv.y) + (dv.z * dv.z + dv.w * dv.w)) * (1.0f / 256.0f);
            const float rstd = 1.0f / sqrtf(var + EPS);
            f32x4 y = dv * rstd * lg + lb;
            y.x = y.x / (1.0f + expf(-y.x)); y.y = y.y / (1.0f + expf(-y.y)); y.z = y.z / (1.0f + expf(-y.z)); y.w = y.w / (1.0f + expf(-y.w));
            const size_t row = sample ? (size_t)(TP + 4 * bn + tl) : (size_t)bn * SEQ + t0 + tl;
            *(u32x2*)(MIX + row * 512 + 4 * lane) = (u32x2){pk2(y.x, y.y), pk2(y.z, y.w)};
        } }
    __syncthreads();
}

constexpr int SA_NEW = 0, SA_Q = 4 * 2 * 256 * 4, SA_P = SA_Q + 4 * 256 * 4;
__device__ __forceinline__ void sattn_item(const Params& p, LAS unsigned char* lds, int n, int g) {
    int tid = threadIdx.x; asm volatile("" : "+v"(tid));
    const int lane = tid & 63, wave = tid >> 6;
    const bf16* PROJ = (const bf16*)(p.ws + WS_PROJ);
    const int dl = 2 * g, d = 1 << dl, Wb = 128 << dl;
    const float* cache = p.in[I_KV0 + g] + (size_t)n * Wb * 512;
    float* kvout = p.out + (g == 0 ? O_KV0S : g == 1 ? O_KV1S : O_KV2S) + (size_t)n * Wb * 512;
    LAS float* newkv = (LAS float*)(lds + SA_NEW); LAS float* qs = (LAS float*)(lds + SA_Q); LAS float* pw = (LAS float*)(lds + SA_P) + wave * 192;
    for (int idx = tid; idx < 4 * 3 * 256; idx += NTHR) { const int s = idx / 768, rem = idx % 768, which = rem >> 8, col = rem & 255;
        const float v = bf2f(PROJ[(size_t)(TP + 4 * n + s) * E_IN + QCOL + (which * 3 + g) * 256 + col]);
        if (which == 0) qs[s * 256 + col] = v;
        else { newkv[(s * 2 + which - 1) * 256 + col] = v; kvout[((size_t)(Wb - 4 + s) * 2 + which - 1) * 256 + col] = v; } }
    __syncthreads();
    float* OG = (float*)(p.ws + WS_OG) + (size_t)g * MR * 256;
    float* LSE = (float*)(p.ws + WS_LSE) + (size_t)g * MR * 4;
    for (int pr = 2 * wave; pr < 2 * wave + 2; ++pr) {
        const int s = pr >> 2, h = pr & 3;
        float sc[3];
#pragma unroll
        for (int rd = 0; rd < 3; ++rd) {
            const int j = rd * 64 + lane; float dot = 0.f;
            if (j <= 128) {
                const int idx = Wb + s - j * d;
                if (idx >= Wb) { const LAS float* kp = newkv + ((idx - Wb) * 2 + 0) * 256 + h * 64;
#pragma unroll
                    for (int e = 0; e < 16; ++e) { const f32x4 kv = *(const LAS f32x4*)(kp + 4 * e), qv = *(const LAS f32x4*)(qs + s * 256 + h * 64 + 4 * e); dot += (kv.x * qv.x + kv.y * qv.y) + (kv.z * qv.z + kv.w * qv.w); }
                } else { const float* kp = cache + ((size_t)idx * 2 + 0) * 256 + h * 64;
#pragma unroll
                    for (int e = 0; e < 16; ++e) { const f32x4 kv = *(const f32x4*)(kp + 4 * e), qv = *(const LAS f32x4*)(qs + s * 256 + h * 64 + 4 * e); dot += (kv.x * qv.x + kv.y * qv.y) + (kv.z * qv.z + kv.w * qv.w); }
                }
                sc[rd] = dot * 0.125f + p.in[I_RB][BUCKET[g][j] * 12 + g * 4 + h];
            } else sc[rd] = -INFINITY;
        }
        const float m = wave_max(fmaxf(fmaxf(sc[0], sc[1]), sc[2]));
        float e3[3]; float l = 0.f;
#pragma unroll
        for (int rd = 0; rd < 3; ++rd) { e3[rd] = expf(sc[rd] - m); l += e3[rd]; }
        l = wave_sum(l);
        const float inv = 1.0f / l;
#pragma unroll
        for (int rd = 0; rd < 3; ++rd) pw[rd * 64 + lane] = e3[rd] * inv;
        LDS_WAIT();
        const int kq = lane >> 4, d4 = 4 * (lane & 15);
        f32x4 o = (f32x4){0.f, 0.f, 0.f, 0.f};
        for (int it = 0; it < 33; ++it) {
            const int j = 4 * it + kq;
            if (j <= 128) {
                const int idx = Wb + s - j * d; const float pj = pw[j];
                f32x4 vv;
                if (idx >= Wb) vv = *(const LAS f32x4*)(newkv + ((idx - Wb) * 2 + 1) * 256 + h * 64 + d4);
                else vv = *(const f32x4*)(cache + ((size_t)idx * 2 + 1) * 256 + h * 64 + d4);
                o += vv * pj;
            }
        }
#pragma unroll
        for (int c = 0; c < 4; ++c) { o[c] += __shfl_xor(o[c], 16); o[c] += __shfl_xor(o[c], 32); }
        const size_t row = (size_t)(TP + 4 * n + s);
        if (lane < 16) *(f32x4*)(OG + row * 256 + h * 64 + d4) = o;
        if (lane == 0) LSE[row * 4 + h] = m + logf(l);
        LDS_WAIT();
    }
    __syncthreads();
}

__device__ __forceinline__ void phase3(const Params& p, LAS unsigned char* lds) {
    constexpr int N_ATT = BATCH * 192, N_CA = TP / 32, N_SA = DEC_BATCH * 3, N_CS = DEC_BATCH;
    for (int it = blockIdx.x; it < N_ATT + N_CA + N_SA + N_CS; it += gridDim.x) {
        int r = it;
        if (r < N_SA) { if (DBG_P3 & 1) sattn_item(p, lds, r / 3, r % 3); continue; } r -= N_SA;
        if (r < N_ATT) { if (DBG_P3 & 2) attn_unit(p, lds, r); continue; } r -= N_ATT;
        if (r < N_CA) { if (DBG_P3 & 4) conva_item(p, lds, false, r / 64, (r % 64) * 32); continue; } r -= N_CA;
        if (DBG_P3 & 8) conva_item(p, lds, true, r, 0);
    }
    if (!(DBG_P3 & 16)) return;
    const bf16* PROJ = (const bf16*)(p.ws + WS_PROJ);
    const size_t gt = (size_t)blockIdx.x * NTHR + threadIdx.x, NGT = (size_t)gridDim.x * NTHR;
#pragma unroll
    for (int g = 0; g < 3; ++g) {
        const int W = 128 << (2 * g);
        float* o = p.out + (g == 0 ? O_KV0P : g == 1 ? O_KV1P : O_KV2P);
        const size_t total = (size_t)BATCH * W * 64;
        for (size_t i = gt; i < total; i += NGT) { const int vec = (int)(i & 31), which = (int)((i >> 5) & 1); const size_t bj = i >> 6; int j = (int)(bj % W), b = (int)(bj / W); asm volatile("" : "+v"(j), "+v"(b));
            const u32x4 w = *(const u32x4*)(PROJ + ((size_t)b * SEQ + (SEQ - W + j)) * E_IN + QCOL + ((1 + which) * 3 + g) * 256 + 8 * vec);
            float f[8]; unpack8(w, f);
            float* op = o + i * 8;
            *(f32x4*)op = (f32x4){f[0], f[1], f[2], f[3]}; *(f32x4*)(op + 4) = (f32x4){f[4], f[5], f[6], f[7]}; }
    }
}

__device__ __forceinline__ void phase4(const Params& p) {
    const int tid = threadIdx.x, lane = tid & 63, wave = tid >> 6;
    const int gw = blockIdx.x * NWAVES + wave, NGW = gridDim.x * NWAVES;
    const float* OG = (const float*)(p.ws + WS_OG); const float* LSE = (const float*)(p.ws + WS_LSE);
    bf16* MIX = (bf16*)(p.ws + WS_MIX);
    for (int row = gw; row < MP; row += NGW) {
        if (row >= MR) { *(u32x4*)(MIX + (size_t)row * 512 + 8 * lane) = (u32x4){0u, 0u, 0u, 0u}; continue; }
        const int h = lane >> 4;
        const float l0 = LSE[(size_t)row * 4 + h], l1 = LSE[((size_t)MR + row) * 4 + h], l2 = LSE[((size_t)2 * MR + row) * 4 + h];
        const float m = fmaxf(fmaxf(l0, l1), l2);
        const float e0 = expf(l0 - m), e1 = expf(l1 - m), e2 = expf(l2 - m), inv = 1.0f / (e0 + e1 + e2);
        const f32x4 o0 = *(const f32x4*)(OG + (size_t)row * 256 + 4 * lane), o1 = *(const f32x4*)(OG + ((size_t)MR + row) * 256 + 4 * lane), o2 = *(const f32x4*)(OG + ((size_t)2 * MR + row) * 256 + 4 * lane);
        const f32x4 a = (o0 * e0 + o1 * e1 + o2 * e2) * inv;
        *(u32x2*)(MIX + (size_t)row * 512 + 256 + 4 * lane) = (u32x2){pk2(a.x, a.y), pk2(a.z, a.w)};
    }
}

__device__ __forceinline__ void mixc_rows(const Params& p) {
    const bf16* PJ = (const bf16*)(p.ws + WS_PROJ);
    bf16* MIX = (bf16*)(p.ws + WS_MIX);
    const size_t gt = (size_t)blockIdx.x * NTHR + threadIdx.x, NGT = (size_t)gridDim.x * NTHR;
    for (size_t i = gt; i < (size_t)MP * 64; i += NGT) {
        const int row = (int)(i >> 6), c0 = (int)(i & 63) * 8;
        if (row >= MR) { *(u32x4*)(MIX + (size_t)row * D + c0) = (u32x4){0u, 0u, 0u, 0u}; *(u32x4*)(MIX + (size_t)row * D + 512 + c0) = (u32x4){0u, 0u, 0u, 0u}; continue; }
        const bool smp = row >= TP; const int t = smp ? ((row - TP) & 3) : (row & 2047); const int n = smp ? ((row - TP) >> 2) : (row >> 11);
        float ci[3][8];
#pragma unroll
        for (int k = 0; k < 3; ++k) { const int tt = t - 2 + k;
            if (tt >= 0) { float a[8], b[8]; unpack8(*(const u32x4*)(PJ + (size_t)(row - 2 + k) * O_IN + 512 + c0), a); unpack8(*(const u32x4*)(PJ + (size_t)(row - 2 + k) * O_IN + 1024 + c0), b);
#pragma unroll
                for (int e = 0; e < 8; ++e) ci[k][e] = a[e] * b[e]; }
            else if (smp) { const float* sp = p.in[I_SC] + ((size_t)n * 2 + (tt + 2)) * 512 + c0;
#pragma unroll
                for (int e = 0; e < 8; ++e) ci[k][e] = sp[e]; }
            else {
#pragma unroll
                for (int e = 0; e < 8; ++e) ci[k][e] = 0.f; } }
        float bg[8]; unpack8(*(const u32x4*)(PJ + (size_t)row * O_IN + c0), bg);
        float y[8];
#pragma unroll
        for (int e = 0; e < 8; ++e) { const float* w = p.in[I_CCW] + c0 + e;
            y[e] = bg[e] * (w[0] * ci[0][e] + w[512] * ci[1][e] + w[1024] * ci[2][e] + p.in[I_CCB][c0 + e]); }
        *(u32x4*)(MIX + (size_t)row * D + c0) = (u32x4){pk2(y[0], y[1]), pk2(y[2], y[3]), pk2(y[4], y[5]), pk2(y[6], y[7])};
        float* so = nullptr;
        if (smp) { if (t >= 2) so = p.out + O_CS + ((size_t)n * 2 + (t - 2)) * 512 + c0; }
        else if (t >= SEQ - 2) so = p.out + O_CP + ((size_t)n * 2 + (t - (SEQ - 2))) * 512 + c0;
        if (so) { *(f32x4*)so = (f32x4){ci[2][0], ci[2][1], ci[2][2], ci[2][3]}; *(f32x4*)(so + 4) = (f32x4){ci[2][4], ci[2][5], ci[2][6], ci[2][7]}; }
    }
}

constexpr int MD_PITCH = 136;
constexpr int MD_VT = 0, MD_WS = 128 * MD_PITCH * 2, MD_ST = 2 * 128 * MD_PITCH * 2;
__device__ __forceinline__ void mixd_item(const Params& p, LAS unsigned char* lds, int b, int ck) {
    int tid = threadIdx.x; asm volatile("" : "+v"(tid));
    const int lane = tid & 63, wave = tid >> 6, fr = lane & 15, fq = lane >> 4;
    const bf16* PJ = (const bf16*)(p.ws + WS_PROJ);
    bf16* MIX = (bf16*)(p.ws + WS_MIX);
    LAS bf16* vT = (LAS bf16*)(lds + MD_VT); LAS bf16* Wl = (LAS bf16*)(lds + MD_WS); LAS float* st = (LAS float*)(lds + MD_ST);
    const size_t row0 = (size_t)b * SEQ + (size_t)ck * 128;
    for (int q = 0; q < 16; ++q) { const int j = 16 * wave + q;
        float f[8]; unpack8(*(const u32x4*)(PJ + (row0 + j) * O_IN + 2048 + 8 * lane), f);
        float s = 0.f;
#pragma unroll
        for (int e = 0; e < 8; ++e) s += f[e];
        const float mu = wave_sum(s) * (1.0f / 512.0f); float s2 = 0.f;
#pragma unroll
        for (int e = 0; e < 8; ++e) { const float dlt = f[e] - mu; s2 += dlt * dlt; }
        const float var = wave_sum(s2) * (1.0f / 512.0f);
        if (lane == 0) { st[2 * j] = mu; st[2 * j + 1] = 1.0f / sqrtf(var + EPS); } }
    __syncthreads();
    for (int g = 0; g < 4; ++g) {
        {
            const int j = tid & 127, cq = tid >> 7; const float mu = st[2 * j], rs = st[2 * j + 1];
#pragma unroll
            for (int c8 = 0; c8 < 4; ++c8) { const int cc = 32 * cq + 8 * c8;
                float f[8]; unpack8(*(const u32x4*)(PJ + (row0 + j) * O_IN + 2048 + g * 128 + cc), f);
#pragma unroll
                for (int e = 0; e < 8; ++e) { const float y = (f[e] - mu) * rs * p.in[I_DLG][g * 128 + cc + e] + p.in[I_DLB][g * 128 + cc + e];
                    vT[(cc + e) * MD_PITCH + j] = (bf16)f2bf(y); } }
            const float* wsg = p.in[I_DSW] + (size_t)g * 128 * 128;
            for (int idx = tid; idx < 128 * 128; idx += NTHR) { const int ii = idx >> 7, jj = idx & 127; Wl[ii * MD_PITCH + jj] = (bf16)(jj <= ii ? f2bf(wsg[idx]) : 0u); }
        }
        __syncthreads();
        f32x4 acc[8];
#pragma unroll
        for (int nc = 0; nc < 8; ++nc) acc[nc] = (f32x4){0.f, 0.f, 0.f, 0.f};
#pragma unroll
        for (int ks = 0; ks < 4; ++ks) {
            const bf16x8 a = *(const LAS bf16x8*)(Wl + (16 * wave + fr) * MD_PITCH + 32 * ks + 8 * fq);
#pragma unroll
            for (int nc = 0; nc < 8; ++nc) { const bf16x8 bb = *(const LAS bf16x8*)(vT + (16 * nc + fr) * MD_PITCH + 32 * ks + 8 * fq);
                acc[nc] = __builtin_amdgcn_mfma_f32_16x16x32_bf16(a, bb, acc[nc], 0, 0, 0); }
        }
#pragma unroll
        for (int rg = 0; rg < 4; ++rg) { const int ii = 16 * wave + 4 * fq + rg; const float bsv = p.in[I_DSB][g * 128 + ii];
            const bf16* up = PJ + (row0 + ii) * O_IN + 1536 + g * 128; bf16* op = MIX + (row0 + ii) * D + 512 + g * 128;
#pragma unroll
            for (int nc = 0; nc < 8; ++nc) { const int c = 16 * nc + fr; op[c] = (bf16)f2bf(bf2f(up[c]) * (acc[nc][rg] + bsv)); } }
        __syncthreads();
    }
}
__device__ __forceinline__ void mixd_sample(const Params& p, LAS unsigned char* lds, int n) {
    int tid = threadIdx.x; asm volatile("" : "+v"(tid));
    const int lane = tid & 63, wave = tid >> 6;
    const bf16* PJ = (const bf16*)(p.ws + WS_PROJ);
    bf16* MIX = (bf16*)(p.ws + WS_MIX);
    LAS float* red = (LAS float*)lds;
    float x[4], v[4];
#pragma unroll
    for (int s = 0; s < 4; ++s) x[s] = bf2f(PJ[(size_t)(TP + 4 * n + s) * O_IN + 2048 + tid]);
    __syncthreads();
#pragma unroll
    for (int s = 0; s < 4; ++s) { const float t = wave_sum(x[s]); if (lane == 0) red[s * 8 + wave] = t; }
    __syncthreads();
    float mu[4];
#pragma unroll
    for (int s = 0; s < 4; ++s) { float t = 0.f;
#pragma unroll
        for (int w = 0; w < 8; ++w) t += red[s * 8 + w];
        mu[s] = t * (1.0f / 512.0f); }
    __syncthreads();
#pragma unroll
    for (int s = 0; s < 4; ++s) { const float dlt = x[s] - mu[s]; const float t = wave_sum(dlt * dlt); if (lane == 0) red[s * 8 + wave] = t; }
    __syncthreads();
    const float lg = p.in[I_DLG][tid], lb = p.in[I_DLB][tid];
#pragma unroll
    for (int s = 0; s < 4; ++s) { float t = 0.f;
#pragma unroll
        for (int w = 0; w < 8; ++w) t += red[s * 8 + w];
        v[s] = (x[s] - mu[s]) * (1.0f / sqrtf(t * (1.0f / 512.0f) + EPS)) * lg + lb;
        p.out[O_DV + ((size_t)n * 4 + s) * 512 + tid] = v[s]; }
    const int g = tid >> 7;
    const float* wsg = p.in[I_DSW] + (size_t)g * 128 * 128;
#pragma unroll
    for (int i = 0; i < 4; ++i) { float m = p.in[I_DSB][g * 128 + i];
#pragma unroll
        for (int j = 0; j <= i; ++j) m += wsg[i * 128 + j] * v[j];
        const float u = bf2f(PJ[(size_t)(TP + 4 * n + i) * O_IN + 1536 + tid]);
        MIX[(size_t)(TP + 4 * n + i) * D + 512 + tid] = (bf16)f2bf(u * m); }
    __syncthreads();
}
__device__ __forceinline__ void phase11(const Params& p, LAS unsigned char* lds) {
    constexpr int N_D = BATCH * 16, N_DS = DEC_BATCH;
    for (int it = blockIdx.x; it < N_D + N_DS; it += gridDim.x) {
        if (it < N_D) mixd_item(p, lds, it / 16, it % 16); else mixd_sample(p, lds, it - N_D);
    }
    mixc_rows(p);
}

template <bool COOP>
__global__ void __launch_bounds__(NTHR, 2) fwd_kernel(Params p) {
    extern __shared__ __attribute__((aligned(16))) unsigned char lds_raw[];
    LAS unsigned char* lds = (LAS unsigned char*)lds_raw;
    unsigned char* ws = p.ws;
    float* mod = (float*)(ws + WS_MOD);
    float* X = (float*)(ws + WS_X);
    bf16* H = (bf16*)(ws + WS_H); bf16* PROJ = (bf16*)(ws + WS_PROJ); bf16* MIX = (bf16*)(ws + WS_MIX); bf16* ACT = (bf16*)(ws + WS_ACT);
    const int lo = p.ph_lo, hi = p.ph_hi;
#define IN(k) (lo <= (k) && (k) < hi)
#define SEAM(k) do { if (COOP) { if ((k) + 1 < hi) cg::this_grid().sync(); } } while (0)
#define GEMM_PHASE(EpiT, Aptr, Wptr, Mrows, Ncols, Kdim, ...) do { pg8::Gemm g_{(const pg8::bf16_t*)(Aptr), (const pg8::bf16_t*)(Wptr), Mrows, Ncols, Kdim}; \
        pg8::StaticOrder S_; S_.init(Mrows, Ncols, (int)gridDim.x, (int)blockIdx.x); pg8::EpiT E_{__VA_ARGS__}; \
        pg8::gemm_phase<pg8::EpiT, pg8::StaticOrder, true, true>(lds, g_, S_, E_); } while (0)

    if (IN(0)) { phase0(p, lds); SEAM(0); }
    if (IN(1)) { norm_phase<false>(p.in[I_XP], p.in[I_XS], p.in[I_NMG], mod + 0 * D, mod + 1 * D, H, nullptr, nullptr); SEAM(1); }
    if (IN(2)) { GEMM_PHASE(EpiStoreBf16, H, ws + WS_WEIN, MP, E_IN, D, (pg8::bf16_t*)PROJ, E_IN, 1 << 30); SEAM(2); }
    if (IN(3)) { phase3(p, lds); SEAM(3); }
    if (IN(4)) { phase4(p); SEAM(4); }
    if (IN(5)) { GEMM_PHASE(EpiResid, MIX, ws + WS_WEOUT, MP, D, 512, p.in[I_XP], p.in[I_XS], X, mod + 2 * D); SEAM(5); }
    if (IN(6)) { norm_phase<false>(X, X + (size_t)TP * D, p.in[I_NFG], mod + 3 * D, mod + 4 * D, H, nullptr, nullptr); SEAM(6); }
    if (IN(7)) { GEMM_PHASE(EpiSwiGLU, H, ws + WS_WGU0, MP, 2 * FFN, D, (pg8::bf16_t*)ACT, FFN); SEAM(7); }
    if (IN(8)) { GEMM_PHASE(EpiResid, ACT, ws + WS_WDN0, MP, D, FFN, X, X + (size_t)TP * D, X, mod + 5 * D); SEAM(8); }
    const float* mod1 = mod + (size_t)NB * MODW;
    if (IN(9)) { norm_phase<false>(X, X + (size_t)TP * D, p.in[I_NMG] + D, mod1 + 0 * D, mod1 + 1 * D, H, nullptr, nullptr); SEAM(9); }
    if (IN(10)) { GEMM_PHASE(EpiStoreBf16, H, ws + WS_WOIN, MP, O_IN, D, (pg8::bf16_t*)PROJ, O_IN, 6); SEAM(10); }
    if (IN(11)) { phase11(p, lds); SEAM(11); }
    if (IN(12)) { GEMM_PHASE(EpiResid, MIX, ws + WS_WOOUT, MP, D, D, X, X + (size_t)TP * D, X, mod1 + 2 * D); SEAM(12); }
    if (IN(13)) { norm_phase<false>(X, X + (size_t)TP * D, p.in[I_NFG] + D, mod1 + 3 * D, mod1 + 4 * D, H, nullptr, nullptr); SEAM(13); }
    if (IN(14)) { GEMM_PHASE(EpiSwiGLU, H, ws + WS_WGU1, MP, 2 * FFN, D, (pg8::bf16_t*)ACT, FFN); SEAM(14); }
    if (IN(15)) { GEMM_PHASE(EpiResid, ACT, ws + WS_WDN1, MP, D, FFN, X, X + (size_t)TP * D, X, mod1 + 5 * D); SEAM(15); }
    if (IN(16)) { norm_phase<true>(X, X + (size_t)TP * D, p.in[I_FNG], nullptr, nullptr, nullptr, p.out + O_YP, p.out + O_YS); }
#undef IN
#undef SEAM
#undef GEMM_PHASE
}

#ifndef DBG_PH_HI
#define DBG_PH_HI NPHASE
#endif
#ifndef MK_MULTI
#define MK_MULTI 1
#endif
extern "C" void kernel_launch(void* const* d_in, const int* in_sizes, int n_in, void* d_out, int out_size, void* d_ws, size_t ws_size, hipStream_t stream) {
    static int grid = 0;
    if (grid == 0) {
        if (n_in != N_IN || out_size != (int)O_END || ws_size < WS_END) { fprintf(stderr, "kernel_launch: unexpected shapes: n_in %d out %d ws %zu (need %zu)\n", n_in, out_size, ws_size, (size_t)WS_END); grid = -1; return; }
        int dev = 0, cus = 0, per_cu = 0;
        if (hipGetDevice(&dev) != hipSuccess || hipDeviceGetAttribute(&cus, hipDeviceAttributeMultiprocessorCount, dev) != hipSuccess) { grid = -1; return; }
        hipFuncSetAttribute((const void*)fwd_kernel<true>, hipFuncAttributeMaxDynamicSharedMemorySize, LDS_BYTES);
        hipFuncSetAttribute((const void*)fwd_kernel<false>, hipFuncAttributeMaxDynamicSharedMemorySize, LDS_BYTES);
        if (hipOccupancyMaxActiveBlocksPerMultiprocessor(&per_cu, (const void*)fwd_kernel<true>, NTHR, LDS_BYTES) != hipSuccess || per_cu < 1) { fprintf(stderr, "kernel_launch: occupancy query says %d blocks per CU\n", per_cu); per_cu = 1; }
        (void)hipGetLastError();
        grid = cus;
    }
    if (grid < 0) return;
    Params prm{};
    for (int i = 0; i < N_IN; ++i) prm.in[i] = (const float*)d_in[i];
    prm.out = (float*)d_out; prm.ws = (unsigned char*)d_ws;
#if MK_MULTI
    for (int ph = 0; ph < DBG_PH_HI; ++ph) { prm.ph_lo = ph; prm.ph_hi = ph + 1;
        hipLaunchKernelGGL(fwd_kernel<false>, dim3(grid), dim3(NTHR), LDS_BYTES, stream, prm); }
#else
    prm.ph_lo = 0; prm.ph_hi = NPHASE;
    void* args[] = {&prm};
    hipError_t e = hipLaunchCooperativeKernel((const void*)fwd_kernel<true>, dim3(grid), dim3(NTHR), args, LDS_BYTES, stream);
    if (e != hipSuccess) fprintf(stderr, "cooperative launch failed: %s (grid %d)\n", hipGetErrorString(e), grid);
#endif
}
```

```cpp
#define MK_MULTI 0
#include <hip/hip_runtime.h>
#include <hip/hip_cooperative_groups.h>
#include <cstdio>
#include <cstdint>
namespace cg = cooperative_groups;

constexpr int D = 1024, BATCH = 8, SEQ = 2048, DEC_BATCH = 32, DEC_SEQ = 4, NB = BATCH + DEC_BATCH;
constexpr int TP = BATCH * SEQ;
constexpr int TS = DEC_BATCH * DEC_SEQ;
constexpr int MR = TP + TS;
constexpr int MP = 16640;
constexpr int E_IN = 2816, O_IN = 2560, FFN = 2816, MODW = 6 * D;
constexpr float EPS = 1e-6f;
namespace pg8 {
#define PG8_LAS __attribute__((address_space(3)))
typedef unsigned short bf16_t;
typedef short bf16x8 __attribute__((ext_vector_type(8)));
typedef float f32x4 __attribute__((ext_vector_type(4)));
typedef unsigned u32x4 __attribute__((ext_vector_type(4)));
constexpr int BM = 256, BK = 64, HALF = 128, HTB = HALF * BK * 2  , STAGE_BYTES = 8 * HTB, NXCD = 8, WGM = 8;

__host__ __device__ __forceinline__ int lds_byte(int r, int c) { const int st = (r >> 4) * 2 + (c >> 5), rr = r & 15, cc = c & 31, ob = rr * 64 + cc * 2; return st * 1024 + (ob ^ (((ob >> 9) & 1) << 5)); }
__host__ __device__ __forceinline__ void stage_rc(int b, int& R, int& C) { const int st = b / 1024, sb = b % 1024, swz = sb ^ (((sb >> 9) & 1) << 5); R = (st >> 1) * 16 + swz / 64; C = (st & 1) * 32 + (swz % 64) / 2; }
__host__ __device__ __forceinline__ int perm32(int rho) { const int n = rho >> 4, i = rho & 15; return 8 * (i >> 2) + 4 * n + (i & 3); }

struct Unit { int pm, pn; };
struct Gemm { const bf16_t* A; const bf16_t* Bt; int M, N, K; };

struct StaticOrder {
    int nM, nN, nwg, G, c;
    __host__ __device__ void init(int M, int N, int G_, int c_) { nM = M / BM; nN = N / BM; nwg = nM * nN; G = G_; c = c_; }
    __host__ __device__ bool next(int i, Unit& u) const {
        const long L = (long)i * G + c; if (L >= nwg) return false;
        int wgid = (int)L; { const int q = nwg / NXCD, r = nwg % NXCD, xcd = wgid % NXCD, off = wgid / NXCD; wgid = (xcd < r ? xcd * (q + 1) : r * (q + 1) + (xcd - r) * q) + off; }
        const int nig = WGM * nN, gid = wgid / nig, fm = gid * WGM, gsz = (nM - fm) < WGM ? (nM - fm) : WGM;
        u.pm = fm + ((wgid % nig) % gsz); u.pn = (wgid % nig) / gsz; return true;
    }
    __device__ __forceinline__ void a_ready(const Unit&) const {}
    __device__ __forceinline__ void done(const Unit&) const {}
};

__device__ __forceinline__ unsigned cvt_pk_bf16(float lo, float hi) { unsigned r; asm volatile("v_cvt_pk_bf16_f32 %0, %1, %2" : "=v"(r) : "v"(lo), "v"(hi)); return r; }
typedef float f32x2 __attribute__((ext_vector_type(2)));
__device__ __forceinline__ f32x2 gelu_pk(f32x2 v) {
    const f32x2 av = __builtin_elementwise_abs(v), d = av * 0.2316418882f + 1.0f;
    f32x2 t; t.x = __builtin_amdgcn_rcpf(d.x); t.y = __builtin_amdgcn_rcpf(d.y);
    f32x2 q = t * 0.5307027145f + (-0.7265760135f); q = q * t + 0.7107068705f; q = q * t + (-0.142248368f); q = q * t + 0.127414796f; q = q * t;
    const f32x2 s = (v * v) * (-0.72134752044f);
    f32x2 e; e.x = __builtin_amdgcn_exp2f(s.x); e.y = __builtin_amdgcn_exp2f(s.y);
    const f32x2 m = v * (q * e), r = v - m;
    f32x2 o; o.x = v.x < 0.f ? m.x : r.x; o.y = v.y < 0.f ? m.y : r.y; return o;
}

template <int ACT  > struct EpiBf16 {
    static constexpr bool PERM = true, AFTER_DRAIN = false; static_assert(ACT == 0 || ACT == 1, "EpiBf16: ACT is 0 (none) or 1 (gelu_pk)");
    bf16_t* O; int ldc; const float* bias; int split_cols; size_t split_stride; float scale0;
    __device__ __forceinline__ void operator()(const f32x4 (&acc)[2][2][4][2], const Unit& u, int wr, int wc, int fr, int fq) const {
        const int row0 = u.pm * BM + wr * 64 + fr; int colt = u.pn * BM; bf16_t* base = O;
        float sc = 1.f; if (split_cols) { const int t = colt / split_cols; base += (size_t)t * split_stride; colt -= t * split_cols; if (t == 0) sc = scale0; }
        const int col0 = colt + wc * 32 + 8 * fq, bcol0 = u.pn * BM + wc * 32 + 8 * fq;
        f32x4 bv[2][2];
#pragma unroll
        for (int bj = 0; bj < 2; ++bj)
#pragma unroll
            for (int n = 0; n < 2; ++n) bv[bj][n] = bias ? *(const f32x4*)(bias + bcol0 + bj * HALF + 4 * n) : (f32x4){0.f, 0.f, 0.f, 0.f};
#pragma unroll
        for (int ai = 0; ai < 2; ++ai)
#pragma unroll
            for (int m = 0; m < 4; ++m) { bf16_t* rowp = base + (size_t)(row0 + ai * HALF + m * 16) * ldc + col0;
#pragma unroll
                for (int bj = 0; bj < 2; ++bj) { f32x4 v0 = acc[ai][bj][m][0] + bv[bj][0], v1 = acc[ai][bj][m][1] + bv[bj][1];
                    if (ACT == 1) { f32x2 a = gelu_pk((f32x2){v0[0], v0[1]}), b = gelu_pk((f32x2){v0[2], v0[3]}), c = gelu_pk((f32x2){v1[0], v1[1]}), d = gelu_pk((f32x2){v1[2], v1[3]});
                        v0 = (f32x4){a.x, a.y, b.x, b.y}; v1 = (f32x4){c.x, c.y, d.x, d.y}; }
                    v0 = v0 * sc; v1 = v1 * sc; u32x4 w; w.x = cvt_pk_bf16(v0[0], v0[1]); w.y = cvt_pk_bf16(v0[2], v0[3]); w.z = cvt_pk_bf16(v1[0], v1[1]); w.w = cvt_pk_bf16(v1[2], v1[3]);
                    *(u32x4*)(rowp + bj * HALF) = w; } }
    }
};

__device__ __forceinline__ float gelu_tanh_f(float x) {
    const float y = 1.5957691216057308f * (x + 0.044715f * x * x * x);
    return x * __builtin_amdgcn_rcpf(1.0f + __builtin_amdgcn_exp2f(-1.4426950408889634f * y));
}
__device__ __forceinline__ float silu_f(float x) { return x * __builtin_amdgcn_rcpf(1.0f + __builtin_amdgcn_exp2f(-1.4426950408889634f * x)); }

struct EpiStoreBf16 {
    static constexpr bool PERM = true, AFTER_DRAIN = false;
    bf16_t* O; int ldc; int gelu_from;
    __device__ __forceinline__ void operator()(const f32x4 (&acc)[2][2][4][2], const Unit& u, int wr, int wc, int fr, int fq) const {
        const int row0 = u.pm * BM + wr * 64 + fr, col0 = u.pn * BM + wc * 32 + 8 * fq;
        const bool g = u.pn >= gelu_from;
#pragma unroll
        for (int ai = 0; ai < 2; ++ai)
#pragma unroll
            for (int m = 0; m < 4; ++m) { bf16_t* rowp = O + (size_t)(row0 + ai * HALF + m * 16) * ldc + col0;
#pragma unroll
                for (int bj = 0; bj < 2; ++bj) { f32x4 v0 = acc[ai][bj][m][0], v1 = acc[ai][bj][m][1];
                    if (g) {
#pragma unroll
                        for (int j = 0; j < 4; ++j) { v0[j] = gelu_tanh_f(v0[j]); v1[j] = gelu_tanh_f(v1[j]); } }
                    u32x4 w; w.x = cvt_pk_bf16(v0[0], v0[1]); w.y = cvt_pk_bf16(v0[2], v0[3]); w.z = cvt_pk_bf16(v1[0], v1[1]); w.w = cvt_pk_bf16(v1[2], v1[3]);
                    *(u32x4*)(rowp + bj * HALF) = w; } }
    }
};
struct EpiSwiGLU {
    static constexpr bool PERM = true, AFTER_DRAIN = false;
    bf16_t* O; int ldc;
    __device__ __forceinline__ void operator()(const f32x4 (&acc)[2][2][4][2], const Unit& u, int wr, int wc, int fr, int fq) const {
        const int row0 = u.pm * BM + wr * 64 + fr, col0 = (u.pn * BM + wc * 32 + 8 * fq) >> 1;
#pragma unroll
        for (int ai = 0; ai < 2; ++ai)
#pragma unroll
            for (int m = 0; m < 4; ++m) { bf16_t* rowp = O + (size_t)(row0 + ai * HALF + m * 16) * ldc + col0;
#pragma unroll
                for (int bj = 0; bj < 2; ++bj) { const f32x4 v0 = acc[ai][bj][m][0], v1 = acc[ai][bj][m][1];
                    const float a0 = silu_f(v0[0]) * v0[1], a1 = silu_f(v0[2]) * v0[3], a2 = silu_f(v1[0]) * v1[1], a3 = silu_f(v1[2]) * v1[3];
                    typedef unsigned u32x2 __attribute__((ext_vector_type(2)));
                    u32x2 w; w.x = cvt_pk_bf16(a0, a1); w.y = cvt_pk_bf16(a2, a3);
                    *(u32x2*)(rowp + bj * (HALF / 2)) = w; } }
    }
};
struct EpiResid {
    static constexpr bool PERM = false, AFTER_DRAIN = false;
    const float* xin_p; const float* xin_s; float* xout; const float* gate;
    __device__ __forceinline__ void operator()(const f32x4 (&acc)[2][2][4][2], const Unit& u, int wr, int wc, int fr, int fq) const {
        const int row0 = u.pm * BM + wr * 64 + fr, col0 = u.pn * BM + wc * 32 + 4 * fq;
#pragma unroll
        for (int ai = 0; ai < 2; ++ai)
#pragma unroll
            for (int m = 0; m < 4; ++m) { const int row = row0 + ai * HALF + m * 16;
                if (row < MR) {
                    const int nb = row < TP ? (row >> 11) : BATCH + ((row - TP) >> 2);
                    const float* gp = gate + (size_t)nb * MODW + col0;
                    const float* xi = (row < TP ? xin_p + (size_t)row * D : xin_s + (size_t)(row - TP) * D) + col0;
                    float* xo = xout + (size_t)row * D + col0;
#pragma unroll
                    for (int bj = 0; bj < 2; ++bj)
#pragma unroll
                        for (int n = 0; n < 2; ++n) { const int off = bj * HALF + n * 16;
                            const f32x4 gv = *(const f32x4*)(gp + off), xv = *(const f32x4*)(xi + off);
                            *(f32x4*)(xo + off) = xv + gv * acc[ai][bj][m][n]; } } }
    }
};
template <class Epi, class Sched, bool ALIGN_EPI = false, bool SP2 = false>
__device__ __forceinline__ void gemm_phase(PG8_LAS unsigned char* lds, const Gemm g, const Sched& S, const Epi& E) {
    const int tid = threadIdx.x, wid = __builtin_amdgcn_readfirstlane(tid >> 6), lane = tid & 63, wr = wid >> 2, wc = wid & 3, fr = lane & 15, fq = lane >> 4;
    const int K = g.K, nt = K / BK;
    unsigned voffA[2], voffB[2];
#pragma unroll
    for (int i = 0; i < 2; ++i) { int R, C; stage_rc(tid * 16 + i * 8192, R, C); const int Rb = Epi::PERM ? ((R & ~31) + perm32(R & 31)) : R;
        voffA[i] = (unsigned)(R * K + C) * 2u; voffB[i] = (unsigned)(Rb * K + C) * 2u; }
    const size_t kstep = (size_t)(BK * 2);
    const size_t hstep = (size_t)HALF * K * 2;
    const size_t tstep = 2 * hstep;
    const unsigned ldsw = (unsigned)wid * 1024u;
    const int aoff = lds_byte(wr * 64 + fr, fq * 8), boff = lds_byte(wc * 32 + fr, fq * 8);
#define PG8_SA(b, h) (((b) * 2 + (h)) * HTB)
#define PG8_SB(b, h) ((4 + (b) * 2 + (h)) * HTB)
#define PG8_STAGE(bufoff, gbase, voff) do { _Pragma("unroll") for (int _i = 0; _i < 2; ++_i) \
        __builtin_amdgcn_global_load_lds((const unsigned*)((const char*)(gbase) + (voff)[_i]), (PG8_LAS unsigned*)(lds + (bufoff) + ldsw + _i * 8192), 16, 0, 0); } while (0)
#define PG8_LDA(dst, b, h) do { _Pragma("unroll") for (int m = 0; m < 4; ++m) _Pragma("unroll") for (int k = 0; k < 2; ++k) dst[m][k] = *(const PG8_LAS bf16x8*)(lds + PG8_SA(b, h) + aoff + m * 2048 + k * 1024); } while (0)
#define PG8_LDB(dst, b, h) do { _Pragma("unroll") for (int n = 0; n < 2; ++n) _Pragma("unroll") for (int k = 0; k < 2; ++k) dst[n][k] = *(const PG8_LAS bf16x8*)(lds + PG8_SB(b, h) + boff + n * 2048 + k * 1024); } while (0)
#define PG8_MMA(ai, bj, At, Bt) do { __builtin_amdgcn_s_setprio(1); _Pragma("unroll") for (int m = 0; m < 4; ++m) _Pragma("unroll") for (int n = 0; n < 2; ++n) _Pragma("unroll") for (int k = 0; k < 2; ++k) \
        acc[ai][bj][m][n] = __builtin_amdgcn_mfma_f32_16x16x32_bf16(Bt[n][k], At[m][k], acc[ai][bj][m][n], 0, 0, 0); __builtin_amdgcn_s_setprio(0); } while (0)
#define PG8_WAIT_V(n) asm volatile("s_waitcnt vmcnt(" #n ")" ::: "memory")
#define PG8_WAIT_L(n) asm volatile("s_waitcnt lgkmcnt(" #n ")" ::: "memory")
#define PG8_BAR __builtin_amdgcn_s_barrier()
#define PG8_SCHED __builtin_amdgcn_sched_barrier(0)
    Unit cur, nxt; int ui = 0;
    if (!S.next(0, cur)) return;
    f32x4 acc[2][2][4][2];
#pragma unroll
    for (int a = 0; a < 2; ++a)
#pragma unroll
        for (int b = 0; b < 2; ++b)
#pragma unroll
            for (int m = 0; m < 4; ++m)
#pragma unroll
                for (int n = 0; n < 2; ++n) acc[a][b][m][n] = (f32x4){0.f, 0.f, 0.f, 0.f};
    bf16x8 At[4][2], B0[2][2], B1[2][2];
    const char* cA = (const char*)g.A + (size_t)cur.pm * tstep; const char* cB = (const char*)g.Bt + (size_t)cur.pn * tstep;
    S.a_ready(cur);
    if constexpr (SP2) {
        PG8_STAGE(PG8_SB(0, 0), cB, voffB); PG8_STAGE(PG8_SB(0, 1), cB + hstep, voffB); PG8_STAGE(PG8_SA(0, 0), cA, voffA); PG8_STAGE(PG8_SA(0, 1), cA + hstep, voffA);
        if (wr == 1) PG8_BAR;
        PG8_WAIT_V(2); PG8_BAR;
        PG8_STAGE(PG8_SB(1, 0), cB + kstep, voffB); PG8_STAGE(PG8_SA(1, 0), cA + kstep, voffA); PG8_STAGE(PG8_SB(1, 1), cB + hstep + kstep, voffB);
        PG8_WAIT_V(6); PG8_BAR;
    } else {
        PG8_STAGE(PG8_SB(0, 0), cB, voffB); PG8_STAGE(PG8_SA(0, 0), cA, voffA); PG8_STAGE(PG8_SB(0, 1), cB + hstep, voffB); PG8_STAGE(PG8_SA(0, 1), cA + hstep, voffA);
        if (wr == 1) PG8_BAR;
        PG8_WAIT_V(4); PG8_BAR;
        PG8_STAGE(PG8_SB(1, 0), cB + kstep, voffB); PG8_STAGE(PG8_SA(1, 0), cA + kstep, voffA); PG8_STAGE(PG8_SB(1, 1), cB + hstep + kstep, voffB);
        PG8_WAIT_V(6); PG8_BAR;
    }
    for (;;) {
        const bool has_next = S.next(ui + 1, nxt);
        const char* nA = has_next ? (const char*)g.A + (size_t)nxt.pm * tstep : cA; const char* nB = has_next ? (const char*)g.Bt + (size_t)nxt.pn * tstep : cB;
        for (int t = 0; t < nt; t += 2) {
            const bool last = (t == nt - 2);
            const char* a1 = cA + (size_t)(t + 1) * kstep;
            const char* a2 = last ? nA : cA + (size_t)(t + 2) * kstep; const char* b2 = last ? nB : cB + (size_t)(t + 2) * kstep;
            const char* a3 = a2 + kstep; const char* b3 = b2 + kstep;
            if (last && has_next) S.a_ready(nxt);
            if constexpr (SP2) {
            PG8_LDB(B0, 0, 0); PG8_LDB(B1, 0, 1); PG8_SCHED; PG8_LDA(At, 0, 0); PG8_STAGE(PG8_SA(1, 1), a1 + hstep, voffA);
            PG8_WAIT_V(8); PG8_WAIT_L(0); PG8_BAR; PG8_MMA(0, 0, At, B0); PG8_MMA(0, 1, At, B1); PG8_BAR; PG8_SCHED;
            PG8_LDA(At, 0, 1); PG8_STAGE(PG8_SB(0, 0), b2, voffB); PG8_STAGE(PG8_SB(0, 1), b2 + hstep, voffB); PG8_STAGE(PG8_SA(0, 0), a2, voffA);
            PG8_WAIT_V(8); PG8_WAIT_L(0); PG8_BAR; PG8_MMA(1, 0, At, B0); PG8_MMA(1, 1, At, B1); PG8_BAR; PG8_SCHED;
            PG8_LDB(B0, 1, 0); PG8_LDB(B1, 1, 1); PG8_SCHED; PG8_LDA(At, 1, 0); PG8_STAGE(PG8_SA(0, 1), a2 + hstep, voffA);
            PG8_WAIT_V(8); PG8_WAIT_L(0); PG8_BAR; PG8_MMA(0, 0, At, B0); PG8_MMA(0, 1, At, B1); PG8_BAR; PG8_SCHED;
            PG8_LDA(At, 1, 1); PG8_STAGE(PG8_SB(1, 0), b3, voffB); PG8_STAGE(PG8_SB(1, 1), b3 + hstep, voffB); PG8_STAGE(PG8_SA(1, 0), a3, voffA);
            PG8_WAIT_V(8); PG8_WAIT_L(0); PG8_BAR; PG8_MMA(1, 0, At, B0); PG8_MMA(1, 1, At, B1); PG8_BAR; PG8_SCHED;
            } else {
            PG8_LDB(B0, 0, 0); PG8_SCHED; PG8_LDA(At, 0, 0); PG8_STAGE(PG8_SA(1, 1), a1 + hstep, voffA);
            PG8_WAIT_L(8); PG8_BAR; PG8_WAIT_L(0); PG8_MMA(0, 0, At, B0); PG8_BAR; PG8_SCHED;
            PG8_LDB(B1, 0, 1); PG8_STAGE(PG8_SB(0, 0), b2, voffB);
            PG8_BAR; PG8_WAIT_L(0); PG8_MMA(0, 1, At, B1); PG8_BAR;
            PG8_LDA(At, 0, 1); PG8_STAGE(PG8_SA(0, 0), a2, voffA);
            PG8_BAR; PG8_WAIT_L(0); PG8_MMA(1, 0, At, B0); PG8_BAR; PG8_SCHED;
            PG8_STAGE(PG8_SB(0, 1), b2 + hstep, voffB);
            PG8_WAIT_V(6); PG8_BAR; PG8_MMA(1, 1, At, B1); PG8_BAR;
            PG8_LDB(B0, 1, 0); PG8_SCHED; PG8_LDA(At, 1, 0); PG8_STAGE(PG8_SA(0, 1), a2 + hstep, voffA);
            PG8_WAIT_L(8); PG8_BAR; PG8_WAIT_L(0); PG8_MMA(0, 0, At, B0); PG8_BAR; PG8_SCHED;
            PG8_LDB(B1, 1, 1); PG8_STAGE(PG8_SB(1, 0), b3, voffB);
            PG8_BAR; PG8_WAIT_L(0); PG8_MMA(0, 1, At, B1); PG8_BAR;
            PG8_LDA(At, 1, 1); PG8_STAGE(PG8_SA(1, 0), a3, voffA);
            PG8_BAR; PG8_WAIT_L(0); PG8_MMA(1, 0, At, B0); PG8_BAR; PG8_SCHED;
            PG8_STAGE(PG8_SB(1, 1), b3 + hstep, voffB);
            PG8_WAIT_V(6); PG8_BAR; PG8_MMA(1, 1, At, B1); PG8_BAR;
            }
        }
        if constexpr (ALIGN_EPI) { if (wr == 0) PG8_BAR; }
        if constexpr (!Epi::AFTER_DRAIN) { E(acc, cur, wr, wc, fr, fq); S.done(cur); }
        if (!has_next) break;
#pragma unroll
        for (int a = 0; a < 2; ++a)
#pragma unroll
            for (int b = 0; b < 2; ++b)
#pragma unroll
                for (int m = 0; m < 4; ++m)
#pragma unroll
                    for (int n = 0; n < 2; ++n) acc[a][b][m][n] = (f32x4){0.f, 0.f, 0.f, 0.f};
        cur = nxt; cA = nA; cB = nB; ++ui;
        if constexpr (ALIGN_EPI) { if (wr == 1) PG8_BAR; }
    }
    PG8_WAIT_V(0);
    if constexpr (!ALIGN_EPI) { if (wr == 0) PG8_BAR; }
    PG8_BAR;
    if constexpr (Epi::AFTER_DRAIN) { E.fused(acc, cur, wr, wc, fr, fq, lds, wid, lane); S.done(cur); }
#undef PG8_SA
#undef PG8_SB
#undef PG8_STAGE
#undef PG8_LDA
#undef PG8_LDB
#undef PG8_MMA
#undef PG8_WAIT_V
#undef PG8_WAIT_L
#undef PG8_BAR
#undef PG8_SCHED
}
}

#define GAS __attribute__((address_space(1)))
#define LAS __attribute__((address_space(3)))
typedef unsigned short bf16;
typedef float f32x4 __attribute__((ext_vector_type(4)));
typedef short bf16x8 __attribute__((ext_vector_type(8)));
typedef unsigned u32x4 __attribute__((ext_vector_type(4)));
typedef unsigned u32x2 __attribute__((ext_vector_type(2)));

constexpr int NWAVES = 8, NTHR = 512;
constexpr int LDS_BYTES = 147456;
constexpr int NPHASE = 17;
constexpr int LDSCTL_OFF = 131072;
constexpr int CW_BAR = 4096;
constexpr size_t CTL_ZERO_BYTES = 65536;

enum { I_XP = 0, I_XS, I_CP, I_CS, I_SA, I_KV0, I_KV1, I_KV2, I_SC, I_RB, I_ADAW, I_ADAB, I_NMG, I_NFG, I_WGU, I_WDN, I_FNG, I_EWIN, I_ACW, I_ACB,
       I_ALG, I_ALB, I_EWOUT, I_OWIN, I_CCW, I_CCB, I_DLG, I_DLB, I_DSW, I_DSB, I_OWOUT, N_IN };
constexpr size_t O_YP = 0, O_YS = O_YP + (size_t)TP * D, O_AP = O_YS + (size_t)TS * D, O_AS = O_AP + (size_t)BATCH * 30 * 256,
    O_KV0P = O_AS + (size_t)DEC_BATCH * 30 * 256, O_KV0S = O_KV0P + (size_t)BATCH * 128 * 512, O_KV1P = O_KV0S + (size_t)DEC_BATCH * 128 * 512,
    O_KV1S = O_KV1P + (size_t)BATCH * 512 * 512, O_KV2P = O_KV1S + (size_t)DEC_BATCH * 512 * 512, O_KV2S = O_KV2P + (size_t)BATCH * 2048 * 512,
    O_CP = O_KV2S + (size_t)DEC_BATCH * 2048 * 512, O_CS = O_CP + (size_t)BATCH * 2 * 512, O_DV = O_CS + (size_t)DEC_BATCH * 2 * 512,
    O_END = O_DV + (size_t)DEC_BATCH * 4 * 512;
static_assert(O_END == 72372224, "output size");
constexpr size_t al256(size_t x) { return (x + 255) & ~(size_t)255; }
constexpr size_t WS_CTL = 0, WS_CTL_BYTES = 1u << 20;
constexpr size_t WS_WEIN = WS_CTL + WS_CTL_BYTES;
constexpr size_t WS_WEOUT = WS_WEIN + (size_t)E_IN * D * 2;
constexpr size_t WS_WGU0 = WS_WEOUT + (size_t)D * 512 * 2;
constexpr size_t WS_WGU1 = WS_WGU0 + (size_t)2 * FFN * D * 2;
constexpr size_t WS_WDN0 = WS_WGU1 + (size_t)2 * FFN * D * 2;
constexpr size_t WS_WDN1 = WS_WDN0 + (size_t)D * FFN * 2;
constexpr size_t WS_WOIN = WS_WDN1 + (size_t)D * FFN * 2;
constexpr size_t WS_WOOUT = WS_WOIN + (size_t)O_IN * D * 2;
constexpr size_t WS_MOD = WS_WOOUT + (size_t)D * D * 2;
constexpr size_t WS_X = al256(WS_MOD + (size_t)2 * NB * MODW * 4);
constexpr size_t WS_H = WS_X + (size_t)MP * D * 4;
constexpr size_t WS_PROJ = WS_H + (size_t)MP * D * 2;
constexpr size_t WS_MIX = WS_PROJ + (size_t)MP * E_IN * 2;
constexpr size_t WS_ACT = WS_MIX + (size_t)MP * D * 2;
constexpr size_t WS_OG = WS_ACT + (size_t)MP * FFN * 2;
constexpr size_t WS_LSE = WS_OG + (size_t)3 * MR * 256 * 4;
constexpr size_t WS_END = al256(WS_LSE + (size_t)3 * MR * 4 * 4);

struct Params { const float* in[N_IN]; float* out; unsigned char* ws; int ph_lo, ph_hi; };
static_assert(sizeof(Params) == 8 * N_IN + 8 + 8 + 8, "Params has no padding");

__device__ const unsigned char BUCKET[3][132] = {
 {0,1,2,3,4,5,6,7,8,9,10,11,12,13,14,15,16,16,16,16,16,16,17,17,17,17,17,17,17,17,18,18,18,18,18,18,18,18,18,18,19,19,19,19,19,19,19,19,19,19,19,19,19,19,20,20,20,20,20,20,20,20,20,20,20,20,20,20,20,20,20,20,20,21,21,21,21,21,21,21,21,21,21,21,21,21,21,21,21,21,21,21,21,21,21,21,21,21,21,22,22,22,22,22,22,22,22,22,22,22,22,22,22,22,22,22,22,22,22,22,22,22,22,22,22,22,22,22,22,0,0,0},
 {0,4,8,12,16,16,17,17,18,18,19,19,19,19,20,20,20,20,20,21,21,21,21,21,21,22,22,22,22,22,22,22,22,22,23,23,23,23,23,23,23,23,23,23,23,23,24,24,24,24,24,24,24,24,24,24,24,24,24,24,24,24,25,25,25,25,25,25,25,25,25,25,25,25,25,25,25,25,25,25,25,25,25,26,26,26,26,26,26,26,26,26,26,26,26,26,26,26,26,26,26,26,26,26,26,26,26,26,26,26,26,26,26,27,27,27,27,27,27,27,27,27,27,27,27,27,27,27,27,0,0,0},
 {0,16,18,19,20,21,21,22,22,23,23,23,24,24,24,24,25,25,25,25,25,26,26,26,26,26,26,26,26,27,27,27,27,27,27,27,27,27,27,28,28,28,28,28,28,28,28,28,28,28,28,28,29,29,29,29,29,29,29,29,29,29,29,29,29,29,29,29,29,29,30,30,30,30,30,30,30,30,30,30,30,30,30,30,30,30,30,30,30,30,30,30,30,30,30,31,31,31,31,31,31,31,31,31,31,31,31,31,31,31,31,31,31,31,31,31,31,31,31,31,31,31,31,31,31,31,31,31,31,0,0,0}};

__device__ __forceinline__ float bf2f(unsigned b) { return __uint_as_float(b << 16); }
__device__ __forceinline__ unsigned f2bf(float f) { unsigned u = __float_as_uint(f); return (u + 0x7fffu + ((u >> 16) & 1u)) >> 16; }
__device__ __forceinline__ unsigned pk2(float lo, float hi) { return f2bf(lo) | (f2bf(hi) << 16); }
__device__ __forceinline__ float wave_sum(float v) {
#pragma unroll
    for (int o = 1; o < 64; o <<= 1) v += __shfl_xor(v, o);
    return v;
}
__device__ __forceinline__ float wave_max(float v) {
#pragma unroll
    for (int o = 1; o < 64; o <<= 1) v = fmaxf(v, __shfl_xor(v, o));
    return v;
}
__device__ __forceinline__ void unpack8(const u32x4 w, float (&f)[8]) {
    f[0] = bf2f(w.x & 0xffffu); f[1] = bf2f(w.x >> 16); f[2] = bf2f(w.y & 0xffffu); f[3] = bf2f(w.y >> 16);
    f[4] = bf2f(w.z & 0xffffu); f[5] = bf2f(w.z >> 16); f[6] = bf2f(w.w & 0xffffu); f[7] = bf2f(w.w >> 16);
}
__device__ __forceinline__ int batch_of(int row) { return row < TP ? (row >> 11) : BATCH + ((row - TP) >> 2); }
#define LDS_WAIT() asm volatile("s_waitcnt lgkmcnt(0)" ::: "memory")

__device__ __forceinline__ void transpose_item(const float* W, int K, int N, bf16* WT, bool ilv, LAS float* scr, int item, int lane) {
    const int nblk = N / 32, kb = item / nblk, nb = item % nblk, k0 = 64 * kb, n0 = 32 * nb;
#pragma unroll 8
    for (int i = 0; i < 32; ++i) { const int kk = 2 * i + (lane >> 5); scr[kk * 33 + (lane & 31)] = W[(size_t)(k0 + kk) * N + n0 + (lane & 31)]; }
    LDS_WAIT();
    const int c = lane & 7;
#pragma unroll
    for (int j = 0; j < 4; ++j) { const int n = (lane >> 3) + 8 * j; const LAS float* s = scr + (8 * c) * 33 + n;
        u32x4 o; o.x = pk2(s[0 * 33], s[1 * 33]); o.y = pk2(s[2 * 33], s[3 * 33]); o.z = pk2(s[4 * 33], s[5 * 33]); o.w = pk2(s[6 * 33], s[7 * 33]);
        const int col = n0 + n; const int orow = ilv ? (col < FFN ? 2 * col : 2 * (col - FFN) + 1) : col;
        *(u32x4*)(WT + (size_t)orow * K + k0 + 8 * c) = o; }
    LDS_WAIT();
}

__device__ __forceinline__ void adaln_item(const Params& p, LAS unsigned char* lds, int it) {
    int tid = threadIdx.x; asm volatile("" : "+v"(tid));
    const int lane = tid & 63, wave = tid >> 6;
    const int l = it / 96, j0 = (it % 96) * 64;
    LAS float* s = (LAS float*)lds;
    const float* cp = p.in[I_CP]; const float* cs = p.in[I_CS];
    float* mod = (float*)(p.ws + WS_MOD);
    float acc[NB];
#pragma unroll
    for (int n = 0; n < NB; ++n) acc[n] = 0.f;
    for (int kh = 0; kh < 2; ++kh) {
        __syncthreads();
        for (int idx = tid; idx < NB * 512; idx += NTHR) { const int n = idx >> 9, k = idx & 511;
            const float c = n < BATCH ? cp[n * D + kh * 512 + k] : cs[(n - BATCH) * D + kh * 512 + k];
            s[idx] = c / (1.0f + expf(-c)); }
        __syncthreads();
        const float* wp = p.in[I_ADAW] + ((size_t)l * D + kh * 512 + wave * 64) * MODW + j0 + lane;
#pragma unroll 2
        for (int k4 = 0; k4 < 16; ++k4) {
            const float w0 = wp[(size_t)(4 * k4 + 0) * MODW], w1 = wp[(size_t)(4 * k4 + 1) * MODW], w2 = wp[(size_t)(4 * k4 + 2) * MODW], w3 = wp[(size_t)(4 * k4 + 3) * MODW];
#pragma unroll
            for (int n = 0; n < NB; ++n) { const f32x4 sv = *(const LAS f32x4*)(s + n * 512 + wave * 64 + 4 * k4);
                acc[n] += sv.x * w0 + sv.y * w1 + sv.z * w2 + sv.w * w3; }
        }
    }
    __syncthreads();
    LAS float* red = (LAS float*)lds;
#pragma unroll
    for (int n = 0; n < NB; ++n) red[(wave * NB + n) * 64 + lane] = acc[n];
    __syncthreads();
    for (int idx = tid; idx < NB * 64; idx += NTHR) { const int n = idx >> 6, j = idx & 63; float t = 0.f;
#pragma unroll
        for (int w = 0; w < NWAVES; ++w) t += red[(w * NB + n) * 64 + j];
        mod[((size_t)l * NB + n) * MODW + j0 + j] = t + p.in[I_ADAB][l * MODW + j0 + j]; }
    __syncthreads();
}

__device__ __forceinline__ void phase0(const Params& p, LAS unsigned char* lds) {
    const int tid = threadIdx.x, lane = tid & 63, wave = tid >> 6;
    for (int it = blockIdx.x; it < 192; it += gridDim.x) adaln_item(p, lds, it);
    __syncthreads();
    {
        LAS float* scr = (LAS float*)(lds + wave * 16384);
        const int gw = blockIdx.x * NWAVES + wave, NGW = gridDim.x * NWAVES;
        constexpr int I0 = (D / 64) * (E_IN / 32), I1 = (512 / 64) * (D / 32), I2 = (D / 64) * (2 * FFN / 32), I3 = (FFN / 64) * (D / 32), I4 = (D / 64) * (O_IN / 32), I5 = (D / 64) * (D / 32);
        constexpr int NIT = I0 + I1 + 2 * I2 + 2 * I3 + I4 + I5;
        for (int it = gw; it < NIT; it += NGW) {
            int r = it;
            if (r < I0) { transpose_item(p.in[I_EWIN], D, E_IN, (bf16*)(p.ws + WS_WEIN), false, scr, r, lane); continue; } r -= I0;
            if (r < I1) { transpose_item(p.in[I_EWOUT], 512, D, (bf16*)(p.ws + WS_WEOUT), false, scr, r, lane); continue; } r -= I1;
            if (r < I2) { transpose_item(p.in[I_WGU], D, 2 * FFN, (bf16*)(p.ws + WS_WGU0), true, scr, r, lane); continue; } r -= I2;
            if (r < I2) { transpose_item(p.in[I_WGU] + (size_t)D * 2 * FFN, D, 2 * FFN, (bf16*)(p.ws + WS_WGU1), true, scr, r, lane); continue; } r -= I2;
            if (r < I3) { transpose_item(p.in[I_WDN], FFN, D, (bf16*)(p.ws + WS_WDN0), false, scr, r, lane); continue; } r -= I3;
            if (r < I3) { transpose_item(p.in[I_WDN] + (size_t)FFN * D, FFN, D, (bf16*)(p.ws + WS_WDN1), false, scr, r, lane); continue; } r -= I3;
            if (r < I4) { transpose_item(p.in[I_OWIN], D, O_IN, (bf16*)(p.ws + WS_WOIN), false, scr, r, lane); continue; } r -= I4;
            transpose_item(p.in[I_OWOUT], D, D, (bf16*)(p.ws + WS_WOOUT), false, scr, r, lane);
        }
    }
    {
        const size_t gt = (size_t)blockIdx.x * NTHR + tid, NGT = (size_t)gridDim.x * NTHR;
#pragma unroll
        for (int g = 0; g < 3; ++g) {
            const int Wb = 128 << (2 * g);
            const f32x4* src = (const f32x4*)p.in[I_KV0 + g];
            f32x4* dst = (f32x4*)(p.out + (g == 0 ? O_KV0S : g == 1 ? O_KV1S : O_KV2S));
            const size_t cnt = (size_t)(Wb - 4) * 128, total = (size_t)DEC_BATCH * cnt;
            for (size_t i = gt; i < total; i += NGT) { const size_t n = i / cnt, r = i - n * cnt;
                dst[n * Wb * 128 + r] = src[(n * Wb + 4) * 128 + r]; }
        }
    }
}

template <bool FINAL>
__device__ __forceinline__ void norm_phase(const float* xp, const float* xs, const float* g, const float* shift, const float* scale, bf16* H, float* outp, float* outs) {
    const int tid = threadIdx.x, lane = tid & 63, wave = tid >> 6;
    const int gw = blockIdx.x * NWAVES + wave, NGW = gridDim.x * NWAVES;
    f32x4 gv[4];
#pragma unroll
    for (int j = 0; j < 4; ++j) gv[j] = ((const f32x4*)g)[lane + 64 * j];
    for (int row = gw; row < (FINAL ? MR : MP); row += NGW) {
        if (!FINAL && row >= MR) {
#pragma unroll
            for (int j = 0; j < 4; ++j) *(u32x2*)(H + (size_t)row * D + 4 * lane + 256 * j) = (u32x2){0u, 0u};
            continue;
        }
        const float* xr = row < TP ? xp + (size_t)row * D : xs + (size_t)(row - TP) * D;
        f32x4 v[4]; float ss = 0.f;
#pragma unroll
        for (int j = 0; j < 4; ++j) { v[j] = ((const f32x4*)xr)[lane + 64 * j]; ss += (v[j].x * v[j].x + v[j].y * v[j].y) + (v[j].z * v[j].z + v[j].w * v[j].w); }
        const float rstd = 1.0f / sqrtf(wave_sum(ss) * (1.0f / D) + EPS);
        if (FINAL) {
            float* o = row < TP ? outp + (size_t)row * D : outs + (size_t)(row - TP) * D;
#pragma unroll
            for (int j = 0; j < 4; ++j) ((f32x4*)o)[lane + 64 * j] = v[j] * rstd * gv[j];
        } else {
            const int nb = batch_of(row);
            const f32x4* sh = (const f32x4*)(shift + (size_t)nb * MODW); const f32x4* sc = (const f32x4*)(scale + (size_t)nb * MODW);
#pragma unroll
            for (int j = 0; j < 4; ++j) { const f32x4 y = v[j] * rstd * gv[j] * (sc[lane + 64 * j] + 1.0f) + sh[lane + 64 * j];
                *(u32x2*)(H + (size_t)row * D + 4 * lane + 256 * j) = (u32x2){pk2(y.x, y.y), pk2(y.z, y.w)}; }
        }
    }
}

#ifndef DBG_P3
#define DBG_P3 31
#endif
constexpr int QCOL = 512, KCOL = 1280, VCOL = 2048;
constexpr int VT_PITCH = 264;
constexpr int AT_VT = 0, AT_P = 64 * VT_PITCH * 2, AT_PW = 16 * VT_PITCH * 2, AT_BIAS = AT_P + NWAVES * AT_PW;
static_assert(AT_BIAS + 132 * 4 <= 131072, "attention LDS");

__device__ __forceinline__ void attn_unit(const Params& p, LAS unsigned char* lds, int u) {
    int tid = threadIdx.x; asm volatile("" : "+v"(tid));
    const int lane = tid & 63, wave = tid >> 6, fr = lane & 15, fq = lane >> 4;
    const int b = u / 192, v_ = u % 192, g = v_ / 64, w_ = v_ % 64, h = w_ / 16, x_ = w_ % 16;
    const int dl = 2 * g, d = 1 << dl, nblk = 16 >> dl, r = x_ / nblk, i = x_ % nblk;
    const bf16* PROJ = (const bf16*)(p.ws + WS_PROJ);
    LAS bf16* Vt = (LAS bf16*)(lds + AT_VT);
    LAS bf16* Pw = (LAS bf16*)(lds + AT_P + wave * AT_PW);
    LAS float* biasl = (LAS float*)(lds + AT_BIAS);
    const int kt0 = (i == 0) ? 8 : 0;
    const size_t rowbase = (size_t)b * SEQ;
    {
        const int kl = tid & 255, half = tid >> 8; const int mk = 128 * (i - 1) + kl;
        u32x4 w[4];
        if (mk >= 0) { const bf16* vp = PROJ + (rowbase + (size_t)mk * d + r) * E_IN + VCOL + g * 256 + h * 64 + 32 * half;
#pragma unroll
            for (int c = 0; c < 4; ++c) w[c] = *(const u32x4*)(vp + 8 * c);
        } else {
#pragma unroll
            for (int c = 0; c < 4; ++c) w[c] = (u32x4){0u, 0u, 0u, 0u};
        }
#pragma unroll
        for (int c = 0; c < 4; ++c) { const unsigned ww[4] = {w[c].x, w[c].y, w[c].z, w[c].w};
#pragma unroll
            for (int e = 0; e < 4; ++e) { const int dd = 32 * half + 8 * c + 2 * e;
                Vt[dd * VT_PITCH + kl] = (bf16)(ww[e] & 0xffffu); Vt[(dd + 1) * VT_PITCH + kl] = (bf16)(ww[e] >> 16); } }
        if (tid < 129) biasl[tid] = p.in[I_RB][BUCKET[g][tid] * 12 + g * 4 + h];
    }
    bf16x8 qa[2];
    {
        const int mq = 128 * i + 16 * wave + fr;
        const bf16* qp = PROJ + (rowbase + (size_t)mq * d + r) * E_IN + QCOL + g * 256 + h * 64 + 8 * fq;
        qa[0] = *(const bf16x8*)qp; qa[1] = *(const bf16x8*)(qp + 32);
    }
    f32x4 sacc[16];
#pragma unroll
    for (int kt = 0; kt < 16; ++kt) {
        sacc[kt] = (f32x4){0.f, 0.f, 0.f, 0.f};
        if (kt >= kt0) {
            const int mk = 128 * (i - 1) + 16 * kt + fr;
            const bf16* kp = PROJ + (rowbase + (size_t)mk * d + r) * E_IN + KCOL + g * 256 + h * 64 + 8 * fq;
            const bf16x8 k0 = *(const bf16x8*)kp, k1 = *(const bf16x8*)(kp + 32);
            sacc[kt] = __builtin_amdgcn_mfma_f32_16x16x32_bf16(qa[0], k0, sacc[kt], 0, 0, 0);
            sacc[kt] = __builtin_amdgcn_mfma_f32_16x16x32_bf16(qa[1], k1, sacc[kt], 0, 0, 0);
        }
    }
    __syncthreads();
    float mx[4] = {-INFINITY, -INFINITY, -INFINITY, -INFINITY};
#pragma unroll
    for (int kt = 0; kt < 16; ++kt) {
#pragma unroll
        for (int rg = 0; rg < 4; ++rg) {
            const int rel = (16 * wave + 4 * fq + rg) + 128 - (16 * kt + fr);
            const bool ok = (kt >= kt0) && rel >= 0 && rel <= 128;
            const float sv = ok ? sacc[kt][rg] * 0.125f + biasl[ok ? rel : 0] : -INFINITY;
            sacc[kt][rg] = sv; mx[rg] = fmaxf(mx[rg], sv);
        }
    }
#pragma unroll
    for (int rg = 0; rg < 4; ++rg) {
#pragma unroll
        for (int o = 1; o < 16; o <<= 1) mx[rg] = fmaxf(mx[rg], __shfl_xor(mx[rg], o));
    }
    float ls[4] = {0.f, 0.f, 0.f, 0.f};
#pragma unroll
    for (int kt = 0; kt < 16; ++kt) {
#pragma unroll
        for (int rg = 0; rg < 4; ++rg) {
            const float e = __builtin_amdgcn_exp2f((sacc[kt][rg] - mx[rg]) * 1.4426950408889634f);
            ls[rg] += e;
            Pw[(4 * fq + rg) * VT_PITCH + 16 * kt + fr] = (bf16)f2bf(e);
        }
    }
#pragma unroll
    for (int rg = 0; rg < 4; ++rg) {
#pragma unroll
        for (int o = 1; o < 16; o <<= 1) ls[rg] += __shfl_xor(ls[rg], o);
    }
    __syncthreads();
    f32x4 oacc[4];
#pragma unroll
    for (int nd = 0; nd < 4; ++nd) oacc[nd] = (f32x4){0.f, 0.f, 0.f, 0.f};
#pragma unroll
    for (int ks = 0; ks < 8; ++ks) {
        if (2 * ks >= kt0) {
            const bf16x8 pa = *(const LAS bf16x8*)(Pw + fr * VT_PITCH + 32 * ks + 8 * fq);
#pragma unroll
            for (int nd = 0; nd < 4; ++nd) {
                const bf16x8 vb = *(const LAS bf16x8*)(Vt + (16 * nd + fr) * VT_PITCH + 32 * ks + 8 * fq);
                oacc[nd] = __builtin_amdgcn_mfma_f32_16x16x32_bf16(pa, vb, oacc[nd], 0, 0, 0);
            }
        }
    }
    float* OG = (float*)(p.ws + WS_OG) + (size_t)g * MR * 256;
    float* LSE = (float*)(p.ws + WS_LSE) + (size_t)g * MR * 4;
#pragma unroll
    for (int rg = 0; rg < 4; ++rg) {
        const int mq = 128 * i + 16 * wave + 4 * fq + rg; const size_t row = rowbase + (size_t)mq * d + r;
        const float inv = 1.0f / ls[rg];
#pragma unroll
        for (int nd = 0; nd < 4; ++nd) OG[row * 256 + h * 64 + 16 * nd + fr] = oacc[nd][rg] * inv;
        if (fr == 0) LSE[row * 4 + h] = mx[rg] + logf(ls[rg]);
    }
    __syncthreads();
}

constexpr int CA_GLU = 0, CA_Y = 62 * 256 * 4;
__device__ __forceinline__ void conva_item(const Params& p, LAS unsigned char* lds, bool sample, int bn, int t0) {
    int tid = threadIdx.x; asm volatile("" : "+v"(tid));
    const int lane = tid & 63, wave = tid >> 6;
    const bf16* PROJ = (const bf16*)(p.ws + WS_PROJ);
    bf16* MIX = (bf16*)(p.ws + WS_MIX);
    LAS float* glu = (LAS float*)(lds + CA_GLU); LAS float* ys = (LAS float*)(lds + CA_Y);
    const int c = tid & 255, th = tid >> 8;
    const int RR = sample ? 34 : 62, NT = sample ? 4 : 32;
    for (int rr = th; rr < RR; rr += 2) {
        float v;
        if (sample) {
            if (rr < 30) v = p.in[I_SA][((size_t)bn * 30 + rr) * 256 + c];
            else { const bf16* pr = PROJ + (size_t)(TP + 4 * bn + rr - 30) * E_IN; const float a = bf2f(pr[c]), gt = bf2f(pr[256 + c]); v = a / (1.0f + expf(-gt)); }
        } else {
            const int t = t0 - 30 + rr;
            if (t < 0) v = 0.f;
            else { const bf16* pr = PROJ + ((size_t)bn * SEQ + t) * E_IN; const float a = bf2f(pr[c]), gt = bf2f(pr[256 + c]); v = a / (1.0f + expf(-gt)); }
        }
        glu[rr * 256 + c] = v;
    }
    __syncthreads();
    if (sample) { float* o = p.out + O_AS + (size_t)bn * 30 * 256; for (int j = th; j < 30; j += 2) o[j * 256 + c] = glu[(j + 4) * 256 + c]; }
    else if (t0 == SEQ - 32) { float* o = p.out + O_AP + (size_t)bn * 30 * 256; for (int j = th; j < 30; j += 2) o[j * 256 + c] = glu[(j + 32) * 256 + c]; }
    {
        float win[46];
#pragma unroll
        for (int q = 0; q < 46; ++q) { const int rr = 16 * th + q; win[q] = rr < RR ? glu[rr * 256 + c] : 0.f; }
        float y[16]; const float bb = p.in[I_ACB][c];
#pragma unroll
        for (int q = 0; q < 16; ++q) y[q] = bb;
#pragma unroll
        for (int k = 0; k < 31; ++k) { const float wk = p.in[I_ACW][k * 256 + c];
#pragma unroll
            for (int q = 0; q < 16; ++q) y[q] += wk * win[q + k]; }
#pragma unroll
        for (int q = 0; q < 16; ++q) ys[(16 * th + q) * 256 + c] = y[q];
    }
    __syncthreads();
    const f32x4 lg = ((const f32x4*)p.in[I_ALG])[lane], lb = ((const f32x4*)p.in[I_ALB])[lane];
#pragma unroll
    for (int q = 0; q < 4; ++q) { const int tl = 4 * wave + q;
        if (tl < NT) {
            const f32x4 v = *(const LAS f32x4*)(ys + tl * 256 + 4 * lane);
            const float mu = wave_sum((v.x + v.y) + (v.z + v.w)) * (1.0f / 256.0f);
            const f32x4 dv = v - mu;
            const float var = wave_sum((dv.x * dv.x + dv.y * dv.y) + (dv.z * dv.z + dv.w * dv.w)) * (1.0f / 256.0f);
            const float rstd = 1.0f / sqrtf(var + EPS);
            f32x4 y = dv * rstd * lg + lb;
            y.x = y.x / (1.0f + expf(-y.x)); y.y = y.y / (1.0f + expf(-y.y)); y.z = y.z / (1.0f + expf(-y.z)); y.w = y.w / (1.0f + expf(-y.w));
            const size_t row = sample ? (size_t)(TP + 4 * bn + tl) : (size_t)bn * SEQ + t0 + tl;
            *(u32x2*)(MIX + row * 512 + 4 * lane) = (u32x2){pk2(y.x, y.y), pk2(y.z, y.w)};
        } }
    __syncthreads();
}

constexpr int SA_NEW = 0, SA_Q = 4 * 2 * 256 * 4, SA_P = SA_Q + 4 * 256 * 4;
__device__ __forceinline__ void sattn_item(const Params& p, LAS unsigned char* lds, int n, int g) {
    int tid = threadIdx.x; asm volatile("" : "+v"(tid));
    const int lane = tid & 63, wave = tid >> 6;
    const bf16* PROJ = (const bf16*)(p.ws + WS_PROJ);
    const int dl = 2 * g, d = 1 << dl, Wb = 128 << dl;
    const float* cache = p.in[I_KV0 + g] + (size_t)n * Wb * 512;
    float* kvout = p.out + (g == 0 ? O_KV0S : g == 1 ? O_KV1S : O_KV2S) + (size_t)n * Wb * 512;
    LAS float* newkv = (LAS float*)(lds + SA_NEW); LAS float* qs = (LAS float*)(lds + SA_Q); LAS float* pw = (LAS float*)(lds + SA_P) + wave * 192;
    for (int idx = tid; idx < 4 * 3 * 256; idx += NTHR) { const int s = idx / 768, rem = idx % 768, which = rem >> 8, col = rem & 255;
        const float v = bf2f(PROJ[(size_t)(TP + 4 * n + s) * E_IN + QCOL + (which * 3 + g) * 256 + col]);
        if (which == 0) qs[s * 256 + col] = v;
        else { newkv[(s * 2 + which - 1) * 256 + col] = v; kvout[((size_t)(Wb - 4 + s) * 2 + which - 1) * 256 + col] = v; } }
    __syncthreads();
    float* OG = (float*)(p.ws + WS_OG) + (size_t)g * MR * 256;
    float* LSE = (float*)(p.ws + WS_LSE) + (size_t)g * MR * 4;
    for (int pr = 2 * wave; pr < 2 * wave + 2; ++pr) {
        const int s = pr >> 2, h = pr & 3;
        float sc[3];
#pragma unroll
        for (int rd = 0; rd < 3; ++rd) {
            const int j = rd * 64 + lane; float dot = 0.f;
            if (j <= 128) {
                const int idx = Wb + s - j * d;
                if (idx >= Wb) { const LAS float* kp = newkv + ((idx - Wb) * 2 + 0) * 256 + h * 64;
#pragma unroll
                    for (int e = 0; e < 16; ++e) { const f32x4 kv = *(const LAS f32x4*)(kp + 4 * e), qv = *(const LAS f32x4*)(qs + s * 256 + h * 64 + 4 * e); dot += (kv.x * qv.x + kv.y * qv.y) + (kv.z * qv.z + kv.w * qv.w); }
                } else { const float* kp = cache + ((size_t)idx * 2 + 0) * 256 + h * 64;
#pragma unroll
                    for (int e = 0; e < 16; ++e) { const f32x4 kv = *(const f32x4*)(kp + 4 * e), qv = *(const LAS f32x4*)(qs + s * 256 + h * 64 + 4 * e); dot += (kv.x * qv.x + kv.y * qv.y) + (kv.z * qv.z + kv.w * qv.w); }
                }
                sc[rd] = dot * 0.125f + p.in[I_RB][BUCKET[g][j] * 12 + g * 4 + h];
            } else sc[rd] = -INFINITY;
        }
        const float m = wave_max(fmaxf(fmaxf(sc[0], sc[1]), sc[2]));
        float e3[3]; float l = 0.f;
#pragma unroll
        for (int rd = 0; rd < 3; ++rd) { e3[rd] = expf(sc[rd] - m); l += e3[rd]; }
        l = wave_sum(l);
        const float inv = 1.0f / l;
#pragma unroll
        for (int rd = 0; rd < 3; ++rd) pw[rd * 64 + lane] = e3[rd] * inv;
        LDS_WAIT();
        const int kq = lane >> 4, d4 = 4 * (lane & 15);
        f32x4 o = (f32x4){0.f, 0.f, 0.f, 0.f};
        for (int it = 0; it < 33; ++it) {
            const int j = 4 * it + kq;
            if (j <= 128) {
                const int idx = Wb + s - j * d; const float pj = pw[j];
                f32x4 vv;
                if (idx >= Wb) vv = *(const LAS f32x4*)(newkv + ((idx - Wb) * 2 + 1) * 256 + h * 64 + d4);
                else vv = *(const f32x4*)(cache + ((size_t)idx * 2 + 1) * 256 + h * 64 + d4);
                o += vv * pj;
            }
        }
#pragma unroll
        for (int c = 0; c < 4; ++c) { o[c] += __shfl_xor(o[c], 16); o[c] += __shfl_xor(o[c], 32); }
        const size_t row = (size_t)(TP + 4 * n + s);
        if (lane < 16) *(f32x4*)(OG + row * 256 + h * 64 + d4) = o;
        if (lane == 0) LSE[row * 4 + h] = m + logf(l);
        LDS_WAIT();
    }
    __syncthreads();
}

__device__ __forceinline__ void phase3(const Params& p, LAS unsigned char* lds) {
    constexpr int N_ATT = BATCH * 192, N_CA = TP / 32, N_SA = DEC_BATCH * 3, N_CS = DEC_BATCH;
    for (int it = blockIdx.x; it < N_ATT + N_CA + N_SA + N_CS; it += gridDim.x) {
        int r = it;
        if (r < N_SA) { if (DBG_P3 & 1) sattn_item(p, lds, r / 3, r % 3); continue; } r -= N_SA;
        if (r < N_ATT) { if (DBG_P3 & 2) attn_unit(p, lds, r); continue; } r -= N_ATT;
        if (r < N_CA) { if (DBG_P3 & 4) conva_item(p, lds, false, r / 64, (r % 64) * 32); continue; } r -= N_CA;
        if (DBG_P3 & 8) conva_item(p, lds, true, r, 0);
    }
    if (!(DBG_P3 & 16)) return;
    const bf16* PROJ = (const bf16*)(p.ws + WS_PROJ);
    const size_t gt = (size_t)blockIdx.x * NTHR + threadIdx.x, NGT = (size_t)gridDim.x * NTHR;
#pragma unroll
    for (int g = 0; g < 3; ++g) {
        const int W = 128 << (2 * g);
        float* o = p.out + (g == 0 ? O_KV0P : g == 1 ? O_KV1P : O_KV2P);
        const size_t total = (size_t)BATCH * W * 64;
        for (size_t i = gt; i < total; i += NGT) { const int vec = (int)(i & 31), which = (int)((i >> 5) & 1); const size_t bj = i >> 6; int j = (int)(bj % W), b = (int)(bj / W); asm volatile("" : "+v"(j), "+v"(b));
            const u32x4 w = *(const u32x4*)(PROJ + ((size_t)b * SEQ + (SEQ - W + j)) * E_IN + QCOL + ((1 + which) * 3 + g) * 256 + 8 * vec);
            float f[8]; unpack8(w, f);
            float* op = o + i * 8;
            *(f32x4*)op = (f32x4){f[0], f[1], f[2], f[3]}; *(f32x4*)(op + 4) = (f32x4){f[4], f[5], f[6], f[7]}; }
    }
}

__device__ __forceinline__ void phase4(const Params& p) {
    const int tid = threadIdx.x, lane = tid & 63, wave = tid >> 6;
    const int gw = blockIdx.x * NWAVES + wave, NGW = gridDim.x * NWAVES;
    const float* OG = (const float*)(p.ws + WS_OG); const float* LSE = (const float*)(p.ws + WS_LSE);
    bf16* MIX = (bf16*)(p.ws + WS_MIX);
    for (int row = gw; row < MP; row += NGW) {
        if (row >= MR) { *(u32x4*)(MIX + (size_t)row * 512 + 8 * lane) = (u32x4){0u, 0u, 0u, 0u}; continue; }
        const int h = lane >> 4;
        const float l0 = LSE[(size_t)row * 4 + h], l1 = LSE[((size_t)MR + row) * 4 + h], l2 = LSE[((size_t)2 * MR + row) * 4 + h];
        const float m = fmaxf(fmaxf(l0, l1), l2);
        const float e0 = expf(l0 - m), e1 = expf(l1 - m), e2 = expf(l2 - m), inv = 1.0f / (e0 + e1 + e2);
        const f32x4 o0 = *(const f32x4*)(OG + (size_t)row * 256 + 4 * lane), o1 = *(const f32x4*)(OG + ((size_t)MR + row) * 256 + 4 * lane), o2 = *(const f32x4*)(OG + ((size_t)2 * MR + row) * 256 + 4 * lane);
        const f32x4 a = (o0 * e0 + o1 * e1 + o2 * e2) * inv;
        *(u32x2*)(MIX + (size_t)row * 512 + 256 + 4 * lane) = (u32x2){pk2(a.x, a.y), pk2(a.z, a.w)};
    }
}

__device__ __forceinline__ void mixc_rows(const Params& p) {
    const bf16* PJ = (const bf16*)(p.ws + WS_PROJ);
    bf16* MIX = (bf16*)(p.ws + WS_MIX);
    const size_t gt = (size_t)blockIdx.x * NTHR + threadIdx.x, NGT = (size_t)gridDim.x * NTHR;
    for (size_t i = gt; i < (size_t)MP * 64; i += NGT) {
        const int row = (int)(i >> 6), c0 = (int)(i & 63) * 8;
        if (row >= MR) { *(u32x4*)(MIX + (size_t)row * D + c0) = (u32x4){0u, 0u, 0u, 0u}; *(u32x4*)(MIX + (size_t)row * D + 512 + c0) = (u32x4){0u, 0u, 0u, 0u}; continue; }
        const bool smp = row >= TP; const int t = smp ? ((row - TP) & 3) : (row & 2047); const int n = smp ? ((row - TP) >> 2) : (row >> 11);
        float ci[3][8];
#pragma unroll
        for (int k = 0; k < 3; ++k) { const int tt = t - 2 + k;
            if (tt >= 0) { float a[8], b[8]; unpack8(*(const u32x4*)(PJ + (size_t)(row - 2 + k) * O_IN + 512 + c0), a); unpack8(*(const u32x4*)(PJ + (size_t)(row - 2 + k) * O_IN + 1024 + c0), b);
#pragma unroll
                for (int e = 0; e < 8; ++e) ci[k][e] = a[e] * b[e]; }
            else if (smp) { const float* sp = p.in[I_SC] + ((size_t)n * 2 + (tt + 2)) * 512 + c0;
#pragma unroll
                for (int e = 0; e < 8; ++e) ci[k][e] = sp[e]; }
            else {
#pragma unroll
                for (int e = 0; e < 8; ++e) ci[k][e] = 0.f; } }
        float bg[8]; unpack8(*(const u32x4*)(PJ + (size_t)row * O_IN + c0), bg);
        float y[8];
#pragma unroll
        for (int e = 0; e < 8; ++e) { const float* w = p.in[I_CCW] + c0 + e;
            y[e] = bg[e] * (w[0] * ci[0][e] + w[512] * ci[1][e] + w[1024] * ci[2][e] + p.in[I_CCB][c0 + e]); }
        *(u32x4*)(MIX + (size_t)row * D + c0) = (u32x4){pk2(y[0], y[1]), pk2(y[2], y[3]), pk2(y[4], y[5]), pk2(y[6], y[7])};
        float* so = nullptr;
        if (smp) { if (t >= 2) so = p.out + O_CS + ((size_t)n * 2 + (t - 2)) * 512 + c0; }
        else if (t >= SEQ - 2) so = p.out + O_CP + ((size_t)n * 2 + (t - (SEQ - 2))) * 512 + c0;
        if (so) { *(f32x4*)so = (f32x4){ci[2][0], ci[2][1], ci[2][2], ci[2][3]}; *(f32x4*)(so + 4) = (f32x4){ci[2][4], ci[2][5], ci[2][6], ci[2][7]}; }
    }
}

constexpr int MD_PITCH = 136;
constexpr int MD_VT = 0, MD_WS = 128 * MD_PITCH * 2, MD_ST = 2 * 128 * MD_PITCH * 2;
__device__ __forceinline__ void mixd_item(const Params& p, LAS unsigned char* lds, int b, int ck) {
    int tid = threadIdx.x; asm volatile("" : "+v"(tid));
    const int lane = tid & 63, wave = tid >> 6, fr = lane & 15, fq = lane >> 4;
    const bf16* PJ = (const bf16*)(p.ws + WS_PROJ);
    bf16* MIX = (bf16*)(p.ws + WS_MIX);
    LAS bf16* vT = (LAS bf16*)(lds + MD_VT); LAS bf16* Wl = (LAS bf16*)(lds + MD_WS); LAS float* st = (LAS float*)(lds + MD_ST);
    const size_t row0 = (size_t)b * SEQ + (size_t)ck * 128;
    for (int q = 0; q < 16; ++q) { const int j = 16 * wave + q;
        float f[8]; unpack8(*(const u32x4*)(PJ + (row0 + j) * O_IN + 2048 + 8 * lane), f);
        float s = 0.f;
#pragma unroll
        for (int e = 0; e < 8; ++e) s += f[e];
        const float mu = wave_sum(s) * (1.0f / 512.0f); float s2 = 0.f;
#pragma unroll
        for (int e = 0; e < 8; ++e) { const float dlt = f[e] - mu; s2 += dlt * dlt; }
        const float var = wave_sum(s2) * (1.0f / 512.0f);
        if (lane == 0) { st[2 * j] = mu; st[2 * j + 1] = 1.0f / sqrtf(var + EPS); } }
    __syncthreads();
    for (int g = 0; g < 4; ++g) {
        {
            const int j = tid & 127, cq = tid >> 7; const float mu = st[2 * j], rs = st[2 * j + 1];
#pragma unroll
            for (int c8 = 0; c8 < 4; ++c8) { const int cc = 32 * cq + 8 * c8;
                float f[8]; unpack8(*(const u32x4*)(PJ + (row0 + j) * O_IN + 2048 + g * 128 + cc), f);
#pragma unroll
                for (int e = 0; e < 8; ++e) { const float y = (f[e] - mu) * rs * p.in[I_DLG][g * 128 + cc + e] + p.in[I_DLB][g * 128 + cc + e];
                    vT[(cc + e) * MD_PITCH + j] = (bf16)f2bf(y); } }
            const float* wsg = p.in[I_DSW] + (size_t)g * 128 * 128;
            for (int idx = tid; idx < 128 * 128; idx += NTHR) { const int ii = idx >> 7, jj = idx & 127; Wl[ii * MD_PITCH + jj] = (bf16)(jj <= ii ? f2bf(wsg[idx]) : 0u); }
        }
        __syncthreads();
        f32x4 acc[8];
#pragma unroll
        for (int nc = 0; nc < 8; ++nc) acc[nc] = (f32x4){0.f, 0.f, 0.f, 0.f};
#pragma unroll
        for (int ks = 0; ks < 4; ++ks) {
            const bf16x8 a = *(const LAS bf16x8*)(Wl + (16 * wave + fr) * MD_PITCH + 32 * ks + 8 * fq);
#pragma unroll
            for (int nc = 0; nc < 8; ++nc) { const bf16x8 bb = *(const LAS bf16x8*)(vT + (16 * nc + fr) * MD_PITCH + 32 * ks + 8 * fq);
                acc[nc] = __builtin_amdgcn_mfma_f32_16x16x32_bf16(a, bb, acc[nc], 0, 0, 0); }
        }
#pragma unroll
        for (int rg = 0; rg < 4; ++rg) { const int ii = 16 * wave + 4 * fq + rg; const float bsv = p.in[I_DSB][g * 128 + ii];
            const bf16* up = PJ + (row0 + ii) * O_IN + 1536 + g * 128; bf16* op = MIX + (row0 + ii) * D + 512 + g * 128;
#pragma unroll
            for (int nc = 0; nc < 8; ++nc) { const int c = 16 * nc + fr; op[c] = (bf16)f2bf(bf2f(up[c]) * (acc[nc][rg] + bsv)); } }
        __syncthreads();
    }
}
__device__ __forceinline__ void mixd_sample(const Params& p, LAS unsigned char* lds, int n) {
    int tid = threadIdx.x; asm volatile("" : "+v"(tid));
    const int lane = tid & 63, wave = tid >> 6;
    const bf16* PJ = (const bf16*)(p.ws + WS_PROJ);
    bf16* MIX = (bf16*)(p.ws + WS_MIX);
    LAS float* red = (LAS float*)lds;
    float x[4], v[4];
#pragma unroll
    for (int s = 0; s < 4; ++s) x[s] = bf2f(PJ[(size_t)(TP + 4 * n + s) * O_IN + 2048 + tid]);
    __syncthreads();
#pragma unroll
    for (int s = 0; s < 4; ++s) { const float t = wave_sum(x[s]); if (lane == 0) red[s * 8 + wave] = t; }
    __syncthreads();
    float mu[4];
#pragma unroll
    for (int s = 0; s < 4; ++s) { float t = 0.f;
#pragma unroll
        for (int w = 0; w < 8; ++w) t += red[s * 8 + w];
        mu[s] = t * (1.0f / 512.0f); }
    __syncthreads();
#pragma unroll
    for (int s = 0; s < 4; ++s) { const float dlt = x[s] - mu[s]; const float t = wave_sum(dlt * dlt); if (lane == 0) red[s * 8 + wave] = t; }
    __syncthreads();
    const float lg = p.in[I_DLG][tid], lb = p.in[I_DLB][tid];
#pragma unroll
    for (int s = 0; s < 4; ++s) { float t = 0.f;
#pragma unroll
        for (int w = 0; w < 8; ++w) t += red[s * 8 + w];
        v[s] = (x[s] - mu[s]) * (1.0f / sqrtf(t * (1.0f / 512.0f) + EPS)) * lg + lb;
        p.out[O_DV + ((size_t)n * 4 + s) * 512 + tid] = v[s]; }
    const int g = tid >> 7;
    const float* wsg = p.in[I_DSW] + (size_t)g * 128 * 128;
#pragma unroll
    for (int i = 0; i < 4; ++i) { float m = p.in[I_DSB][g * 128 + i];
#pragma unroll
        for (int j = 0; j <= i; ++j) m += wsg[i * 128 + j] * v[j];
        const float u = bf2f(PJ[(size_t)(TP + 4 * n + i) * O_IN + 1536 + tid]);
        MIX[(size_t)(TP + 4 * n + i) * D + 512 + tid] = (bf16)f2bf(u * m); }
    __syncthreads();
}
__device__ __forceinline__ void phase11(const Params& p, LAS unsigned char* lds) {
    constexpr int N_D = BATCH * 16, N_DS = DEC_BATCH;
    for (int it = blockIdx.x; it < N_D + N_DS; it += gridDim.x) {
        if (it < N_D) mixd_item(p, lds, it / 16, it % 16); else mixd_sample(p, lds, it - N_D);
    }
    mixc_rows(p);
}

#define XB_TMO      128
#define XB_XCNT(j)  (256  + 64 * (j))
#define XB_XSUB(j)  (1280 + 64 * (j))
#define XB_XGEN(j)  (2304 + 64 * (j))
#define XB_TOP      3328
#define XB_TOPGEN   3392
#define XCD_BAR_WORDS 3456
#define XB_SPIN_CAP (1u << 18)

__device__ __forceinline__ unsigned xb_ld(unsigned* p)              { return __hip_atomic_load(p, __ATOMIC_RELAXED, __HIP_MEMORY_SCOPE_AGENT); }
__device__ __forceinline__ unsigned xb_add(unsigned* p, unsigned v) { return __hip_atomic_fetch_add(p, v, __ATOMIC_RELAXED, __HIP_MEMORY_SCOPE_AGENT); }
__device__ __forceinline__ unsigned xb_xcc_id() { return (unsigned)__builtin_amdgcn_s_getreg((3 << 11) | 20) & 0xFu; }
#define XB_SPIN(cond, bar) do { unsigned _sp = 0; while (cond) { __builtin_amdgcn_s_sleep(1); \
    if ((++_sp & 255u) == 0u) { if (xb_ld(&(bar)[XB_TMO])) break; if (_sp > XB_SPIN_CAP) { atomicAdd(&(bar)[XB_TMO], 1u); break; } } } } while (0)

struct XcdBarrier {
    unsigned* bar; unsigned x;
    volatile LAS unsigned* st;
};

__device__ __forceinline__ XcdBarrier xcd_barrier_post(unsigned* bar, volatile LAS unsigned* st) {
    XcdBarrier b; b.bar = bar; b.x = xb_xcc_id(); b.st = st;
    if (threadIdx.x == 0) (void)xb_add(&bar[XB_XCNT(b.x)], 1u);
    return b;
}
__device__ __forceinline__ void xcd_barrier_complete(unsigned* bar, unsigned x, unsigned& nloc, unsigned& nx) {
    const unsigned G = gridDim.x * gridDim.y * gridDim.z;
    unsigned sum, cnt, mine, sp = 0u;
    for (;;) {
        sum = 0u; cnt = 0u; mine = 0u;
#pragma unroll
        for (unsigned j = 0; j < 16; ++j) { const unsigned c = xb_ld(&bar[XB_XCNT(j)]); sum += c; cnt += (c > 0u) ? 1u : 0u; mine = (j == x) ? c : mine; }
        if (sum == G) break;
        __builtin_amdgcn_s_sleep(1);
        if ((++sp & 255u) == 0u) { if (xb_ld(&bar[XB_TMO])) break; if (sp > XB_SPIN_CAP) { atomicAdd(&bar[XB_TMO], 1u); break; } }
    }
    nloc = mine > 0u ? mine : 1u; nx = cnt > 0u ? cnt : 1u;
}

__device__ __forceinline__ void xcd_barrier(const XcdBarrier& b) {
    asm volatile("s_waitcnt vmcnt(0)" ::: "memory");
    __syncthreads();
    if (threadIdx.x == 0) {
        unsigned* bar = b.bar;
        __builtin_amdgcn_s_waitcnt(0);
        unsigned nloc = b.st[0], nx = b.st[1];
        if (nloc == 0u) { xcd_barrier_complete(bar, b.x, nloc, nx); b.st[0] = nloc; b.st[1] = nx; }
        const unsigned old = xb_add(&bar[XB_XSUB(b.x)], 1u);
        const unsigned gen = old / nloc;
        if (old + 1u == (gen + 1u) * nloc) {
            __builtin_amdgcn_fence(__ATOMIC_RELEASE, "agent");
            asm volatile("s_waitcnt vmcnt(0)" ::: "memory");
            const unsigned og = xb_add(&bar[XB_TOP], 1u);
            const unsigned tg = og / nx;
            if (og + 1u == (tg + 1u) * nx) xb_add(&bar[XB_TOPGEN], 1u);
            else XB_SPIN(xb_ld(&bar[XB_TOPGEN]) == tg, bar);
            __builtin_amdgcn_fence(__ATOMIC_ACQUIRE, "agent");
            xb_add(&bar[XB_XGEN(b.x)], 1u);
            asm volatile("s_waitcnt vmcnt(0)" ::: "memory");
        } else {
            XB_SPIN(xb_ld(&bar[XB_XGEN(b.x)]) == gen, bar);
            __builtin_amdgcn_fence(__ATOMIC_ACQUIRE, "agent");
            asm volatile("s_waitcnt vmcnt(0)" ::: "memory");
        }
    }
    __syncthreads();
}

template <bool COOP>
__global__ void __launch_bounds__(NTHR, 2) fwd_kernel(Params p) {
    extern __shared__ __attribute__((aligned(16))) unsigned char lds_raw[];
    LAS unsigned char* lds = (LAS unsigned char*)lds_raw;
    unsigned char* ws = p.ws;
    float* mod = (float*)(ws + WS_MOD);
    float* X = (float*)(ws + WS_X);
    bf16* H = (bf16*)(ws + WS_H); bf16* PROJ = (bf16*)(ws + WS_PROJ); bf16* MIX = (bf16*)(ws + WS_MIX); bf16* ACT = (bf16*)(ws + WS_ACT);
    const int lo = p.ph_lo, hi = p.ph_hi;
    XcdBarrier bar; bar.bar = (unsigned*)(ws + WS_CTL) + CW_BAR; bar.x = 0; bar.st = nullptr;
    if (COOP) {
        for (int u = threadIdx.x; u < (LDS_BYTES - LDSCTL_OFF) / 4; u += NTHR) ((LAS unsigned*)(lds + LDSCTL_OFF))[u] = 0u;
        __syncthreads();
        bar = xcd_barrier_post((unsigned*)(ws + WS_CTL) + CW_BAR, (volatile LAS unsigned*)(lds + LDSCTL_OFF + 320) + 8);
    }
#define IN(k) (lo <= (k) && (k) < hi)
#define SEAM(k) do { if (COOP) { if ((k) + 1 < hi) xcd_barrier(bar); } } while (0)
#define GEMM_PHASE(EpiT, Aptr, Wptr, Mrows, Ncols, Kdim, ...) do { pg8::Gemm g_{(const pg8::bf16_t*)(Aptr), (const pg8::bf16_t*)(Wptr), Mrows, Ncols, Kdim}; \
        pg8::StaticOrder S_; S_.init(Mrows, Ncols, (int)gridDim.x, (int)blockIdx.x); pg8::EpiT E_{__VA_ARGS__}; \
        pg8::gemm_phase<pg8::EpiT, pg8::StaticOrder, true, true>(lds, g_, S_, E_); } while (0)

    if (IN(0)) { phase0(p, lds); SEAM(0); }
    if (IN(1)) { norm_phase<false>(p.in[I_XP], p.in[I_XS], p.in[I_NMG], mod + 0 * D, mod + 1 * D, H, nullptr, nullptr); SEAM(1); }
    if (IN(2)) { GEMM_PHASE(EpiStoreBf16, H, ws + WS_WEIN, MP, E_IN, D, (pg8::bf16_t*)PROJ, E_IN, 1 << 30); SEAM(2); }
    if (IN(3)) { phase3(p, lds); SEAM(3); }
    if (IN(4)) { phase4(p); SEAM(4); }
    if (IN(5)) { GEMM_PHASE(EpiResid, MIX, ws + WS_WEOUT, MP, D, 512, p.in[I_XP], p.in[I_XS], X, mod + 2 * D); SEAM(5); }
    if (IN(6)) { norm_phase<false>(X, X + (size_t)TP * D, p.in[I_NFG], mod + 3 * D, mod + 4 * D, H, nullptr, nullptr); SEAM(6); }
    if (IN(7)) { GEMM_PHASE(EpiSwiGLU, H, ws + WS_WGU0, MP, 2 * FFN, D, (pg8::bf16_t*)ACT, FFN); SEAM(7); }
    if (IN(8)) { GEMM_PHASE(EpiResid, ACT, ws + WS_WDN0, MP, D, FFN, X, X + (size_t)TP * D, X, mod + 5 * D); SEAM(8); }
    const float* mod1 = mod + (size_t)NB * MODW;
    if (IN(9)) { norm_phase<false>(X, X + (size_t)TP * D, p.in[I_NMG] + D, mod1 + 0 * D, mod1 + 1 * D, H, nullptr, nullptr); SEAM(9); }
    if (IN(10)) { GEMM_PHASE(EpiStoreBf16, H, ws + WS_WOIN, MP, O_IN, D, (pg8::bf16_t*)PROJ, O_IN, 6); SEAM(10); }
    if (IN(11)) { phase11(p, lds); SEAM(11); }
    if (IN(12)) { GEMM_PHASE(EpiResid, MIX, ws + WS_WOOUT, MP, D, D, X, X + (size_t)TP * D, X, mod1 + 2 * D); SEAM(12); }
    if (IN(13)) { norm_phase<false>(X, X + (size_t)TP * D, p.in[I_NFG] + D, mod1 + 3 * D, mod1 + 4 * D, H, nullptr, nullptr); SEAM(13); }
    if (IN(14)) { GEMM_PHASE(EpiSwiGLU, H, ws + WS_WGU1, MP, 2 * FFN, D, (pg8::bf16_t*)ACT, FFN); SEAM(14); }
    if (IN(15)) { GEMM_PHASE(EpiResid, ACT, ws + WS_WDN1, MP, D, FFN, X, X + (size_t)TP * D, X, mod1 + 5 * D); SEAM(15); }
    if (IN(16)) { norm_phase<true>(X, X + (size_t)TP * D, p.in[I_FNG], nullptr, nullptr, nullptr, p.out + O_YP, p.out + O_YS); }
#undef IN
#undef SEAM
#undef GEMM_PHASE
}

#ifndef DBG_PH_HI
#define DBG_PH_HI NPHASE
#endif
#ifndef MK_MULTI
#define MK_MULTI 1
#endif
extern "C" void kernel_launch(void* const* d_in, const int* in_sizes, int n_in, void* d_out, int out_size, void* d_ws, size_t ws_size, hipStream_t stream) {
    static int grid = 0;
    if (grid == 0) {
        if (n_in != N_IN || out_size != (int)O_END || ws_size < WS_END) { fprintf(stderr, "kernel_launch: unexpected shapes: n_in %d out %d ws %zu (need %zu)\n", n_in, out_size, ws_size, (size_t)WS_END); grid = -1; return; }
        int dev = 0, cus = 0, per_cu = 0;
        if (hipGetDevice(&dev) != hipSuccess || hipDeviceGetAttribute(&cus, hipDeviceAttributeMultiprocessorCount, dev) != hipSuccess) { grid = -1; return; }
        hipFuncSetAttribute((const void*)fwd_kernel<true>, hipFuncAttributeMaxDynamicSharedMemorySize, LDS_BYTES);
        hipFuncSetAttribute((const void*)fwd_kernel<false>, hipFuncAttributeMaxDynamicSharedMemorySize, LDS_BYTES);
        if (hipOccupancyMaxActiveBlocksPerMultiprocessor(&per_cu, (const void*)fwd_kernel<true>, NTHR, LDS_BYTES) != hipSuccess || per_cu < 1) { fprintf(stderr, "kernel_launch: occupancy query says %d blocks per CU\n", per_cu); per_cu = 1; }
        (void)hipGetLastError();
        grid = cus;
    }
    if (grid < 0) return;
    Params prm{};
    for (int i = 0; i < N_IN; ++i) prm.in[i] = (const float*)d_in[i];
    prm.out = (float*)d_out; prm.ws = (unsigned char*)d_ws;
#if MK_MULTI
    for (int ph = 0; ph < DBG_PH_HI; ++ph) { prm.ph_lo = ph; prm.ph_hi = ph + 1;
        hipLaunchKernelGGL(fwd_kernel<false>, dim3(grid), dim3(NTHR), LDS_BYTES, stream, prm); }
#else
    prm.ph_lo = 0; prm.ph_hi = NPHASE;
    if (hipMemsetAsync((char*)d_ws + WS_CTL, 0, CTL_ZERO_BYTES, stream) != hipSuccess) { fprintf(stderr, "kernel_launch: memset of the control words failed\n"); return; }
    void* args[] = {&prm};
    hipError_t e = hipLaunchCooperativeKernel((const void*)fwd_kernel<true>, dim3(grid), dim3(NTHR), args, LDS_BYTES, stream);
    if (e != hipSuccess) fprintf(stderr, "cooperative launch failed: %s (grid %d)\n", hipGetErrorString(e), grid);
#endif
}
```

```cpp
#define MK_MULTI 0
#include <hip/hip_runtime.h>
#include <hip/hip_cooperative_groups.h>
#include <cstdio>
#include <cstdint>
namespace cg = cooperative_groups;

constexpr int D = 1024, BATCH = 8, SEQ = 2048, DEC_BATCH = 32, DEC_SEQ = 4, NB = BATCH + DEC_BATCH;
constexpr int TP = BATCH * SEQ;
constexpr int TS = DEC_BATCH * DEC_SEQ;
constexpr int MR = TP + TS;
constexpr int MP = 16640;
constexpr int E_IN = 2816, O_IN = 2560, FFN = 2816, MODW = 6 * D;
constexpr float EPS = 1e-6f;
namespace pg8 {
#define PG8_LAS __attribute__((address_space(3)))
typedef unsigned short bf16_t;
typedef short bf16x8 __attribute__((ext_vector_type(8)));
typedef float f32x4 __attribute__((ext_vector_type(4)));
typedef unsigned u32x4 __attribute__((ext_vector_type(4)));
constexpr int BM = 256, BK = 64, HALF = 128, HTB = HALF * BK * 2  , STAGE_BYTES = 8 * HTB, NXCD = 8, WGM = 8;

__host__ __device__ __forceinline__ int lds_byte(int r, int c) { const int st = (r >> 4) * 2 + (c >> 5), rr = r & 15, cc = c & 31, ob = rr * 64 + cc * 2; return st * 1024 + (ob ^ (((ob >> 9) & 1) << 5)); }
__host__ __device__ __forceinline__ void stage_rc(int b, int& R, int& C) { const int st = b / 1024, sb = b % 1024, swz = sb ^ (((sb >> 9) & 1) << 5); R = (st >> 1) * 16 + swz / 64; C = (st & 1) * 32 + (swz % 64) / 2; }
__host__ __device__ __forceinline__ int perm32(int rho) { const int n = rho >> 4, i = rho & 15; return 8 * (i >> 2) + 4 * n + (i & 3); }

struct Unit { int pm, pn; };
struct Gemm { const bf16_t* A; const bf16_t* Bt; int M, N, K; };

struct StaticOrder {
    int nM, nN, nwg, G, c;
    __host__ __device__ void init(int M, int N, int G_, int c_) { nM = M / BM; nN = N / BM; nwg = nM * nN; G = G_; c = c_; }
    __host__ __device__ bool next(int i, Unit& u) const {
        const long L = (long)i * G + c; if (L >= nwg) return false;
        int wgid = (int)L; { const int q = nwg / NXCD, r = nwg % NXCD, xcd = wgid % NXCD, off = wgid / NXCD; wgid = (xcd < r ? xcd * (q + 1) : r * (q + 1) + (xcd - r) * q) + off; }
        const int nig = WGM * nN, gid = wgid / nig, fm = gid * WGM, gsz = (nM - fm) < WGM ? (nM - fm) : WGM;
        u.pm = fm + ((wgid % nig) % gsz); u.pn = (wgid % nig) / gsz; return true;
    }
    __device__ __forceinline__ void a_ready(const Unit&) const {}
    __device__ __forceinline__ void done(const Unit&) const {}
};

__device__ __forceinline__ unsigned cvt_pk_bf16(float lo, float hi) { unsigned r; asm volatile("v_cvt_pk_bf16_f32 %0, %1, %2" : "=v"(r) : "v"(lo), "v"(hi)); return r; }
typedef float f32x2 __attribute__((ext_vector_type(2)));
__device__ __forceinline__ f32x2 gelu_pk(f32x2 v) {
    const f32x2 av = __builtin_elementwise_abs(v), d = av * 0.2316418882f + 1.0f;
    f32x2 t; t.x = __builtin_amdgcn_rcpf(d.x); t.y = __builtin_amdgcn_rcpf(d.y);
    f32x2 q = t * 0.5307027145f + (-0.7265760135f); q = q * t + 0.7107068705f; q = q * t + (-0.142248368f); q = q * t + 0.127414796f; q = q * t;
    const f32x2 s = (v * v) * (-0.72134752044f);
    f32x2 e; e.x = __builtin_amdgcn_exp2f(s.x); e.y = __builtin_amdgcn_exp2f(s.y);
    const f32x2 m = v * (q * e), r = v - m;
    f32x2 o; o.x = v.x < 0.f ? m.x : r.x; o.y = v.y < 0.f ? m.y : r.y; return o;
}

template <int ACT  > struct EpiBf16 {
    static constexpr bool PERM = true, AFTER_DRAIN = false; static_assert(ACT == 0 || ACT == 1, "EpiBf16: ACT is 0 (none) or 1 (gelu_pk)");
    bf16_t* O; int ldc; const float* bias; int split_cols; size_t split_stride; float scale0;
    __device__ __forceinline__ void operator()(const f32x4 (&acc)[2][2][4][2], const Unit& u, int wr, int wc, int fr, int fq) const {
        const int row0 = u.pm * BM + wr * 64 + fr; int colt = u.pn * BM; bf16_t* base = O;
        float sc = 1.f; if (split_cols) { const int t = colt / split_cols; base += (size_t)t * split_stride; colt -= t * split_cols; if (t == 0) sc = scale0; }
        const int col0 = colt + wc * 32 + 8 * fq, bcol0 = u.pn * BM + wc * 32 + 8 * fq;
        f32x4 bv[2][2];
#pragma unroll
        for (int bj = 0; bj < 2; ++bj)
#pragma unroll
            for (int n = 0; n < 2; ++n) bv[bj][n] = bias ? *(const f32x4*)(bias + bcol0 + bj * HALF + 4 * n) : (f32x4){0.f, 0.f, 0.f, 0.f};
#pragma unroll
        for (int ai = 0; ai < 2; ++ai)
#pragma unroll
            for (int m = 0; m < 4; ++m) { bf16_t* rowp = base + (size_t)(row0 + ai * HALF + m * 16) * ldc + col0;
#pragma unroll
                for (int bj = 0; bj < 2; ++bj) { f32x4 v0 = acc[ai][bj][m][0] + bv[bj][0], v1 = acc[ai][bj][m][1] + bv[bj][1];
                    if (ACT == 1) { f32x2 a = gelu_pk((f32x2){v0[0], v0[1]}), b = gelu_pk((f32x2){v0[2], v0[3]}), c = gelu_pk((f32x2){v1[0], v1[1]}), d = gelu_pk((f32x2){v1[2], v1[3]});
                        v0 = (f32x4){a.x, a.y, b.x, b.y}; v1 = (f32x4){c.x, c.y, d.x, d.y}; }
                    v0 = v0 * sc; v1 = v1 * sc; u32x4 w; w.x = cvt_pk_bf16(v0[0], v0[1]); w.y = cvt_pk_bf16(v0[2], v0[3]); w.z = cvt_pk_bf16(v1[0], v1[1]); w.w = cvt_pk_bf16(v1[2], v1[3]);
                    *(u32x4*)(rowp + bj * HALF) = w; } }
    }
};

__device__ __forceinline__ float gelu_tanh_f(float x) {
    const float y = 1.5957691216057308f * (x + 0.044715f * x * x * x);
    return x * __builtin_amdgcn_rcpf(1.0f + __builtin_amdgcn_exp2f(-1.4426950408889634f * y));
}
__device__ __forceinline__ float silu_f(float x) { return x * __builtin_amdgcn_rcpf(1.0f + __builtin_amdgcn_exp2f(-1.4426950408889634f * x)); }

struct EpiStoreBf16 {
    static constexpr bool PERM = true, AFTER_DRAIN = false;
    bf16_t* O; int ldc; int gelu_from;
    __device__ __forceinline__ void operator()(const f32x4 (&acc)[2][2][4][2], const Unit& u, int wr, int wc, int fr, int fq) const {
        const int row0 = u.pm * BM + wr * 64 + fr, col0 = u.pn * BM + wc * 32 + 8 * fq;
        const bool g = u.pn >= gelu_from;
#pragma unroll
        for (int ai = 0; ai < 2; ++ai)
#pragma unroll
            for (int m = 0; m < 4; ++m) { bf16_t* rowp = O + (size_t)(row0 + ai * HALF + m * 16) * ldc + col0;
#pragma unroll
                for (int bj = 0; bj < 2; ++bj) { f32x4 v0 = acc[ai][bj][m][0], v1 = acc[ai][bj][m][1];
                    if (g) {
#pragma unroll
                        for (int j = 0; j < 4; ++j) { v0[j] = gelu_tanh_f(v0[j]); v1[j] = gelu_tanh_f(v1[j]); } }
                    u32x4 w; w.x = cvt_pk_bf16(v0[0], v0[1]); w.y = cvt_pk_bf16(v0[2], v0[3]); w.z = cvt_pk_bf16(v1[0], v1[1]); w.w = cvt_pk_bf16(v1[2], v1[3]);
                    *(u32x4*)(rowp + bj * HALF) = w; } }
    }
};
struct EpiSwiGLU {
    static constexpr bool PERM = true, AFTER_DRAIN = false;
    bf16_t* O; int ldc;
    __device__ __forceinline__ void operator()(const f32x4 (&acc)[2][2][4][2], const Unit& u, int wr, int wc, int fr, int fq) const {
        const int row0 = u.pm * BM + wr * 64 + fr, col0 = (u.pn * BM + wc * 32 + 8 * fq) >> 1;
#pragma unroll
        for (int ai = 0; ai < 2; ++ai)
#pragma unroll
            for (int m = 0; m < 4; ++m) { bf16_t* rowp = O + (size_t)(row0 + ai * HALF + m * 16) * ldc + col0;
#pragma unroll
                for (int bj = 0; bj < 2; ++bj) { const f32x4 v0 = acc[ai][bj][m][0], v1 = acc[ai][bj][m][1];
                    const float a0 = silu_f(v0[0]) * v0[1], a1 = silu_f(v0[2]) * v0[3], a2 = silu_f(v1[0]) * v1[1], a3 = silu_f(v1[2]) * v1[3];
                    typedef unsigned u32x2 __attribute__((ext_vector_type(2)));
                    u32x2 w; w.x = cvt_pk_bf16(a0, a1); w.y = cvt_pk_bf16(a2, a3);
                    *(u32x2*)(rowp + bj * (HALF / 2)) = w; } }
    }
};
struct EpiResid {
    static constexpr bool PERM = false, AFTER_DRAIN = false;
    const float* xin_p; const float* xin_s; float* xout; const float* gate;
    __device__ __forceinline__ void operator()(const f32x4 (&acc)[2][2][4][2], const Unit& u, int wr, int wc, int fr, int fq) const {
        const int row0 = u.pm * BM + wr * 64 + fr, col0 = u.pn * BM + wc * 32 + 4 * fq;
#pragma unroll
        for (int ai = 0; ai < 2; ++ai)
#pragma unroll
            for (int m = 0; m < 4; ++m) { const int row = row0 + ai * HALF + m * 16;
                if (row < MR) {
                    const int nb = row < TP ? (row >> 11) : BATCH + ((row - TP) >> 2);
                    const float* gp = gate + (size_t)nb * MODW + col0;
                    const float* xi = (row < TP ? xin_p + (size_t)row * D : xin_s + (size_t)(row - TP) * D) + col0;
                    float* xo = xout + (size_t)row * D + col0;
#pragma unroll
                    for (int bj = 0; bj < 2; ++bj)
#pragma unroll
                        for (int n = 0; n < 2; ++n) { const int off = bj * HALF + n * 16;
                            const f32x4 gv = *(const f32x4*)(gp + off), xv = *(const f32x4*)(xi + off);
                            *(f32x4*)(xo + off) = xv + gv * acc[ai][bj][m][n]; } } }
    }
};
template <class Epi, class Sched, bool ALIGN_EPI = false, bool SP2 = false>
__device__ __forceinline__ void gemm_phase(PG8_LAS unsigned char* lds, const Gemm g, const Sched& S, const Epi& E) {
    const int tid = threadIdx.x, wid = __builtin_amdgcn_readfirstlane(tid >> 6), lane = tid & 63, wr = wid >> 2, wc = wid & 3, fr = lane & 15, fq = lane >> 4;
    const int K = g.K, nt = K / BK;
    unsigned voffA[2], voffB[2];
#pragma unroll
    for (int i = 0; i < 2; ++i) { int R, C; stage_rc(tid * 16 + i * 8192, R, C); const int Rb = Epi::PERM ? ((R & ~31) + perm32(R & 31)) : R;
        voffA[i] = (unsigned)(R * K + C) * 2u; voffB[i] = (unsigned)(Rb * K + C) * 2u; }
    const size_t kstep = (size_t)(BK * 2);
    const size_t hstep = (size_t)HALF * K * 2;
    const size_t tstep = 2 * hstep;
    const unsigned ldsw = (unsigned)wid * 1024u;
    const int aoff = lds_byte(wr * 64 + fr, fq * 8), boff = lds_byte(wc * 32 + fr, fq * 8);
#define PG8_SA(b, h) (((b) * 2 + (h)) * HTB)
#define PG8_SB(b, h) ((4 + (b) * 2 + (h)) * HTB)
#define PG8_STAGE(bufoff, gbase, voff) do { _Pragma("unroll") for (int _i = 0; _i < 2; ++_i) \
        __builtin_amdgcn_global_load_lds((const unsigned*)((const char*)(gbase) + (voff)[_i]), (PG8_LAS unsigned*)(lds + (bufoff) + ldsw + _i * 8192), 16, 0, 0); } while (0)
#define PG8_LDA(dst, b, h) do { _Pragma("unroll") for (int m = 0; m < 4; ++m) _Pragma("unroll") for (int k = 0; k < 2; ++k) dst[m][k] = *(const PG8_LAS bf16x8*)(lds + PG8_SA(b, h) + aoff + m * 2048 + k * 1024); } while (0)
#define PG8_LDB(dst, b, h) do { _Pragma("unroll") for (int n = 0; n < 2; ++n) _Pragma("unroll") for (int k = 0; k < 2; ++k) dst[n][k] = *(const PG8_LAS bf16x8*)(lds + PG8_SB(b, h) + boff + n * 2048 + k * 1024); } while (0)
#define PG8_MMA(ai, bj, At, Bt) do { __builtin_amdgcn_s_setprio(1); _Pragma("unroll") for (int m = 0; m < 4; ++m) _Pragma("unroll") for (int n = 0; n < 2; ++n) _Pragma("unroll") for (int k = 0; k < 2; ++k) \
        acc[ai][bj][m][n] = __builtin_amdgcn_mfma_f32_16x16x32_bf16(Bt[n][k], At[m][k], acc[ai][bj][m][n], 0, 0, 0); __builtin_amdgcn_s_setprio(0); } while (0)
#define PG8_WAIT_V(n) asm volatile("s_waitcnt vmcnt(" #n ")" ::: "memory")
#define PG8_WAIT_L(n) asm volatile("s_waitcnt lgkmcnt(" #n ")" ::: "memory")
#define PG8_BAR __builtin_amdgcn_s_barrier()
#define PG8_SCHED __builtin_amdgcn_sched_barrier(0)
    Unit cur, nxt; int ui = 0;
    if (!S.next(0, cur)) return;
    f32x4 acc[2][2][4][2];
#pragma unroll
    for (int a = 0; a < 2; ++a)
#pragma unroll
        for (int b = 0; b < 2; ++b)
#pragma unroll
            for (int m = 0; m < 4; ++m)
#pragma unroll
                for (int n = 0; n < 2; ++n) acc[a][b][m][n] = (f32x4){0.f, 0.f, 0.f, 0.f};
    bf16x8 At[4][2], B0[2][2], B1[2][2];
    const char* cA = (const char*)g.A + (size_t)cur.pm * tstep; const char* cB = (const char*)g.Bt + (size_t)cur.pn * tstep;
    S.a_ready(cur);
    if constexpr (SP2) {
        PG8_STAGE(PG8_SB(0, 0), cB, voffB); PG8_STAGE(PG8_SB(0, 1), cB + hstep, voffB); PG8_STAGE(PG8_SA(0, 0), cA, voffA); PG8_STAGE(PG8_SA(0, 1), cA + hstep, voffA);
        if (wr == 1) PG8_BAR;
        PG8_WAIT_V(2); PG8_BAR;
        PG8_STAGE(PG8_SB(1, 0), cB + kstep, voffB); PG8_STAGE(PG8_SA(1, 0), cA + kstep, voffA); PG8_STAGE(PG8_SB(1, 1), cB + hstep + kstep, voffB);
        PG8_WAIT_V(6); PG8_BAR;
    } else {
        PG8_STAGE(PG8_SB(0, 0), cB, voffB); PG8_STAGE(PG8_SA(0, 0), cA, voffA); PG8_STAGE(PG8_SB(0, 1), cB + hstep, voffB); PG8_STAGE(PG8_SA(0, 1), cA + hstep, voffA);
        if (wr == 1) PG8_BAR;
        PG8_WAIT_V(4); PG8_BAR;
        PG8_STAGE(PG8_SB(1, 0), cB + kstep, voffB); PG8_STAGE(PG8_SA(1, 0), cA + kstep, voffA); PG8_STAGE(PG8_SB(1, 1), cB + hstep + kstep, voffB);
        PG8_WAIT_V(6); PG8_BAR;
    }
    for (;;) {
        const bool has_next = S.next(ui + 1, nxt);
        const char* nA = has_next ? (const char*)g.A + (size_t)nxt.pm * tstep : cA; const char* nB = has_next ? (const char*)g.Bt + (size_t)nxt.pn * tstep : cB;
        for (int t = 0; t < nt; t += 2) {
            const bool last = (t == nt - 2);
            const char* a1 = cA + (size_t)(t + 1) * kstep;
            const char* a2 = last ? nA : cA + (size_t)(t + 2) * kstep; const char* b2 = last ? nB : cB + (size_t)(t + 2) * kstep;
            const char* a3 = a2 + kstep; const char* b3 = b2 + kstep;
            if (last && has_next) S.a_ready(nxt);
            if constexpr (SP2) {
            PG8_LDB(B0, 0, 0); PG8_LDB(B1, 0, 1); PG8_SCHED; PG8_LDA(At, 0, 0); PG8_STAGE(PG8_SA(1, 1), a1 + hstep, voffA);
            PG8_WAIT_V(8); PG8_WAIT_L(0); PG8_BAR; PG8_MMA(0, 0, At, B0); PG8_MMA(0, 1, At, B1); PG8_BAR; PG8_SCHED;
            PG8_LDA(At, 0, 1); PG8_STAGE(PG8_SB(0, 0), b2, voffB); PG8_STAGE(PG8_SB(0, 1), b2 + hstep, voffB); PG8_STAGE(PG8_SA(0, 0), a2, voffA);
            PG8_WAIT_V(8); PG8_WAIT_L(0); PG8_BAR; PG8_MMA(1, 0, At, B0); PG8_MMA(1, 1, At, B1); PG8_BAR; PG8_SCHED;
            PG8_LDB(B0, 1, 0); PG8_LDB(B1, 1, 1); PG8_SCHED; PG8_LDA(At, 1, 0); PG8_STAGE(PG8_SA(0, 1), a2 + hstep, voffA);
            PG8_WAIT_V(8); PG8_WAIT_L(0); PG8_BAR; PG8_MMA(0, 0, At, B0); PG8_MMA(0, 1, At, B1); PG8_BAR; PG8_SCHED;
            PG8_LDA(At, 1, 1); PG8_STAGE(PG8_SB(1, 0), b3, voffB); PG8_STAGE(PG8_SB(1, 1), b3 + hstep, voffB); PG8_STAGE(PG8_SA(1, 0), a3, voffA);
            PG8_WAIT_V(8); PG8_WAIT_L(0); PG8_BAR; PG8_MMA(1, 0, At, B0); PG8_MMA(1, 1, At, B1); PG8_BAR; PG8_SCHED;
            } else {
            PG8_LDB(B0, 0, 0); PG8_SCHED; PG8_LDA(At, 0, 0); PG8_STAGE(PG8_SA(1, 1), a1 + hstep, voffA);
            PG8_WAIT_L(8); PG8_BAR; PG8_WAIT_L(0); PG8_MMA(0, 0, At, B0); PG8_BAR; PG8_SCHED;
            PG8_LDB(B1, 0, 1); PG8_STAGE(PG8_SB(0, 0), b2, voffB);
            PG8_BAR; PG8_WAIT_L(0); PG8_MMA(0, 1, At, B1); PG8_BAR;
            PG8_LDA(At, 0, 1); PG8_STAGE(PG8_SA(0, 0), a2, voffA);
            PG8_BAR; PG8_WAIT_L(0); PG8_MMA(1, 0, At, B0); PG8_BAR; PG8_SCHED;
            PG8_STAGE(PG8_SB(0, 1), b2 + hstep, voffB);
            PG8_WAIT_V(6); PG8_BAR; PG8_MMA(1, 1, At, B1); PG8_BAR;
            PG8_LDB(B0, 1, 0); PG8_SCHED; PG8_LDA(At, 1, 0); PG8_STAGE(PG8_SA(0, 1), a2 + hstep, voffA);
            PG8_WAIT_L(8); PG8_BAR; PG8_WAIT_L(0); PG8_MMA(0, 0, At, B0); PG8_BAR; PG8_SCHED;
            PG8_LDB(B1, 1, 1); PG8_STAGE(PG8_SB(1, 0), b3, voffB);
            PG8_BAR; PG8_WAIT_L(0); PG8_MMA(0, 1, At, B1); PG8_BAR;
            PG8_LDA(At, 1, 1); PG8_STAGE(PG8_SA(1, 0), a3, voffA);
            PG8_BAR; PG8_WAIT_L(0); PG8_MMA(1, 0, At, B0); PG8_BAR; PG8_SCHED;
            PG8_STAGE(PG8_SB(1, 1), b3 + hstep, voffB);
            PG8_WAIT_V(6); PG8_BAR; PG8_MMA(1, 1, At, B1); PG8_BAR;
            }
        }
        if constexpr (ALIGN_EPI) { if (wr == 0) PG8_BAR; }
        if constexpr (!Epi::AFTER_DRAIN) { E(acc, cur, wr, wc, fr, fq); S.done(cur); }
        if (!has_next) break;
#pragma unroll
        for (int a = 0; a < 2; ++a)
#pragma unroll
            for (int b = 0; b < 2; ++b)
#pragma unroll
                for (int m = 0; m < 4; ++m)
#pragma unroll
                    for (int n = 0; n < 2; ++n) acc[a][b][m][n] = (f32x4){0.f, 0.f, 0.f, 0.f};
        cur = nxt; cA = nA; cB = nB; ++ui;
        if constexpr (ALIGN_EPI) { if (wr == 1) PG8_BAR; }
    }
    PG8_WAIT_V(0);
    if constexpr (!ALIGN_EPI) { if (wr == 0) PG8_BAR; }
    PG8_BAR;
    if constexpr (Epi::AFTER_DRAIN) { E.fused(acc, cur, wr, wc, fr, fq, lds, wid, lane); S.done(cur); }
#undef PG8_SA
#undef PG8_SB
#undef PG8_STAGE
#undef PG8_LDA
#undef PG8_LDB
#undef PG8_MMA
#undef PG8_WAIT_V
#undef PG8_WAIT_L
#undef PG8_BAR
#undef PG8_SCHED
}
}

#define GAS __attribute__((address_space(1)))
#define LAS __attribute__((address_space(3)))
typedef unsigned short bf16;
typedef float f32x4 __attribute__((ext_vector_type(4)));
typedef short bf16x8 __attribute__((ext_vector_type(8)));
typedef unsigned u32x4 __attribute__((ext_vector_type(4)));
typedef unsigned u32x2 __attribute__((ext_vector_type(2)));

constexpr int NWAVES = 8, NTHR = 512;
constexpr int LDS_BYTES = 147456;
constexpr int NPHASE = 17;
constexpr int LDSCTL_OFF = 131072;
constexpr int CW_BAR = 4096;
constexpr size_t CTL_ZERO_BYTES = 65536;

enum { I_XP = 0, I_XS, I_CP, I_CS, I_SA, I_KV0, I_KV1, I_KV2, I_SC, I_RB, I_ADAW, I_ADAB, I_NMG, I_NFG, I_WGU, I_WDN, I_FNG, I_EWIN, I_ACW, I_ACB,
       I_ALG, I_ALB, I_EWOUT, I_OWIN, I_CCW, I_CCB, I_DLG, I_DLB, I_DSW, I_DSB, I_OWOUT, N_IN };
constexpr size_t O_YP = 0, O_YS = O_YP + (size_t)TP * D, O_AP = O_YS + (size_t)TS * D, O_AS = O_AP + (size_t)BATCH * 30 * 256,
    O_KV0P = O_AS + (size_t)DEC_BATCH * 30 * 256, O_KV0S = O_KV0P + (size_t)BATCH * 128 * 512, O_KV1P = O_KV0S + (size_t)DEC_BATCH * 128 * 512,
    O_KV1S = O_KV1P + (size_t)BATCH * 512 * 512, O_KV2P = O_KV1S + (size_t)DEC_BATCH * 512 * 512, O_KV2S = O_KV2P + (size_t)BATCH * 2048 * 512,
    O_CP = O_KV2S + (size_t)DEC_BATCH * 2048 * 512, O_CS = O_CP + (size_t)BATCH * 2 * 512, O_DV = O_CS + (size_t)DEC_BATCH * 2 * 512,
    O_END = O_DV + (size_t)DEC_BATCH * 4 * 512;
static_assert(O_END == 72372224, "output size");
constexpr size_t al256(size_t x) { return (x + 255) & ~(size_t)255; }
constexpr size_t WS_CTL = 0, WS_CTL_BYTES = 1u << 20;
constexpr size_t WS_WEIN = WS_CTL + WS_CTL_BYTES;
constexpr size_t WS_WEOUT = WS_WEIN + (size_t)E_IN * D * 2;
constexpr size_t WS_WGU0 = WS_WEOUT + (size_t)D * 512 * 2;
constexpr size_t WS_WGU1 = WS_WGU0 + (size_t)2 * FFN * D * 2;
constexpr size_t WS_WDN0 = WS_WGU1 + (size_t)2 * FFN * D * 2;
constexpr size_t WS_WDN1 = WS_WDN0 + (size_t)D * FFN * 2;
constexpr size_t WS_WOIN = WS_WDN1 + (size_t)D * FFN * 2;
constexpr size_t WS_WOOUT = WS_WOIN + (size_t)O_IN * D * 2;
constexpr size_t WS_MOD = WS_WOOUT + (size_t)D * D * 2;
constexpr size_t WS_X = al256(WS_MOD + (size_t)2 * NB * MODW * 4);
constexpr size_t WS_H = WS_X + (size_t)MP * D * 4;
constexpr size_t WS_PROJ = WS_H + (size_t)MP * D * 2;
constexpr size_t WS_MIX = WS_PROJ + (size_t)MP * E_IN * 2;
constexpr size_t WS_ACT = WS_MIX + (size_t)MP * D * 2;
constexpr size_t WS_OG = WS_ACT + (size_t)MP * FFN * 2;
constexpr size_t WS_LSE = WS_OG + (size_t)3 * MR * 256 * 4;
constexpr size_t WS_WSB = al256(WS_LSE + (size_t)3 * MR * 4 * 4);
constexpr size_t WS_END = al256(WS_WSB + (size_t)4 * 128 * 128 * 2);

struct Params { const float* in[N_IN]; float* out; unsigned char* ws; int ph_lo, ph_hi; };
static_assert(sizeof(Params) == 8 * N_IN + 8 + 8 + 8, "Params has no padding");

__device__ const unsigned char BUCKET[3][132] = {
 {0,1,2,3,4,5,6,7,8,9,10,11,12,13,14,15,16,16,16,16,16,16,17,17,17,17,17,17,17,17,18,18,18,18,18,18,18,18,18,18,19,19,19,19,19,19,19,19,19,19,19,19,19,19,20,20,20,20,20,20,20,20,20,20,20,20,20,20,20,20,20,20,20,21,21,21,21,21,21,21,21,21,21,21,21,21,21,21,21,21,21,21,21,21,21,21,21,21,21,22,22,22,22,22,22,22,22,22,22,22,22,22,22,22,22,22,22,22,22,22,22,22,22,22,22,22,22,22,22,0,0,0},
 {0,4,8,12,16,16,17,17,18,18,19,19,19,19,20,20,20,20,20,21,21,21,21,21,21,22,22,22,22,22,22,22,22,22,23,23,23,23,23,23,23,23,23,23,23,23,24,24,24,24,24,24,24,24,24,24,24,24,24,24,24,24,25,25,25,25,25,25,25,25,25,25,25,25,25,25,25,25,25,25,25,25,25,26,26,26,26,26,26,26,26,26,26,26,26,26,26,26,26,26,26,26,26,26,26,26,26,26,26,26,26,26,26,27,27,27,27,27,27,27,27,27,27,27,27,27,27,27,27,0,0,0},
 {0,16,18,19,20,21,21,22,22,23,23,23,24,24,24,24,25,25,25,25,25,26,26,26,26,26,26,26,26,27,27,27,27,27,27,27,27,27,27,28,28,28,28,28,28,28,28,28,28,28,28,28,29,29,29,29,29,29,29,29,29,29,29,29,29,29,29,29,29,29,30,30,30,30,30,30,30,30,30,30,30,30,30,30,30,30,30,30,30,30,30,30,30,30,30,31,31,31,31,31,31,31,31,31,31,31,31,31,31,31,31,31,31,31,31,31,31,31,31,31,31,31,31,31,31,31,31,31,31,0,0,0}};

__device__ __forceinline__ float bf2f(unsigned b) { return __uint_as_float(b << 16); }
__device__ __forceinline__ unsigned f2bf(float f) { unsigned u = __float_as_uint(f); return (u + 0x7fffu + ((u >> 16) & 1u)) >> 16; }
__device__ __forceinline__ unsigned pk2(float lo, float hi) { return f2bf(lo) | (f2bf(hi) << 16); }
__device__ __forceinline__ float wave_sum(float v) {
#pragma unroll
    for (int o = 1; o < 64; o <<= 1) v += __shfl_xor(v, o);
    return v;
}
__device__ __forceinline__ float wave_max(float v) {
#pragma unroll
    for (int o = 1; o < 64; o <<= 1) v = fmaxf(v, __shfl_xor(v, o));
    return v;
}
__device__ __forceinline__ void unpack8(const u32x4 w, float (&f)[8]) {
    f[0] = bf2f(w.x & 0xffffu); f[1] = bf2f(w.x >> 16); f[2] = bf2f(w.y & 0xffffu); f[3] = bf2f(w.y >> 16);
    f[4] = bf2f(w.z & 0xffffu); f[5] = bf2f(w.z >> 16); f[6] = bf2f(w.w & 0xffffu); f[7] = bf2f(w.w >> 16);
}
__device__ __forceinline__ int batch_of(int row) { return row < TP ? (row >> 11) : BATCH + ((row - TP) >> 2); }
#define LDS_WAIT() asm volatile("s_waitcnt lgkmcnt(0)" ::: "memory")

__device__ __forceinline__ void transpose_item(const float* W, int K, int N, bf16* WT, bool ilv, LAS float* scr, int item, int lane) {
    const int nblk = N / 32, kb = item / nblk, nb = item % nblk, k0 = 64 * kb, n0 = 32 * nb;
#pragma unroll 8
    for (int i = 0; i < 32; ++i) { const int kk = 2 * i + (lane >> 5); scr[kk * 33 + (lane & 31)] = W[(size_t)(k0 + kk) * N + n0 + (lane & 31)]; }
    LDS_WAIT();
    const int c = lane & 7;
#pragma unroll
    for (int j = 0; j < 4; ++j) { const int n = (lane >> 3) + 8 * j; const LAS float* s = scr + (8 * c) * 33 + n;
        u32x4 o; o.x = pk2(s[0 * 33], s[1 * 33]); o.y = pk2(s[2 * 33], s[3 * 33]); o.z = pk2(s[4 * 33], s[5 * 33]); o.w = pk2(s[6 * 33], s[7 * 33]);
        const int col = n0 + n; const int orow = ilv ? (col < FFN ? 2 * col : 2 * (col - FFN) + 1) : col;
        *(u32x4*)(WT + (size_t)orow * K + k0 + 8 * c) = o; }
    LDS_WAIT();
}

__device__ __forceinline__ void adaln_item(const Params& p, LAS unsigned char* lds, int it) {
    int tid = threadIdx.x; asm volatile("" : "+v"(tid));
    const int lane = tid & 63, wave = tid >> 6;
    const int l = it / 96, j0 = (it % 96) * 64;
    LAS float* s = (LAS float*)lds;
    const float* cp = p.in[I_CP]; const float* cs = p.in[I_CS];
    float* mod = (float*)(p.ws + WS_MOD);
    float acc[NB];
#pragma unroll
    for (int n = 0; n < NB; ++n) acc[n] = 0.f;
    for (int kh = 0; kh < 2; ++kh) {
        __syncthreads();
        for (int idx = tid; idx < NB * 512; idx += NTHR) { const int n = idx >> 9, k = idx & 511;
            const float c = n < BATCH ? cp[n * D + kh * 512 + k] : cs[(n - BATCH) * D + kh * 512 + k];
            s[idx] = c / (1.0f + expf(-c)); }
        __syncthreads();
        const float* wp = p.in[I_ADAW] + ((size_t)l * D + kh * 512 + wave * 64) * MODW + j0 + lane;
#pragma unroll 1
        for (int kb = 0; kb < 4; ++kb) {
            float wv[16];
#pragma unroll
            for (int q = 0; q < 16; ++q) wv[q] = wp[(size_t)(16 * kb + q) * MODW];
#pragma unroll
            for (int n = 0; n < NB; ++n) {
#pragma unroll
                for (int q4 = 0; q4 < 4; ++q4) { const f32x4 sv = *(const LAS f32x4*)(s + n * 512 + wave * 64 + 16 * kb + 4 * q4);
                    acc[n] += (sv.x * wv[4 * q4] + sv.y * wv[4 * q4 + 1]) + (sv.z * wv[4 * q4 + 2] + sv.w * wv[4 * q4 + 3]); } }
        }
    }
    __syncthreads();
    LAS float* red = (LAS float*)lds;
#pragma unroll
    for (int n = 0; n < NB; ++n) red[(wave * NB + n) * 64 + lane] = acc[n];
    __syncthreads();
    for (int idx = tid; idx < NB * 64; idx += NTHR) { const int n = idx >> 6, j = idx & 63; float t = 0.f;
#pragma unroll
        for (int w = 0; w < NWAVES; ++w) t += red[(w * NB + n) * 64 + j];
        mod[((size_t)l * NB + n) * MODW + j0 + j] = t + p.in[I_ADAB][l * MODW + j0 + j]; }
    __syncthreads();
}

__device__ __forceinline__ void phase0(const Params& p, LAS unsigned char* lds) {
    const int tid = threadIdx.x, lane = tid & 63, wave = tid >> 6;
    for (int it = blockIdx.x; it < 192; it += gridDim.x) adaln_item(p, lds, it);
    __syncthreads();
    {
        LAS float* scr = (LAS float*)(lds + wave * 16384);
        const int gw = blockIdx.x * NWAVES + wave, NGW = gridDim.x * NWAVES;
        constexpr int I0 = (D / 64) * (E_IN / 32), I1 = (512 / 64) * (D / 32), I2 = (D / 64) * (2 * FFN / 32), I3 = (FFN / 64) * (D / 32), I4 = (D / 64) * (O_IN / 32), I5 = (D / 64) * (D / 32);
        constexpr int NIT = I0 + I1 + 2 * I2 + 2 * I3 + I4 + I5;
        for (int it = gw; it < NIT; it += NGW) {
            int r = it;
            if (r < I0) { transpose_item(p.in[I_EWIN], D, E_IN, (bf16*)(p.ws + WS_WEIN), false, scr, r, lane); continue; } r -= I0;
            if (r < I1) { transpose_item(p.in[I_EWOUT], 512, D, (bf16*)(p.ws + WS_WEOUT), false, scr, r, lane); continue; } r -= I1;
            if (r < I2) { transpose_item(p.in[I_WGU], D, 2 * FFN, (bf16*)(p.ws + WS_WGU0), true, scr, r, lane); continue; } r -= I2;
            if (r < I2) { transpose_item(p.in[I_WGU] + (size_t)D * 2 * FFN, D, 2 * FFN, (bf16*)(p.ws + WS_WGU1), true, scr, r, lane); continue; } r -= I2;
            if (r < I3) { transpose_item(p.in[I_WDN], FFN, D, (bf16*)(p.ws + WS_WDN0), false, scr, r, lane); continue; } r -= I3;
            if (r < I3) { transpose_item(p.in[I_WDN] + (size_t)FFN * D, FFN, D, (bf16*)(p.ws + WS_WDN1), false, scr, r, lane); continue; } r -= I3;
            if (r < I4) { transpose_item(p.in[I_OWIN], D, O_IN, (bf16*)(p.ws + WS_WOIN), false, scr, r, lane); continue; } r -= I4;
            transpose_item(p.in[I_OWOUT], D, D, (bf16*)(p.ws + WS_WOOUT), false, scr, r, lane);
        }
    }
    {
        bf16* wsb = (bf16*)(p.ws + WS_WSB);
        for (int idx = blockIdx.x * NTHR + tid; idx < 4 * 128 * 128; idx += gridDim.x * NTHR) { const int ii = (idx >> 7) & 127, jj = idx & 127;
            wsb[idx] = (bf16)(jj <= ii ? f2bf(p.in[I_DSW][idx]) : 0u); }
    }
    {
        const size_t gt = (size_t)blockIdx.x * NTHR + tid, NGT = (size_t)gridDim.x * NTHR;
#pragma unroll
        for (int g = 0; g < 3; ++g) {
            const int Wb = 128 << (2 * g);
            const f32x4* src = (const f32x4*)p.in[I_KV0 + g];
            f32x4* dst = (f32x4*)(p.out + (g == 0 ? O_KV0S : g == 1 ? O_KV1S : O_KV2S));
            const unsigned cnt = (unsigned)(Wb - 4) * 128u, total = (unsigned)DEC_BATCH * cnt;
            for (unsigned i0 = (unsigned)gt; i0 < total; i0 += 8u * (unsigned)NGT) {
                f32x4 v[8]; unsigned di[8];
#pragma unroll
                for (int u = 0; u < 8; ++u) { const unsigned i = i0 + u * (unsigned)NGT; const unsigned ic = i < total ? i : total - 1u; const unsigned n = ic / cnt;
                    di[u] = ic + n * 512u; v[u] = __builtin_nontemporal_load(src + di[u] + 512u); }
#pragma unroll
                for (int u = 0; u < 8; ++u) if (i0 + u * (unsigned)NGT < total) __builtin_nontemporal_store(v[u], dst + di[u]);
            }
        }
    }
}

template <bool FINAL>
__device__ __forceinline__ void norm_phase(const float* xp, const float* xs, const float* g, const float* shift, const float* scale, bf16* H, float* outp, float* outs) {
    const int tid = threadIdx.x, lane = tid & 63, wave = tid >> 6;
    const int gw = blockIdx.x * NWAVES + wave, NGW = gridDim.x * NWAVES;
    constexpr int NR = FINAL ? MR : MP;
    f32x4 gv[4];
#pragma unroll
    for (int j = 0; j < 4; ++j) gv[j] = ((const f32x4*)g)[lane + 64 * j];
    for (int row0 = gw; row0 < NR; row0 += 2 * NGW) {
        f32x4 v[2][4], sh[2][4], sc[2][4]; int rows[2]; bool real[2];
#pragma unroll
        for (int u = 0; u < 2; ++u) { const int row = row0 + u * NGW; rows[u] = row; real[u] = row < MR;
            const int rc = real[u] ? row : MR - 1;
            const float* xr = rc < TP ? xp + (size_t)rc * D : xs + (size_t)(rc - TP) * D;
#pragma unroll
            for (int j = 0; j < 4; ++j) v[u][j] = ((const f32x4*)xr)[lane + 64 * j];
            if (!FINAL) { const int nb = batch_of(rc);
#pragma unroll
                for (int j = 0; j < 4; ++j) { sh[u][j] = ((const f32x4*)(shift + (size_t)nb * MODW))[lane + 64 * j]; sc[u][j] = ((const f32x4*)(scale + (size_t)nb * MODW))[lane + 64 * j]; } } }
#pragma unroll
        for (int u = 0; u < 2; ++u) { const int row = rows[u];
            if (row >= NR) continue;
            float ss = 0.f;
#pragma unroll
            for (int j = 0; j < 4; ++j) ss += (v[u][j].x * v[u][j].x + v[u][j].y * v[u][j].y) + (v[u][j].z * v[u][j].z + v[u][j].w * v[u][j].w);
            const float rstd = 1.0f / sqrtf(wave_sum(ss) * (1.0f / D) + EPS);
            if (FINAL) {
                float* o = row < TP ? outp + (size_t)row * D : outs + (size_t)(row - TP) * D;
#pragma unroll
                for (int j = 0; j < 4; ++j) ((f32x4*)o)[lane + 64 * j] = v[u][j] * rstd * gv[j];
            } else {
#pragma unroll
                for (int j = 0; j < 4; ++j) { f32x4 y = v[u][j] * rstd * gv[j] * (sc[u][j] + 1.0f) + sh[u][j];
                    if (!real[u]) y = (f32x4){0.f, 0.f, 0.f, 0.f};
                    *(u32x2*)(H + (size_t)row * D + 4 * lane + 256 * j) = (u32x2){pk2(y.x, y.y), pk2(y.z, y.w)}; }
            }
        }
    }
}

#ifndef DBG_P3
#define DBG_P3 31
#endif
constexpr int QCOL = 512, KCOL = 1280, VCOL = 2048;
constexpr int VT_PITCH = 264;
constexpr int AT_VT = 0, AT_P = 64 * VT_PITCH * 2, AT_PW = 16 * VT_PITCH * 2, AT_BIAS = AT_P + NWAVES * AT_PW;
static_assert(AT_BIAS + 132 * 4 <= 131072, "attention LDS");

__device__ __forceinline__ void attn_unit(const Params& p, LAS unsigned char* lds, int u) {
    int tid = threadIdx.x; asm volatile("" : "+v"(tid));
    const int lane = tid & 63, wave = tid >> 6, fr = lane & 15, fq = lane >> 4;
    const int b = u / 192, v_ = u % 192, g = v_ / 64, w_ = v_ % 64, h = w_ / 16, x_ = w_ % 16;
    const int dl = 2 * g, d = 1 << dl, nblk = 16 >> dl, r = x_ / nblk, i = x_ % nblk;
    const bf16* PROJ = (const bf16*)(p.ws + WS_PROJ);
    LAS bf16* Vt = (LAS bf16*)(lds + AT_VT);
    LAS bf16* Pw = (LAS bf16*)(lds + AT_P + wave * AT_PW);
    LAS float* biasl = (LAS float*)(lds + AT_BIAS);
    const int kt0 = (i == 0) ? 8 : 0;
    const size_t rowbase = (size_t)b * SEQ;
    {
        const int kl = tid & 255, half = tid >> 8; const int mk = 128 * (i - 1) + kl;
        u32x4 w[4];
        if (mk >= 0) { const bf16* vp = PROJ + (rowbase + (size_t)mk * d + r) * E_IN + VCOL + g * 256 + h * 64 + 32 * half;
#pragma unroll
            for (int c = 0; c < 4; ++c) w[c] = *(const u32x4*)(vp + 8 * c);
        } else {
#pragma unroll
            for (int c = 0; c < 4; ++c) w[c] = (u32x4){0u, 0u, 0u, 0u};
        }
#pragma unroll
        for (int c = 0; c < 4; ++c) { const unsigned ww[4] = {w[c].x, w[c].y, w[c].z, w[c].w};
#pragma unroll
            for (int e = 0; e < 4; ++e) { const int dd = 32 * half + 8 * c + 2 * e;
                Vt[dd * VT_PITCH + kl] = (bf16)(ww[e] & 0xffffu); Vt[(dd + 1) * VT_PITCH + kl] = (bf16)(ww[e] >> 16); } }
        if (tid < 129) biasl[tid] = p.in[I_RB][BUCKET[g][tid] * 12 + g * 4 + h];
    }
    bf16x8 qa[2];
    {
        const int mq = 128 * i + 16 * wave + fr;
        const bf16* qp = PROJ + (rowbase + (size_t)mq * d + r) * E_IN + QCOL + g * 256 + h * 64 + 8 * fq;
        qa[0] = *(const bf16x8*)qp; qa[1] = *(const bf16x8*)(qp + 32);
    }
    f32x4 sacc[16];
#pragma unroll
    for (int kt = 0; kt < 16; ++kt) {
        sacc[kt] = (f32x4){0.f, 0.f, 0.f, 0.f};
        if (kt >= kt0) {
            const int mk = 128 * (i - 1) + 16 * kt + fr;
            const bf16* kp = PROJ + (rowbase + (size_t)mk * d + r) * E_IN + KCOL + g * 256 + h * 64 + 8 * fq;
            const bf16x8 k0 = *(const bf16x8*)kp, k1 = *(const bf16x8*)(kp + 32);
            sacc[kt] = __builtin_amdgcn_mfma_f32_16x16x32_bf16(qa[0], k0, sacc[kt], 0, 0, 0);
            sacc[kt] = __builtin_amdgcn_mfma_f32_16x16x32_bf16(qa[1], k1, sacc[kt], 0, 0, 0);
        }
    }
    __syncthreads();
    float mx[4] = {-INFINITY, -INFINITY, -INFINITY, -INFINITY};
#pragma unroll
    for (int kt = 0; kt < 16; ++kt) {
#pragma unroll
        for (int rg = 0; rg < 4; ++rg) {
            const int rel = (16 * wave + 4 * fq + rg) + 128 - (16 * kt + fr);
            const bool ok = (kt >= kt0) && rel >= 0 && rel <= 128;
            const float sv = ok ? sacc[kt][rg] * 0.125f + biasl[ok ? rel : 0] : -INFINITY;
            sacc[kt][rg] = sv; mx[rg] = fmaxf(mx[rg], sv);
        }
    }
#pragma unroll
    for (int rg = 0; rg < 4; ++rg) {
#pragma unroll
        for (int o = 1; o < 16; o <<= 1) mx[rg] = fmaxf(mx[rg], __shfl_xor(mx[rg], o));
    }
    float ls[4] = {0.f, 0.f, 0.f, 0.f};
#pragma unroll
    for (int kt = 0; kt < 16; ++kt) {
#pragma unroll
        for (int rg = 0; rg < 4; ++rg) {
            const float e = __builtin_amdgcn_exp2f((sacc[kt][rg] - mx[rg]) * 1.4426950408889634f);
            ls[rg] += e;
            Pw[(4 * fq + rg) * VT_PITCH + 16 * kt + fr] = (bf16)f2bf(e);
        }
    }
#pragma unroll
    for (int rg = 0; rg < 4; ++rg) {
#pragma unroll
        for (int o = 1; o < 16; o <<= 1) ls[rg] += __shfl_xor(ls[rg], o);
    }
    __syncthreads();
    f32x4 oacc[4];
#pragma unroll
    for (int nd = 0; nd < 4; ++nd) oacc[nd] = (f32x4){0.f, 0.f, 0.f, 0.f};
#pragma unroll
    for (int ks = 0; ks < 8; ++ks) {
        if (2 * ks >= kt0) {
            const bf16x8 pa = *(const LAS bf16x8*)(Pw + fr * VT_PITCH + 32 * ks + 8 * fq);
#pragma unroll
            for (int nd = 0; nd < 4; ++nd) {
                const bf16x8 vb = *(const LAS bf16x8*)(Vt + (16 * nd + fr) * VT_PITCH + 32 * ks + 8 * fq);
                oacc[nd] = __builtin_amdgcn_mfma_f32_16x16x32_bf16(pa, vb, oacc[nd], 0, 0, 0);
            }
        }
    }
    float* OG = (float*)(p.ws + WS_OG) + (size_t)g * MR * 256;
    float* LSE = (float*)(p.ws + WS_LSE) + (size_t)g * MR * 4;
#pragma unroll
    for (int rg = 0; rg < 4; ++rg) {
        const int mq = 128 * i + 16 * wave + 4 * fq + rg; const size_t row = rowbase + (size_t)mq * d + r;
        const float inv = 1.0f / ls[rg];
#pragma unroll
        for (int nd = 0; nd < 4; ++nd) OG[row * 256 + h * 64 + 16 * nd + fr] = oacc[nd][rg] * inv;
        if (fr == 0) LSE[row * 4 + h] = mx[rg] + logf(ls[rg]);
    }
    __syncthreads();
}

constexpr int CA_GLU = 0, CA_Y = 62 * 256 * 4;
__device__ __forceinline__ void conva_item(const Params& p, LAS unsigned char* lds, bool sample, int bn, int t0) {
    int tid = threadIdx.x; asm volatile("" : "+v"(tid));
    const int lane = tid & 63, wave = tid >> 6;
    const bf16* PROJ = (const bf16*)(p.ws + WS_PROJ);
    bf16* MIX = (bf16*)(p.ws + WS_MIX);
    LAS float* glu = (LAS float*)(lds + CA_GLU); LAS float* ys = (LAS float*)(lds + CA_Y);
    const int c = tid & 255, th = tid >> 8;
    const int RR = sample ? 34 : 62, NT = sample ? 4 : 32;
    {
        u32x4 ra[4], rg[4]; f32x4 s0[4], s1[4];
#pragma unroll
        for (int q = 0; q < 4; ++q) { const int v = tid + q * NTHR; const int rr = v >> 5, cv = (v & 31) * 8;
            ra[q] = (u32x4){0u, 0u, 0u, 0u}; rg[q] = ra[q]; s0[q] = (f32x4){0.f, 0.f, 0.f, 0.f}; s1[q] = s0[q];
            if (rr < RR) {
                if (sample && rr < 30) { const float* sp = p.in[I_SA] + ((size_t)bn * 30 + rr) * 256 + cv; s0[q] = *(const f32x4*)sp; s1[q] = *(const f32x4*)(sp + 4); }
                else { const int t = sample ? rr - 30 : t0 - 30 + rr; const int tc = t < 0 ? 0 : t;
                    const bf16* pr = PROJ + (sample ? (size_t)(TP + 4 * bn + tc) : (size_t)bn * SEQ + tc) * E_IN + cv;
                    ra[q] = *(const u32x4*)pr; rg[q] = *(const u32x4*)(pr + 256); } } }
#pragma unroll
        for (int q = 0; q < 4; ++q) { const int v = tid + q * NTHR; const int rr = v >> 5, cv = (v & 31) * 8;
            if (rr < RR) {
                f32x4 o0 = s0[q], o1 = s1[q];
                if (!(sample && rr < 30)) { const int t = sample ? rr - 30 : t0 - 30 + rr;
                    float a[8], gt[8]; unpack8(ra[q], a); unpack8(rg[q], gt);
                    float y[8];
#pragma unroll
                    for (int e = 0; e < 8; ++e) y[e] = t < 0 ? 0.f : a[e] / (1.0f + expf(-gt[e]));
                    o0 = (f32x4){y[0], y[1], y[2], y[3]}; o1 = (f32x4){y[4], y[5], y[6], y[7]}; }
                *(LAS f32x4*)(glu + rr * 256 + cv) = o0; *(LAS f32x4*)(glu + rr * 256 + cv + 4) = o1; } }
    }
    __syncthreads();
    if (sample) { float* o = p.out + O_AS + (size_t)bn * 30 * 256; for (int j = th; j < 30; j += 2) o[j * 256 + c] = glu[(j + 4) * 256 + c]; }
    else if (t0 == SEQ - 32) { float* o = p.out + O_AP + (size_t)bn * 30 * 256; for (int j = th; j < 30; j += 2) o[j * 256 + c] = glu[(j + 32) * 256 + c]; }
    {
        float win[46];
#pragma unroll
        for (int q = 0; q < 46; ++q) { const int rr = 16 * th + q; win[q] = rr < RR ? glu[rr * 256 + c] : 0.f; }
        float y[16]; const float bb = p.in[I_ACB][c];
#pragma unroll
        for (int q = 0; q < 16; ++q) y[q] = bb;
#pragma unroll
        for (int k = 0; k < 31; ++k) { const float wk = p.in[I_ACW][k * 256 + c];
#pragma unroll
            for (int q = 0; q < 16; ++q) y[q] += wk * win[q + k]; }
#pragma unroll
        for (int q = 0; q < 16; ++q) ys[(16 * th + q) * 256 + c] = y[q];
    }
    __syncthreads();
    const f32x4 lg = ((const f32x4*)p.in[I_ALG])[lane], lb = ((const f32x4*)p.in[I_ALB])[lane];
#pragma unroll
    for (int q = 0; q < 4; ++q) { const int tl = 4 * wave + q;
        if (tl < NT) {
            const f32x4 v = *(const LAS f32x4*)(ys + tl * 256 + 4 * lane);
            const float mu = wave_sum((v.x + v.y) + (v.z + v.w)) * (1.0f / 256.0f);
            const f32x4 dv = v - mu;
            const float var = wave_sum((dv.x * dv.x + dv.y * dv.y) + (dv.z * dv.z + dv.w * dv.w)) * (1.0f / 256.0f);
            const float rstd = 1.0f / sqrtf(var + EPS);
            f32x4 y = dv * rstd * lg + lb;
            y.x = y.x / (1.0f + expf(-y.x)); y.y = y.y / (1.0f + expf(-y.y)); y.z = y.z / (1.0f + expf(-y.z)); y.w = y.w / (1.0f + expf(-y.w));
            const size_t row = sample ? (size_t)(TP + 4 * bn + tl) : (size_t)bn * SEQ + t0 + tl;
            *(u32x2*)(MIX + row * 512 + 4 * lane) = (u32x2){pk2(y.x, y.y), pk2(y.z, y.w)};
        } }
    __syncthreads();
}

constexpr int SA_NEW = 0, SA_Q = 4 * 2 * 256 * 4, SA_P = SA_Q + 4 * 256 * 4;
__device__ __forceinline__ void sattn_item(const Params& p, LAS unsigned char* lds, int n, int g) {
    int tid = threadIdx.x; asm volatile("" : "+v"(tid));
    const int lane = tid & 63, wave = tid >> 6;
    const bf16* PROJ = (const bf16*)(p.ws + WS_PROJ);
    const int dl = 2 * g, d = 1 << dl, Wb = 128 << dl;
    const float* cache = p.in[I_KV0 + g] + (size_t)n * Wb * 512;
    float* kvout = p.out + (g == 0 ? O_KV0S : g == 1 ? O_KV1S : O_KV2S) + (size_t)n * Wb * 512;
    LAS float* newkv = (LAS float*)(lds + SA_NEW); LAS float* qs = (LAS float*)(lds + SA_Q); LAS float* pw = (LAS float*)(lds + SA_P) + wave * 192;
    for (int idx = tid; idx < 4 * 3 * 256; idx += NTHR) { const int s = idx / 768, rem = idx % 768, which = rem >> 8, col = rem & 255;
        const float v = bf2f(PROJ[(size_t)(TP + 4 * n + s) * E_IN + QCOL + (which * 3 + g) * 256 + col]);
        if (which == 0) qs[s * 256 + col] = v;
        else { newkv[(s * 2 + which - 1) * 256 + col] = v; kvout[((size_t)(Wb - 4 + s) * 2 + which - 1) * 256 + col] = v; } }
    __syncthreads();
    float* OG = (float*)(p.ws + WS_OG) + (size_t)g * MR * 256;
    float* LSE = (float*)(p.ws + WS_LSE) + (size_t)g * MR * 4;
    for (int pr = 2 * wave; pr < 2 * wave + 2; ++pr) {
        const int s = pr >> 2, h = pr & 3, jn = s >> dl;
        const LAS float* qp = qs + s * 256 + h * 64;
        float sc[3];
#pragma unroll
        for (int rd = 0; rd < 3; ++rd) {
            const int j = rd * 64 + lane, jc = j < 128 ? j : 128; int idx = Wb + s - jc * d; idx = idx < Wb ? idx : Wb - 1;
            const float* kp = cache + ((size_t)idx * 2 + 0) * 256 + h * 64;
            float dot = 0.f;
#pragma unroll
            for (int e = 0; e < 16; ++e) { const f32x4 kv = *(const f32x4*)(kp + 4 * e), qv = *(const LAS f32x4*)(qp + 4 * e); dot += (kv.x * qv.x + kv.y * qv.y) + (kv.z * qv.z + kv.w * qv.w); }
            sc[rd] = dot;
        }
        if (lane <= jn) {
            const LAS float* kp = newkv + ((s - lane * d) * 2 + 0) * 256 + h * 64; float dot = 0.f;
#pragma unroll
            for (int e = 0; e < 16; ++e) { const f32x4 kv = *(const LAS f32x4*)(kp + 4 * e), qv = *(const LAS f32x4*)(qp + 4 * e); dot += (kv.x * qv.x + kv.y * qv.y) + (kv.z * qv.z + kv.w * qv.w); }
            sc[0] = dot;
        }
#pragma unroll
        for (int rd = 0; rd < 3; ++rd) { const int j = rd * 64 + lane; sc[rd] = j <= 128 ? sc[rd] * 0.125f + p.in[I_RB][BUCKET[g][j < 128 ? j : 128] * 12 + g * 4 + h] : -INFINITY; }
        const float m = wave_max(fmaxf(fmaxf(sc[0], sc[1]), sc[2]));
        float e3[3]; float l = 0.f;
#pragma unroll
        for (int rd = 0; rd < 3; ++rd) { e3[rd] = expf(sc[rd] - m); l += e3[rd]; }
        l = wave_sum(l);
        const float inv = 1.0f / l;
#pragma unroll
        for (int rd = 0; rd < 3; ++rd) pw[rd * 64 + lane] = e3[rd] * inv;
        LDS_WAIT();
        const int kq = lane >> 4, d4 = 4 * (lane & 15);
        f32x4 o = (f32x4){0.f, 0.f, 0.f, 0.f};
#pragma unroll 8
        for (int it = 0; it < 32; ++it) {
            const int j = jn + 1 + kq + 4 * it, jc = j < 128 ? j : 128;
            const float pj = j <= 128 ? pw[jc] : 0.f;
            const f32x4 vv = *(const f32x4*)(cache + ((size_t)(Wb + s - jc * d) * 2 + 1) * 256 + h * 64 + d4);
            o += vv * pj;
        }
        if (kq == 0) for (int j = 0; j <= jn; ++j) o += *(const LAS f32x4*)(newkv + ((s - j * d) * 2 + 1) * 256 + h * 64 + d4) * pw[j];
#pragma unroll
        for (int c = 0; c < 4; ++c) { o[c] += __shfl_xor(o[c], 16); o[c] += __shfl_xor(o[c], 32); }
        const size_t row = (size_t)(TP + 4 * n + s);
        if (lane < 16) *(f32x4*)(OG + row * 256 + h * 64 + d4) = o;
        if (lane == 0) LSE[row * 4 + h] = m + logf(l);
        LDS_WAIT();
    }
    __syncthreads();
}

__device__ __forceinline__ void phase3(const Params& p, LAS unsigned char* lds) {
    constexpr int N_ATT = BATCH * 192, N_CA = TP / 32, N_SA = DEC_BATCH * 3, N_CS = DEC_BATCH;
    for (int it = blockIdx.x; it < N_ATT + N_CA + N_SA + N_CS; it += gridDim.x) {
        int r = it;
        if (r < N_SA) { if (DBG_P3 & 1) sattn_item(p, lds, r / 3, r % 3); continue; } r -= N_SA;
        if (r < N_ATT) { if (DBG_P3 & 2) attn_unit(p, lds, r); continue; } r -= N_ATT;
        if (r < N_CA) { if (DBG_P3 & 4) conva_item(p, lds, false, r / 64, (r % 64) * 32); continue; } r -= N_CA;
        if (DBG_P3 & 8) conva_item(p, lds, true, r, 0);
    }
    if (!(DBG_P3 & 16)) return;
    const bf16* PROJ = (const bf16*)(p.ws + WS_PROJ);
    const size_t gt = (size_t)blockIdx.x * NTHR + threadIdx.x, NGT = (size_t)gridDim.x * NTHR;
#pragma unroll
    for (int g = 0; g < 3; ++g) {
        const int W = 128 << (2 * g);
        float* o = p.out + (g == 0 ? O_KV0P : g == 1 ? O_KV1P : O_KV2P);
        const size_t total = (size_t)BATCH * W * 64;
        for (size_t i0 = gt; i0 < total; i0 += 4 * NGT) {
            u32x4 w[4];
#pragma unroll
            for (int u = 0; u < 4; ++u) { const size_t i = i0 + u * NGT < total ? i0 + u * NGT : total - 1;
                const int vec = (int)(i & 31), which = (int)((i >> 5) & 1); const size_t bj = i >> 6; int j = (int)(bj % W), b = (int)(bj / W); asm volatile("" : "+v"(j), "+v"(b));
                w[u] = *(const u32x4*)(PROJ + ((size_t)b * SEQ + (SEQ - W + j)) * E_IN + QCOL + ((1 + which) * 3 + g) * 256 + 8 * vec); }
#pragma unroll
            for (int u = 0; u < 4; ++u) { const size_t i = i0 + u * NGT;
                if (i < total) { float f[8]; unpack8(w[u], f); float* op = o + i * 8;
                    __builtin_nontemporal_store((f32x4){f[0], f[1], f[2], f[3]}, (f32x4*)op); __builtin_nontemporal_store((f32x4){f[4], f[5], f[6], f[7]}, (f32x4*)(op + 4)); } }
        }
    }
}

__device__ __forceinline__ void phase4(const Params& p) {
    const int tid = threadIdx.x, lane = tid & 63, wave = tid >> 6;
    const int gw = blockIdx.x * NWAVES + wave, NGW = gridDim.x * NWAVES;
    const float* OG = (const float*)(p.ws + WS_OG); const float* LSE = (const float*)(p.ws + WS_LSE);
    bf16* MIX = (bf16*)(p.ws + WS_MIX);
    const int h = lane >> 4;
    for (int row0 = gw; row0 < MP; row0 += 2 * NGW) {
        float l0[2], l1[2], l2[2]; f32x4 o0[2], o1[2], o2[2];
#pragma unroll
        for (int u = 0; u < 2; ++u) { const int row = row0 + u * NGW; const size_t rc = row < MR ? row : MR - 1;
            l0[u] = LSE[rc * 4 + h]; l1[u] = LSE[((size_t)MR + rc) * 4 + h]; l2[u] = LSE[((size_t)2 * MR + rc) * 4 + h];
            o0[u] = *(const f32x4*)(OG + rc * 256 + 4 * lane); o1[u] = *(const f32x4*)(OG + ((size_t)MR + rc) * 256 + 4 * lane); o2[u] = *(const f32x4*)(OG + ((size_t)2 * MR + rc) * 256 + 4 * lane); }
#pragma unroll
        for (int u = 0; u < 2; ++u) { const int row = row0 + u * NGW;
            if (row >= MP) continue;
            if (row >= MR) { *(u32x4*)(MIX + (size_t)row * 512 + 8 * lane) = (u32x4){0u, 0u, 0u, 0u}; continue; }
            const float m = fmaxf(fmaxf(l0[u], l1[u]), l2[u]);
            const float e0 = expf(l0[u] - m), e1 = expf(l1[u] - m), e2 = expf(l2[u] - m), inv = 1.0f / (e0 + e1 + e2);
            const f32x4 a = (o0[u] * e0 + o1[u] * e1 + o2[u] * e2) * inv;
            *(u32x2*)(MIX + (size_t)row * 512 + 256 + 4 * lane) = (u32x2){pk2(a.x, a.y), pk2(a.z, a.w)}; }
    }
}

#ifndef DBG_DUP
#define DBG_DUP 0
#endif

__device__ __forceinline__ void mixc_rows(const Params& p) {
    const bf16* PJ = (const bf16*)(p.ws + WS_PROJ);
    bf16* MIX = (bf16*)(p.ws + WS_MIX);
    const size_t gt = (size_t)blockIdx.x * NTHR + threadIdx.x, NGT = (size_t)gridDim.x * NTHR;
    for (size_t i = gt; i < (size_t)MP * 64; i += NGT) {
        const int row = (int)(i >> 6), c0 = (int)(i & 63) * 8;
        if (row >= MR) { *(u32x4*)(MIX + (size_t)row * D + c0) = (u32x4){0u, 0u, 0u, 0u}; *(u32x4*)(MIX + (size_t)row * D + 512 + c0) = (u32x4){0u, 0u, 0u, 0u}; continue; }
        const bool smp = row >= TP; const int t = smp ? ((row - TP) & 3) : (row & 2047); const int n = smp ? ((row - TP) >> 2) : (row >> 11);
        float ci[3][8];
#pragma unroll
        for (int k = 0; k < 3; ++k) { const int tt = t - 2 + k;
            if (tt >= 0) { float a[8], b[8]; unpack8(*(const u32x4*)(PJ + (size_t)(row - 2 + k) * O_IN + 512 + c0), a); unpack8(*(const u32x4*)(PJ + (size_t)(row - 2 + k) * O_IN + 1024 + c0), b);
#pragma unroll
                for (int e = 0; e < 8; ++e) ci[k][e] = a[e] * b[e]; }
            else if (smp) { const float* sp = p.in[I_SC] + ((size_t)n * 2 + (tt + 2)) * 512 + c0;
#pragma unroll
                for (int e = 0; e < 8; ++e) ci[k][e] = sp[e]; }
            else {
#pragma unroll
                for (int e = 0; e < 8; ++e) ci[k][e] = 0.f; } }
        float bg[8]; unpack8(*(const u32x4*)(PJ + (size_t)row * O_IN + c0), bg);
        float y[8];
#pragma unroll
        for (int e = 0; e < 8; ++e) { const float* w = p.in[I_CCW] + c0 + e;
            y[e] = bg[e] * (w[0] * ci[0][e] + w[512] * ci[1][e] + w[1024] * ci[2][e] + p.in[I_CCB][c0 + e]); }
        *(u32x4*)(MIX + (size_t)row * D + c0) = (u32x4){pk2(y[0], y[1]), pk2(y[2], y[3]), pk2(y[4], y[5]), pk2(y[6], y[7])};
        float* so = nullptr;
        if (smp) { if (t >= 2) so = p.out + O_CS + ((size_t)n * 2 + (t - 2)) * 512 + c0; }
        else if (t >= SEQ - 2) so = p.out + O_CP + ((size_t)n * 2 + (t - (SEQ - 2))) * 512 + c0;
        if (so) { *(f32x4*)so = (f32x4){ci[2][0], ci[2][1], ci[2][2], ci[2][3]}; *(f32x4*)(so + 4) = (f32x4){ci[2][4], ci[2][5], ci[2][6], ci[2][7]}; }
    }
}

constexpr int MD_PITCH = 136;
constexpr int MD_VT = 0, MD_WS = 128 * MD_PITCH * 2, MD_ST = 2 * 128 * MD_PITCH * 2;
__device__ __forceinline__ void mixd_item(const Params& p, LAS unsigned char* lds, int b, int ck, int g) {
    int tid = threadIdx.x; asm volatile("" : "+v"(tid));
    const int lane = tid & 63, wave = tid >> 6, fr = lane & 15, fq = lane >> 4;
    const bf16* PJ = (const bf16*)(p.ws + WS_PROJ);
    bf16* MIX = (bf16*)(p.ws + WS_MIX);
    LAS bf16* vT = (LAS bf16*)(lds + MD_VT); LAS bf16* Wl = (LAS bf16*)(lds + MD_WS); LAS float* st = (LAS float*)(lds + MD_ST);
    const size_t row0 = (size_t)b * SEQ + (size_t)ck * 128;
    {
        const bf16* wsb = (const bf16*)(p.ws + WS_WSB) + (size_t)g * 128 * 128;
        u32x4 w[4];
#pragma unroll
        for (int q = 0; q < 4; ++q) { const int v = tid + q * NTHR; w[q] = *(const u32x4*)(wsb + (size_t)v * 8); }
        u32x4 raw[16];
#pragma unroll
        for (int q = 0; q < 16; ++q) raw[q] = *(const u32x4*)(PJ + (row0 + 16 * wave + q) * O_IN + 2048 + 8 * lane);
#pragma unroll
        for (int q = 0; q < 4; ++q) { const int v = tid + q * NTHR; *(LAS u32x4*)(Wl + (v >> 4) * MD_PITCH + (v & 15) * 8) = w[q]; }
#pragma unroll
        for (int q = 0; q < 16; ++q) {
            float f[8]; unpack8(raw[q], f);
            float s = 0.f;
#pragma unroll
            for (int e = 0; e < 8; ++e) s += f[e];
            const float mu = wave_sum(s) * (1.0f / 512.0f); float s2 = 0.f;
#pragma unroll
            for (int e = 0; e < 8; ++e) { const float dlt = f[e] - mu; s2 += dlt * dlt; }
            const float var = wave_sum(s2) * (1.0f / 512.0f);
            if (lane == 0) { st[2 * (16 * wave + q)] = mu; st[2 * (16 * wave + q) + 1] = 1.0f / sqrtf(var + EPS); } }
    }
    __syncthreads();
    {
        const int j = tid & 127, cq = tid >> 7; const float mu = st[2 * j], rs = st[2 * j + 1];
        u32x4 raw[4];
#pragma unroll
        for (int c8 = 0; c8 < 4; ++c8) raw[c8] = *(const u32x4*)(PJ + (row0 + j) * O_IN + 2048 + g * 128 + 32 * cq + 8 * c8);
#pragma unroll
        for (int c8 = 0; c8 < 4; ++c8) { const int cc = 32 * cq + 8 * c8;
            float f[8]; unpack8(raw[c8], f);
            const f32x4 g0 = *(const f32x4*)(p.in[I_DLG] + g * 128 + cc), g1 = *(const f32x4*)(p.in[I_DLG] + g * 128 + cc + 4);
            const f32x4 b0 = *(const f32x4*)(p.in[I_DLB] + g * 128 + cc), b1 = *(const f32x4*)(p.in[I_DLB] + g * 128 + cc + 4);
            const float gg[8] = {g0.x, g0.y, g0.z, g0.w, g1.x, g1.y, g1.z, g1.w}, bb[8] = {b0.x, b0.y, b0.z, b0.w, b1.x, b1.y, b1.z, b1.w};
#pragma unroll
            for (int e = 0; e < 8; ++e) vT[(cc + e) * MD_PITCH + j] = (bf16)f2bf((f[e] - mu) * rs * gg[e] + bb[e]); }
    }
    __syncthreads();
    f32x4 acc[8];
#pragma unroll
    for (int nc = 0; nc < 8; ++nc) acc[nc] = (f32x4){0.f, 0.f, 0.f, 0.f};
#pragma unroll
    for (int ks = 0; ks < 4; ++ks) {
        const bf16x8 a = *(const LAS bf16x8*)(Wl + (16 * wave + fr) * MD_PITCH + 32 * ks + 8 * fq);
#pragma unroll
        for (int nc = 0; nc < 8; ++nc) { const bf16x8 bb = *(const LAS bf16x8*)(vT + (16 * nc + fr) * MD_PITCH + 32 * ks + 8 * fq);
            acc[nc] = __builtin_amdgcn_mfma_f32_16x16x32_bf16(a, bb, acc[nc], 0, 0, 0); }
    }
#pragma unroll
    for (int rg = 0; rg < 4; ++rg) { const int ii = 16 * wave + 4 * fq + rg; const float bsv = p.in[I_DSB][g * 128 + ii];
        const bf16* up = PJ + (row0 + ii) * O_IN + 1536 + g * 128; bf16* op = MIX + (row0 + ii) * D + 512 + g * 128;
        float uu[8];
#pragma unroll
        for (int nc = 0; nc < 8; ++nc) uu[nc] = bf2f(up[16 * nc + fr]);
#pragma unroll
        for (int nc = 0; nc < 8; ++nc) op[16 * nc + fr] = (bf16)f2bf(uu[nc] * (acc[nc][rg] + bsv)); }
    __syncthreads();
}
__device__ __forceinline__ void mixd_sample(const Params& p, LAS unsigned char* lds, int n) {
    int tid = threadIdx.x; asm volatile("" : "+v"(tid));
    const int lane = tid & 63, wave = tid >> 6;
    const bf16* PJ = (const bf16*)(p.ws + WS_PROJ);
    bf16* MIX = (bf16*)(p.ws + WS_MIX);
    LAS float* red = (LAS float*)lds;
    float x[4], v[4];
#pragma unroll
    for (int s = 0; s < 4; ++s) x[s] = bf2f(PJ[(size_t)(TP + 4 * n + s) * O_IN + 2048 + tid]);
    __syncthreads();
#pragma unroll
    for (int s = 0; s < 4; ++s) { const float t = wave_sum(x[s]); if (lane == 0) red[s * 8 + wave] = t; }
    __syncthreads();
    float mu[4];
#pragma unroll
    for (int s = 0; s < 4; ++s) { float t = 0.f;
#pragma unroll
        for (int w = 0; w < 8; ++w) t += red[s * 8 + w];
        mu[s] = t * (1.0f / 512.0f); }
    __syncthreads();
#pragma unroll
    for (int s = 0; s < 4; ++s) { const float dlt = x[s] - mu[s]; const float t = wave_sum(dlt * dlt); if (lane == 0) red[s * 8 + wave] = t; }
    __syncthreads();
    const float lg = p.in[I_DLG][tid], lb = p.in[I_DLB][tid];
#pragma unroll
    for (int s = 0; s < 4; ++s) { float t = 0.f;
#pragma unroll
        for (int w = 0; w < 8; ++w) t += red[s * 8 + w];
        v[s] = (x[s] - mu[s]) * (1.0f / sqrtf(t * (1.0f / 512.0f) + EPS)) * lg + lb;
        p.out[O_DV + ((size_t)n * 4 + s) * 512 + tid] = v[s]; }
    const int g = tid >> 7;
    const float* wsg = p.in[I_DSW] + (size_t)g * 128 * 128;
#pragma unroll
    for (int i = 0; i < 4; ++i) { float m = p.in[I_DSB][g * 128 + i];
#pragma unroll
        for (int j = 0; j <= i; ++j) m += wsg[i * 128 + j] * v[j];
        const float u = bf2f(PJ[(size_t)(TP + 4 * n + i) * O_IN + 1536 + tid]);
        MIX[(size_t)(TP + 4 * n + i) * D + 512 + tid] = (bf16)f2bf(u * m); }
    __syncthreads();
}
__device__ __forceinline__ void phase11(const Params& p, LAS unsigned char* lds) {
    constexpr int N_D = BATCH * 16 * 4, N_DS = DEC_BATCH;
    for (int it = blockIdx.x; it < N_D + N_DS; it += gridDim.x) {
        if (it < N_D) mixd_item(p, lds, it / 64, (it >> 2) & 15, it & 3); else mixd_sample(p, lds, it - N_D);
    }
    mixc_rows(p);
}

#define XB_TMO      128
#define XB_XCNT(j)  (256  + 64 * (j))
#define XB_XSUB(j)  (1280 + 64 * (j))
#define XB_XGEN(j)  (2304 + 64 * (j))
#define XB_TOP      3328
#define XB_TOPGEN   3392
#define XCD_BAR_WORDS 3456
#define XB_SPIN_CAP (1u << 18)

__device__ __forceinline__ unsigned xb_ld(unsigned* p)              { return __hip_atomic_load(p, __ATOMIC_RELAXED, __HIP_MEMORY_SCOPE_AGENT); }
__device__ __forceinline__ unsigned xb_add(unsigned* p, unsigned v) { return __hip_atomic_fetch_add(p, v, __ATOMIC_RELAXED, __HIP_MEMORY_SCOPE_AGENT); }
__device__ __forceinline__ unsigned xb_xcc_id() { return (unsigned)__builtin_amdgcn_s_getreg((3 << 11) | 20) & 0xFu; }
#define XB_SPIN(cond, bar) do { unsigned _sp = 0; while (cond) { __builtin_amdgcn_s_sleep(1); \
    if ((++_sp & 255u) == 0u) { if (xb_ld(&(bar)[XB_TMO])) break; if (_sp > XB_SPIN_CAP) { atomicAdd(&(bar)[XB_TMO], 1u); break; } } } } while (0)

struct XcdBarrier {
    unsigned* bar; unsigned x;
    volatile LAS unsigned* st;
};

__device__ __forceinline__ XcdBarrier xcd_barrier_post(unsigned* bar, volatile LAS unsigned* st) {
    XcdBarrier b; b.bar = bar; b.x = xb_xcc_id(); b.st = st;
    if (threadIdx.x == 0) (void)xb_add(&bar[XB_XCNT(b.x)], 1u);
    return b;
}
__device__ __forceinline__ void xcd_barrier_complete(unsigned* bar, unsigned x, unsigned& nloc, unsigned& nx) {
    const unsigned G = gridDim.x * gridDim.y * gridDim.z;
    unsigned sum, cnt, mine, sp = 0u;
    for (;;) {
        sum = 0u; cnt = 0u; mine = 0u;
#pragma unroll
        for (unsigned j = 0; j < 16; ++j) { const unsigned c = xb_ld(&bar[XB_XCNT(j)]); sum += c; cnt += (c > 0u) ? 1u : 0u; mine = (j == x) ? c : mine; }
        if (sum == G) break;
        __builtin_amdgcn_s_sleep(1);
        if ((++sp & 255u) == 0u) { if (xb_ld(&bar[XB_TMO])) break; if (sp > XB_SPIN_CAP) { atomicAdd(&bar[XB_TMO], 1u); break; } }
    }
    nloc = mine > 0u ? mine : 1u; nx = cnt > 0u ? cnt : 1u;
}

__device__ __forceinline__ void xcd_barrier(const XcdBarrier& b) {
    asm volatile("s_waitcnt vmcnt(0)" ::: "memory");
    __syncthreads();
    if (threadIdx.x == 0) {
        unsigned* bar = b.bar;
        __builtin_amdgcn_s_waitcnt(0);
        unsigned nloc = b.st[0], nx = b.st[1];
        if (nloc == 0u) { xcd_barrier_complete(bar, b.x, nloc, nx); b.st[0] = nloc; b.st[1] = nx; }
        const unsigned old = xb_add(&bar[XB_XSUB(b.x)], 1u);
        const unsigned gen = old / nloc;
        if (old + 1u == (gen + 1u) * nloc) {
            __builtin_amdgcn_fence(__ATOMIC_RELEASE, "agent");
            asm volatile("s_waitcnt vmcnt(0)" ::: "memory");
            const unsigned og = xb_add(&bar[XB_TOP], 1u);
            const unsigned tg = og / nx;
            if (og + 1u == (tg + 1u) * nx) xb_add(&bar[XB_TOPGEN], 1u);
            else XB_SPIN(xb_ld(&bar[XB_TOPGEN]) == tg, bar);
            __builtin_amdgcn_fence(__ATOMIC_ACQUIRE, "agent");
            xb_add(&bar[XB_XGEN(b.x)], 1u);
            asm volatile("s_waitcnt vmcnt(0)" ::: "memory");
        } else {
            XB_SPIN(xb_ld(&bar[XB_XGEN(b.x)]) == gen, bar);
            __builtin_amdgcn_fence(__ATOMIC_ACQUIRE, "agent");
            asm volatile("s_waitcnt vmcnt(0)" ::: "memory");
        }
    }
    __syncthreads();
}

template <bool COOP>
__global__ void __launch_bounds__(NTHR, 2) fwd_kernel(Params p) {
    extern __shared__ __attribute__((aligned(16))) unsigned char lds_raw[];
    LAS unsigned char* lds = (LAS unsigned char*)lds_raw;
    unsigned char* ws = p.ws;
    float* mod = (float*)(ws + WS_MOD);
    float* X = (float*)(ws + WS_X);
    bf16* H = (bf16*)(ws + WS_H); bf16* PROJ = (bf16*)(ws + WS_PROJ); bf16* MIX = (bf16*)(ws + WS_MIX); bf16* ACT = (bf16*)(ws + WS_ACT);
    const int lo = p.ph_lo, hi = p.ph_hi;
    XcdBarrier bar; bar.bar = (unsigned*)(ws + WS_CTL) + CW_BAR; bar.x = 0; bar.st = nullptr;
    if (COOP) {
        for (int u = threadIdx.x; u < (LDS_BYTES - LDSCTL_OFF) / 4; u += NTHR) ((LAS unsigned*)(lds + LDSCTL_OFF))[u] = 0u;
        __syncthreads();
        bar = xcd_barrier_post((unsigned*)(ws + WS_CTL) + CW_BAR, (volatile LAS unsigned*)(lds + LDSCTL_OFF + 320) + 8);
    }
#define IN(k) (lo <= (k) && (k) < hi)
#define SEAM(k) do { if (COOP) { if ((k) + 1 < hi) xcd_barrier(bar); } } while (0)
#define GEMM_PHASE(EpiT, Aptr, Wptr, Mrows, Ncols, Kdim, ...) do { pg8::Gemm g_{(const pg8::bf16_t*)(Aptr), (const pg8::bf16_t*)(Wptr), Mrows, Ncols, Kdim}; \
        pg8::StaticOrder S_; S_.init(Mrows, Ncols, (int)gridDim.x, (int)blockIdx.x); pg8::EpiT E_{__VA_ARGS__}; \
        pg8::gemm_phase<pg8::EpiT, pg8::StaticOrder, true, true>(lds, g_, S_, E_); } while (0)

    if (IN(0)) for (int rep_ = 0; rep_ <= ((DBG_DUP >> 0) & 1); ++rep_) { phase0(p, lds); SEAM(0); }
    if (IN(1)) for (int rep_ = 0; rep_ <= ((DBG_DUP >> 1) & 1); ++rep_) { norm_phase<false>(p.in[I_XP], p.in[I_XS], p.in[I_NMG], mod + 0 * D, mod + 1 * D, H, nullptr, nullptr); SEAM(1); }
    if (IN(2)) for (int rep_ = 0; rep_ <= ((DBG_DUP >> 2) & 1); ++rep_) { GEMM_PHASE(EpiStoreBf16, H, ws + WS_WEIN, MP, E_IN, D, (pg8::bf16_t*)PROJ, E_IN, 1 << 30); SEAM(2); }
    if (IN(3)) for (int rep_ = 0; rep_ <= ((DBG_DUP >> 3) & 1); ++rep_) { phase3(p, lds); SEAM(3); }
    if (IN(4)) for (int rep_ = 0; rep_ <= ((DBG_DUP >> 4) & 1); ++rep_) { phase4(p); SEAM(4); }
    if (IN(5)) for (int rep_ = 0; rep_ <= ((DBG_DUP >> 5) & 1); ++rep_) { GEMM_PHASE(EpiResid, MIX, ws + WS_WEOUT, MP, D, 512, p.in[I_XP], p.in[I_XS], X, mod + 2 * D); SEAM(5); }
    if (IN(6)) for (int rep_ = 0; rep_ <= ((DBG_DUP >> 6) & 1); ++rep_) { norm_phase<false>(X, X + (size_t)TP * D, p.in[I_NFG], mod + 3 * D, mod + 4 * D, H, nullptr, nullptr); SEAM(6); }
    if (IN(7)) for (int rep_ = 0; rep_ <= ((DBG_DUP >> 7) & 1); ++rep_) { GEMM_PHASE(EpiSwiGLU, H, ws + WS_WGU0, MP, 2 * FFN, D, (pg8::bf16_t*)ACT, FFN); SEAM(7); }
    if (IN(8)) for (int rep_ = 0; rep_ <= ((DBG_DUP >> 8) & 1); ++rep_) { GEMM_PHASE(EpiResid, ACT, ws + WS_WDN0, MP, D, FFN, X, X + (size_t)TP * D, X, mod + 5 * D); SEAM(8); }
    const float* mod1 = mod + (size_t)NB * MODW;
    if (IN(9)) for (int rep_ = 0; rep_ <= ((DBG_DUP >> 9) & 1); ++rep_) { norm_phase<false>(X, X + (size_t)TP * D, p.in[I_NMG] + D, mod1 + 0 * D, mod1 + 1 * D, H, nullptr, nullptr); SEAM(9); }
    if (IN(10)) for (int rep_ = 0; rep_ <= ((DBG_DUP >> 10) & 1); ++rep_) { GEMM_PHASE(EpiStoreBf16, H, ws + WS_WOIN, MP, O_IN, D, (pg8::bf16_t*)PROJ, O_IN, 6); SEAM(10); }
    if (IN(11)) for (int rep_ = 0; rep_ <= ((DBG_DUP >> 11) & 1); ++rep_) { phase11(p, lds); SEAM(11); }
    if (IN(12)) for (int rep_ = 0; rep_ <= ((DBG_DUP >> 12) & 1); ++rep_) { GEMM_PHASE(EpiResid, MIX, ws + WS_WOOUT, MP, D, D, X, X + (size_t)TP * D, X, mod1 + 2 * D); SEAM(12); }
    if (IN(13)) for (int rep_ = 0; rep_ <= ((DBG_DUP >> 13) & 1); ++rep_) { norm_phase<false>(X, X + (size_t)TP * D, p.in[I_NFG] + D, mod1 + 3 * D, mod1 + 4 * D, H, nullptr, nullptr); SEAM(13); }
    if (IN(14)) for (int rep_ = 0; rep_ <= ((DBG_DUP >> 14) & 1); ++rep_) { GEMM_PHASE(EpiSwiGLU, H, ws + WS_WGU1, MP, 2 * FFN, D, (pg8::bf16_t*)ACT, FFN); SEAM(14); }
    if (IN(15)) for (int rep_ = 0; rep_ <= ((DBG_DUP >> 15) & 1); ++rep_) { GEMM_PHASE(EpiResid, ACT, ws + WS_WDN1, MP, D, FFN, X, X + (size_t)TP * D, X, mod1 + 5 * D); SEAM(15); }
    if (IN(16)) for (int rep_ = 0; rep_ <= ((DBG_DUP >> 16) & 1); ++rep_) { norm_phase<true>(X, X + (size_t)TP * D, p.in[I_FNG], nullptr, nullptr, nullptr, p.out + O_YP, p.out + O_YS); }
#undef IN
#undef SEAM
#undef GEMM_PHASE
}

#ifndef DBG_PH_HI
#define DBG_PH_HI NPHASE
#endif
#ifndef MK_MULTI
#define MK_MULTI 1
#endif
extern "C" void kernel_launch(void* const* d_in, const int* in_sizes, int n_in, void* d_out, int out_size, void* d_ws, size_t ws_size, hipStream_t stream) {
    static int grid = 0;
    if (grid == 0) {
        if (n_in != N_IN || out_size != (int)O_END || ws_size < WS_END) { fprintf(stderr, "kernel_launch: unexpected shapes: n_in %d out %d ws %zu (need %zu)\n", n_in, out_size, ws_size, (size_t)WS_END); grid = -1; return; }
        int dev = 0, cus = 0, per_cu = 0;
        if (hipGetDevice(&dev) != hipSuccess || hipDeviceGetAttribute(&cus, hipDeviceAttributeMultiprocessorCount, dev) != hipSuccess) { grid = -1; return; }
        hipFuncSetAttribute((const void*)fwd_kernel<true>, hipFuncAttributeMaxDynamicSharedMemorySize, LDS_BYTES);
        hipFuncSetAttribute((const void*)fwd_kernel<false>, hipFuncAttributeMaxDynamicSharedMemorySize, LDS_BYTES);
        if (hipOccupancyMaxActiveBlocksPerMultiprocessor(&per_cu, (const void*)fwd_kernel<true>, NTHR, LDS_BYTES) != hipSuccess || per_cu < 1) { fprintf(stderr, "kernel_launch: occupancy query says %d blocks per CU\n", per_cu); per_cu = 1; }
        (void)hipGetLastError();
        grid = cus;
    }
    if (grid < 0) return;
    Params prm{};
    for (int i = 0; i < N_IN; ++i) prm.in[i] = (const float*)d_in[i];
    prm.out = (float*)d_out; prm.ws = (unsigned char*)d_ws;
#if MK_MULTI
    for (int ph = 0; ph < DBG_PH_HI; ++ph) { prm.ph_lo = ph; prm.ph_hi = ph + 1;
        hipLaunchKernelGGL(fwd_kernel<false>, dim3(grid), dim3(NTHR), LDS_BYTES, stream, prm); }
#else
    prm.ph_lo = 0; prm.ph_hi = NPHASE;
    if (hipMemsetAsync((char*)d_ws + WS_CTL, 0, CTL_ZERO_BYTES, stream) != hipSuccess) { fprintf(stderr, "kernel_launch: memset of the control words failed\n"); return; }
    void* args[] = {&prm};
    hipError_t e = hipLaunchCooperativeKernel((const void*)fwd_kernel<true>, dim3(grid), dim3(NTHR), args, LDS_BYTES, stream);
    if (e != hipSuccess) fprintf(stderr, "cooperative launch failed: %s (grid %d)\n", hipGetErrorString(e), grid);
#endif
}
```

```cpp
#define MK_MULTI 0
#include <hip/hip_runtime.h>
#include <hip/hip_cooperative_groups.h>
#include <cstdio>
#include <cstdint>
namespace cg = cooperative_groups;

constexpr int D = 1024, BATCH = 8, SEQ = 2048, DEC_BATCH = 32, DEC_SEQ = 4, NB = BATCH + DEC_BATCH;
constexpr int TP = BATCH * SEQ;
constexpr int TS = DEC_BATCH * DEC_SEQ;
constexpr int MR = TP + TS;
constexpr int MP = 16640;
constexpr int E_IN = 2816, O_IN = 2560, FFN = 2816, MODW = 6 * D;
constexpr float EPS = 1e-6f;
namespace pg8 {
#define PG8_LAS __attribute__((address_space(3)))
typedef unsigned short bf16_t;
typedef short bf16x8 __attribute__((ext_vector_type(8)));
typedef float f32x4 __attribute__((ext_vector_type(4)));
typedef unsigned u32x4 __attribute__((ext_vector_type(4)));
constexpr int BM = 256, BK = 64, HALF = 128, HTB = HALF * BK * 2  , STAGE_BYTES = 8 * HTB, NXCD = 8, WGM = 8;

__host__ __device__ __forceinline__ int lds_byte(int r, int c) { const int st = (r >> 4) * 2 + (c >> 5), rr = r & 15, cc = c & 31, ob = rr * 64 + cc * 2; return st * 1024 + (ob ^ (((ob >> 9) & 1) << 5)); }
__host__ __device__ __forceinline__ void stage_rc(int b, int& R, int& C) { const int st = b / 1024, sb = b % 1024, swz = sb ^ (((sb >> 9) & 1) << 5); R = (st >> 1) * 16 + swz / 64; C = (st & 1) * 32 + (swz % 64) / 2; }
__host__ __device__ __forceinline__ int perm32(int rho) { const int n = rho >> 4, i = rho & 15; return 8 * (i >> 2) + 4 * n + (i & 3); }

struct Unit { int pm, pn; };
struct Gemm { const bf16_t* A; const bf16_t* Bt; int M, N, K; };

struct StaticOrder {
    int nM, nN, nwg, G, c;
    __host__ __device__ void init(int M, int N, int G_, int c_) { nM = M / BM; nN = N / BM; nwg = nM * nN; G = G_; c = c_; }
    __host__ __device__ bool next(int i, Unit& u) const {
        const long L = (long)i * G + c; if (L >= nwg) return false;
        int wgid = (int)L; { const int q = nwg / NXCD, r = nwg % NXCD, xcd = wgid % NXCD, off = wgid / NXCD; wgid = (xcd < r ? xcd * (q + 1) : r * (q + 1) + (xcd - r) * q) + off; }
        const int nig = WGM * nN, gid = wgid / nig, fm = gid * WGM, gsz = (nM - fm) < WGM ? (nM - fm) : WGM;
        u.pm = fm + ((wgid % nig) % gsz); u.pn = (wgid % nig) / gsz; return true;
    }
    __device__ __forceinline__ void a_ready(const Unit&) const {}
    __device__ __forceinline__ void done(const Unit&) const {}
};

__device__ __forceinline__ unsigned cvt_pk_bf16(float lo, float hi) { unsigned r; asm volatile("v_cvt_pk_bf16_f32 %0, %1, %2" : "=v"(r) : "v"(lo), "v"(hi)); return r; }
typedef float f32x2 __attribute__((ext_vector_type(2)));
__device__ __forceinline__ f32x2 gelu_pk(f32x2 v) {
    const f32x2 av = __builtin_elementwise_abs(v), d = av * 0.2316418882f + 1.0f;
    f32x2 t; t.x = __builtin_amdgcn_rcpf(d.x); t.y = __builtin_amdgcn_rcpf(d.y);
    f32x2 q = t * 0.5307027145f + (-0.7265760135f); q = q * t + 0.7107068705f; q = q * t + (-0.142248368f); q = q * t + 0.127414796f; q = q * t;
    const f32x2 s = (v * v) * (-0.72134752044f);
    f32x2 e; e.x = __builtin_amdgcn_exp2f(s.x); e.y = __builtin_amdgcn_exp2f(s.y);
    const f32x2 m = v * (q * e), r = v - m;
    f32x2 o; o.x = v.x < 0.f ? m.x : r.x; o.y = v.y < 0.f ? m.y : r.y; return o;
}

template <int ACT  > struct EpiBf16 {
    static constexpr bool PERM = true, AFTER_DRAIN = false; static_assert(ACT == 0 || ACT == 1, "EpiBf16: ACT is 0 (none) or 1 (gelu_pk)");
    bf16_t* O; int ldc; const float* bias; int split_cols; size_t split_stride; float scale0;
    __device__ __forceinline__ void operator()(const f32x4 (&acc)[2][2][4][2], const Unit& u, int wr, int wc, int fr, int fq) const {
        const int row0 = u.pm * BM + wr * 64 + fr; int colt = u.pn * BM; bf16_t* base = O;
        float sc = 1.f; if (split_cols) { const int t = colt / split_cols; base += (size_t)t * split_stride; colt -= t * split_cols; if (t == 0) sc = scale0; }
        const int col0 = colt + wc * 32 + 8 * fq, bcol0 = u.pn * BM + wc * 32 + 8 * fq;
        f32x4 bv[2][2];
#pragma unroll
        for (int bj = 0; bj < 2; ++bj)
#pragma unroll
            for (int n = 0; n < 2; ++n) bv[bj][n] = bias ? *(const f32x4*)(bias + bcol0 + bj * HALF + 4 * n) : (f32x4){0.f, 0.f, 0.f, 0.f};
#pragma unroll
        for (int ai = 0; ai < 2; ++ai)
#pragma unroll
            for (int m = 0; m < 4; ++m) { bf16_t* rowp = base + (size_t)(row0 + ai * HALF + m * 16) * ldc + col0;
#pragma unroll
                for (int bj = 0; bj < 2; ++bj) { f32x4 v0 = acc[ai][bj][m][0] + bv[bj][0], v1 = acc[ai][bj][m][1] + bv[bj][1];
                    if (ACT == 1) { f32x2 a = gelu_pk((f32x2){v0[0], v0[1]}), b = gelu_pk((f32x2){v0[2], v0[3]}), c = gelu_pk((f32x2){v1[0], v1[1]}), d = gelu_pk((f32x2){v1[2], v1[3]});
                        v0 = (f32x4){a.x, a.y, b.x, b.y}; v1 = (f32x4){c.x, c.y, d.x, d.y}; }
                    v0 = v0 * sc; v1 = v1 * sc; u32x4 w; w.x = cvt_pk_bf16(v0[0], v0[1]); w.y = cvt_pk_bf16(v0[2], v0[3]); w.z = cvt_pk_bf16(v1[0], v1[1]); w.w = cvt_pk_bf16(v1[2], v1[3]);
                    *(u32x4*)(rowp + bj * HALF) = w; } }
    }
};

__device__ __forceinline__ float gelu_tanh_f(float x) {
    const float y = 1.5957691216057308f * (x + 0.044715f * x * x * x);
    return x * __builtin_amdgcn_rcpf(1.0f + __builtin_amdgcn_exp2f(-1.4426950408889634f * y));
}
__device__ __forceinline__ float silu_f(float x) { return x * __builtin_amdgcn_rcpf(1.0f + __builtin_amdgcn_exp2f(-1.4426950408889634f * x)); }

struct EpiStoreBf16 {
    static constexpr bool PERM = true, AFTER_DRAIN = false;
    bf16_t* O; int ldc; int gelu_from;
    __device__ __forceinline__ void operator()(const f32x4 (&acc)[2][2][4][2], const Unit& u, int wr, int wc, int fr, int fq) const {
        const int row0 = u.pm * BM + wr * 64 + fr, col0 = u.pn * BM + wc * 32 + 8 * fq;
        const bool g = u.pn >= gelu_from;
#pragma unroll
        for (int ai = 0; ai < 2; ++ai)
#pragma unroll
            for (int m = 0; m < 4; ++m) { bf16_t* rowp = O + (size_t)(row0 + ai * HALF + m * 16) * ldc + col0;
#pragma unroll
                for (int bj = 0; bj < 2; ++bj) { f32x4 v0 = acc[ai][bj][m][0], v1 = acc[ai][bj][m][1];
                    if (g) {
#pragma unroll
                        for (int j = 0; j < 4; ++j) { v0[j] = gelu_tanh_f(v0[j]); v1[j] = gelu_tanh_f(v1[j]); } }
                    u32x4 w; w.x = cvt_pk_bf16(v0[0], v0[1]); w.y = cvt_pk_bf16(v0[2], v0[3]); w.z = cvt_pk_bf16(v1[0], v1[1]); w.w = cvt_pk_bf16(v1[2], v1[3]);
                    *(u32x4*)(rowp + bj * HALF) = w; } }
    }
};
struct EpiSwiGLU {
    static constexpr bool PERM = true, AFTER_DRAIN = false;
    bf16_t* O; int ldc;
    __device__ __forceinline__ void operator()(const f32x4 (&acc)[2][2][4][2], const Unit& u, int wr, int wc, int fr, int fq) const {
        const int row0 = u.pm * BM + wr * 64 + fr, col0 = (u.pn * BM + wc * 32 + 8 * fq) >> 1;
#pragma unroll
        for (int ai = 0; ai < 2; ++ai)
#pragma unroll
            for (int m = 0; m < 4; ++m) { bf16_t* rowp = O + (size_t)(row0 + ai * HALF + m * 16) * ldc + col0;
#pragma unroll
                for (int bj = 0; bj < 2; ++bj) { const f32x4 v0 = acc[ai][bj][m][0], v1 = acc[ai][bj][m][1];
                    const float a0 = silu_f(v0[0]) * v0[1], a1 = silu_f(v0[2]) * v0[3], a2 = silu_f(v1[0]) * v1[1], a3 = silu_f(v1[2]) * v1[3];
                    typedef unsigned u32x2 __attribute__((ext_vector_type(2)));
                    u32x2 w; w.x = cvt_pk_bf16(a0, a1); w.y = cvt_pk_bf16(a2, a3);
                    *(u32x2*)(rowp + bj * (HALF / 2)) = w; } }
    }
};
struct EpiResid {
    static constexpr bool PERM = false, AFTER_DRAIN = false;
    const float* xin_p; const float* xin_s; float* xout; const float* gate;
    __device__ __forceinline__ void operator()(const f32x4 (&acc)[2][2][4][2], const Unit& u, int wr, int wc, int fr, int fq) const {
        const int row0 = u.pm * BM + wr * 64 + fr, col0 = u.pn * BM + wc * 32 + 4 * fq;
#pragma unroll
        for (int ai = 0; ai < 2; ++ai)
#pragma unroll
            for (int m = 0; m < 4; ++m) { const int row = row0 + ai * HALF + m * 16;
                if (row < MR) {
                    const int nb = row < TP ? (row >> 11) : BATCH + ((row - TP) >> 2);
                    const float* gp = gate + (size_t)nb * MODW + col0;
                    const float* xi = (row < TP ? xin_p + (size_t)row * D : xin_s + (size_t)(row - TP) * D) + col0;
                    float* xo = xout + (size_t)row * D + col0;
#pragma unroll
                    for (int bj = 0; bj < 2; ++bj)
#pragma unroll
                        for (int n = 0; n < 2; ++n) { const int off = bj * HALF + n * 16;
                            const f32x4 gv = *(const f32x4*)(gp + off), xv = *(const f32x4*)(xi + off);
                            *(f32x4*)(xo + off) = xv + gv * acc[ai][bj][m][n]; } } }
    }
};
template <class Epi, class Sched, bool ALIGN_EPI = false, bool SP2 = false>
__device__ __forceinline__ void gemm_phase(PG8_LAS unsigned char* lds, const Gemm g, const Sched& S, const Epi& E) {
    const int tid = threadIdx.x, wid = __builtin_amdgcn_readfirstlane(tid >> 6), lane = tid & 63, wr = wid >> 2, wc = wid & 3, fr = lane & 15, fq = lane >> 4;
    const int K = g.K, nt = K / BK;
    unsigned voffA[2], voffB[2];
#pragma unroll
    for (int i = 0; i < 2; ++i) { int R, C; stage_rc(tid * 16 + i * 8192, R, C); const int Rb = Epi::PERM ? ((R & ~31) + perm32(R & 31)) : R;
        voffA[i] = (unsigned)(R * K + C) * 2u; voffB[i] = (unsigned)(Rb * K + C) * 2u; }
    const size_t kstep = (size_t)(BK * 2);
    const size_t hstep = (size_t)HALF * K * 2;
    const size_t tstep = 2 * hstep;
    const unsigned ldsw = (unsigned)wid * 1024u;
    const int aoff = lds_byte(wr * 64 + fr, fq * 8), boff = lds_byte(wc * 32 + fr, fq * 8);
#define PG8_SA(b, h) (((b) * 2 + (h)) * HTB)
#define PG8_SB(b, h) ((4 + (b) * 2 + (h)) * HTB)
#define PG8_STAGE(bufoff, gbase, voff) do { _Pragma("unroll") for (int _i = 0; _i < 2; ++_i) \
        __builtin_amdgcn_global_load_lds((const unsigned*)((const char*)(gbase) + (voff)[_i]), (PG8_LAS unsigned*)(lds + (bufoff) + ldsw + _i * 8192), 16, 0, 0); } while (0)
#define PG8_LDA(dst, b, h) do { _Pragma("unroll") for (int m = 0; m < 4; ++m) _Pragma("unroll") for (int k = 0; k < 2; ++k) dst[m][k] = *(const PG8_LAS bf16x8*)(lds + PG8_SA(b, h) + aoff + m * 2048 + k * 1024); } while (0)
#define PG8_LDB(dst, b, h) do { _Pragma("unroll") for (int n = 0; n < 2; ++n) _Pragma("unroll") for (int k = 0; k < 2; ++k) dst[n][k] = *(const PG8_LAS bf16x8*)(lds + PG8_SB(b, h) + boff + n * 2048 + k * 1024); } while (0)
#define PG8_MMA(ai, bj, At, Bt) do { __builtin_amdgcn_s_setprio(1); _Pragma("unroll") for (int m = 0; m < 4; ++m) _Pragma("unroll") for (int n = 0; n < 2; ++n) _Pragma("unroll") for (int k = 0; k < 2; ++k) \
        acc[ai][bj][m][n] = __builtin_amdgcn_mfma_f32_16x16x32_bf16(Bt[n][k], At[m][k], acc[ai][bj][m][n], 0, 0, 0); __builtin_amdgcn_s_setprio(0); } while (0)
#define PG8_WAIT_V(n) asm volatile("s_waitcnt vmcnt(" #n ")" ::: "memory")
#define PG8_WAIT_L(n) asm volatile("s_waitcnt lgkmcnt(" #n ")" ::: "memory")
#define PG8_BAR __builtin_amdgcn_s_barrier()
#define PG8_SCHED __builtin_amdgcn_sched_barrier(0)
    Unit cur, nxt; int ui = 0;
    if (!S.next(0, cur)) return;
    f32x4 acc[2][2][4][2];
#pragma unroll
    for (int a = 0; a < 2; ++a)
#pragma unroll
        for (int b = 0; b < 2; ++b)
#pragma unroll
            for (int m = 0; m < 4; ++m)
#pragma unroll
                for (int n = 0; n < 2; ++n) acc[a][b][m][n] = (f32x4){0.f, 0.f, 0.f, 0.f};
    bf16x8 At[4][2], B0[2][2], B1[2][2];
    const char* cA = (const char*)g.A + (size_t)cur.pm * tstep; const char* cB = (const char*)g.Bt + (size_t)cur.pn * tstep;
    S.a_ready(cur);
    if constexpr (SP2) {
        PG8_STAGE(PG8_SB(0, 0), cB, voffB); PG8_STAGE(PG8_SB(0, 1), cB + hstep, voffB); PG8_STAGE(PG8_SA(0, 0), cA, voffA); PG8_STAGE(PG8_SA(0, 1), cA + hstep, voffA);
        if (wr == 1) PG8_BAR;
        PG8_WAIT_V(2); PG8_BAR;
        PG8_STAGE(PG8_SB(1, 0), cB + kstep, voffB); PG8_STAGE(PG8_SA(1, 0), cA + kstep, voffA); PG8_STAGE(PG8_SB(1, 1), cB + hstep + kstep, voffB);
        PG8_WAIT_V(6); PG8_BAR;
    } else {
        PG8_STAGE(PG8_SB(0, 0), cB, voffB); PG8_STAGE(PG8_SA(0, 0), cA, voffA); PG8_STAGE(PG8_SB(0, 1), cB + hstep, voffB); PG8_STAGE(PG8_SA(0, 1), cA + hstep, voffA);
        if (wr == 1) PG8_BAR;
        PG8_WAIT_V(4); PG8_BAR;
        PG8_STAGE(PG8_SB(1, 0), cB + kstep, voffB); PG8_STAGE(PG8_SA(1, 0), cA + kstep, voffA); PG8_STAGE(PG8_SB(1, 1), cB + hstep + kstep, voffB);
        PG8_WAIT_V(6); PG8_BAR;
    }
    for (;;) {
        const bool has_next = S.next(ui + 1, nxt);
        const char* nA = has_next ? (const char*)g.A + (size_t)nxt.pm * tstep : cA; const char* nB = has_next ? (const char*)g.Bt + (size_t)nxt.pn * tstep : cB;
        for (int t = 0; t < nt; t += 2) {
            const bool last = (t == nt - 2);
            const char* a1 = cA + (size_t)(t + 1) * kstep;
            const char* a2 = last ? nA : cA + (size_t)(t + 2) * kstep; const char* b2 = last ? nB : cB + (size_t)(t + 2) * kstep;
            const char* a3 = a2 + kstep; const char* b3 = b2 + kstep;
            if (last && has_next) S.a_ready(nxt);
            if constexpr (SP2) {
            PG8_LDB(B0, 0, 0); PG8_LDB(B1, 0, 1); PG8_SCHED; PG8_LDA(At, 0, 0); PG8_STAGE(PG8_SA(1, 1), a1 + hstep, voffA);
            PG8_WAIT_V(8); PG8_WAIT_L(0); PG8_BAR; PG8_MMA(0, 0, At, B0); PG8_MMA(0, 1, At, B1); PG8_BAR; PG8_SCHED;
            PG8_LDA(At, 0, 1); PG8_STAGE(PG8_SB(0, 0), b2, voffB); PG8_STAGE(PG8_SB(0, 1), b2 + hstep, voffB); PG8_STAGE(PG8_SA(0, 0), a2, voffA);
            PG8_WAIT_V(8); PG8_WAIT_L(0); PG8_BAR; PG8_MMA(1, 0, At, B0); PG8_MMA(1, 1, At, B1); PG8_BAR; PG8_SCHED;
            PG8_LDB(B0, 1, 0); PG8_LDB(B1, 1, 1); PG8_SCHED; PG8_LDA(At, 1, 0); PG8_STAGE(PG8_SA(0, 1), a2 + hstep, voffA);
            PG8_WAIT_V(8); PG8_WAIT_L(0); PG8_BAR; PG8_MMA(0, 0, At, B0); PG8_MMA(0, 1, At, B1); PG8_BAR; PG8_SCHED;
            PG8_LDA(At, 1, 1); PG8_STAGE(PG8_SB(1, 0), b3, voffB); PG8_STAGE(PG8_SB(1, 1), b3 + hstep, voffB); PG8_STAGE(PG8_SA(1, 0), a3, voffA);
            PG8_WAIT_V(8); PG8_WAIT_L(0); PG8_BAR; PG8_MMA(1, 0, At, B0); PG8_MMA(1, 1, At, B1); PG8_BAR; PG8_SCHED;
            } else {
            PG8_LDB(B0, 0, 0); PG8_SCHED; PG8_LDA(At, 0, 0); PG8_STAGE(PG8_SA(1, 1), a1 + hstep, voffA);
            PG8_WAIT_L(8); PG8_BAR; PG8_WAIT_L(0); PG8_MMA(0, 0, At, B0); PG8_BAR; PG8_SCHED;
            PG8_LDB(B1, 0, 1); PG8_STAGE(PG8_SB(0, 0), b2, voffB);
            PG8_BAR; PG8_WAIT_L(0); PG8_MMA(0, 1, At, B1); PG8_BAR;
            PG8_LDA(At, 0, 1); PG8_STAGE(PG8_SA(0, 0), a2, voffA);
            PG8_BAR; PG8_WAIT_L(0); PG8_MMA(1, 0, At, B0); PG8_BAR; PG8_SCHED;
            PG8_STAGE(PG8_SB(0, 1), b2 + hstep, voffB);
            PG8_WAIT_V(6); PG8_BAR; PG8_MMA(1, 1, At, B1); PG8_BAR;
            PG8_LDB(B0, 1, 0); PG8_SCHED; PG8_LDA(At, 1, 0); PG8_STAGE(PG8_SA(0, 1), a2 + hstep, voffA);
            PG8_WAIT_L(8); PG8_BAR; PG8_WAIT_L(0); PG8_MMA(0, 0, At, B0); PG8_BAR; PG8_SCHED;
            PG8_LDB(B1, 1, 1); PG8_STAGE(PG8_SB(1, 0), b3, voffB);
            PG8_BAR; PG8_WAIT_L(0); PG8_MMA(0, 1, At, B1); PG8_BAR;
            PG8_LDA(At, 1, 1); PG8_STAGE(PG8_SA(1, 0), a3, voffA);
            PG8_BAR; PG8_WAIT_L(0); PG8_MMA(1, 0, At, B0); PG8_BAR; PG8_SCHED;
            PG8_STAGE(PG8_SB(1, 1), b3 + hstep, voffB);
            PG8_WAIT_V(6); PG8_BAR; PG8_MMA(1, 1, At, B1); PG8_BAR;
            }
        }
        if constexpr (ALIGN_EPI) { if (wr == 0) PG8_BAR; }
        if constexpr (!Epi::AFTER_DRAIN) { E(acc, cur, wr, wc, fr, fq); S.done(cur); }
        if (!has_next) break;
#pragma unroll
        for (int a = 0; a < 2; ++a)
#pragma unroll
            for (int b = 0; b < 2; ++b)
#pragma unroll
                for (int m = 0; m < 4; ++m)
#pragma unroll
                    for (int n = 0; n < 2; ++n) acc[a][b][m][n] = (f32x4){0.f, 0.f, 0.f, 0.f};
        cur = nxt; cA = nA; cB = nB; ++ui;
        if constexpr (ALIGN_EPI) { if (wr == 1) PG8_BAR; }
    }
    PG8_WAIT_V(0);
    if constexpr (!ALIGN_EPI) { if (wr == 0) PG8_BAR; }
    PG8_BAR;
    if constexpr (Epi::AFTER_DRAIN) { E.fused(acc, cur, wr, wc, fr, fq, lds, wid, lane); S.done(cur); }
#undef PG8_SA
#undef PG8_SB
#undef PG8_STAGE
#undef PG8_LDA
#undef PG8_LDB
#undef PG8_MMA
#undef PG8_WAIT_V
#undef PG8_WAIT_L
#undef PG8_BAR
#undef PG8_SCHED
}
}

#define GAS __attribute__((address_space(1)))
#define LAS __attribute__((address_space(3)))
typedef unsigned short bf16;
typedef float f32x4 __attribute__((ext_vector_type(4)));
typedef short bf16x8 __attribute__((ext_vector_type(8)));
typedef unsigned u32x4 __attribute__((ext_vector_type(4)));
typedef unsigned u32x2 __attribute__((ext_vector_type(2)));

constexpr int NWAVES = 8, NTHR = 512;
constexpr int LDS_BYTES = 147456;
constexpr int NPHASE = 17;
constexpr int LDSCTL_OFF = 131072;
constexpr int CW_BAR = 4096;
constexpr size_t CTL_ZERO_BYTES = 65536;

enum { I_XP = 0, I_XS, I_CP, I_CS, I_SA, I_KV0, I_KV1, I_KV2, I_SC, I_RB, I_ADAW, I_ADAB, I_NMG, I_NFG, I_WGU, I_WDN, I_FNG, I_EWIN, I_ACW, I_ACB,
       I_ALG, I_ALB, I_EWOUT, I_OWIN, I_CCW, I_CCB, I_DLG, I_DLB, I_DSW, I_DSB, I_OWOUT, N_IN };
constexpr size_t O_YP = 0, O_YS = O_YP + (size_t)TP * D, O_AP = O_YS + (size_t)TS * D, O_AS = O_AP + (size_t)BATCH * 30 * 256,
    O_KV0P = O_AS + (size_t)DEC_BATCH * 30 * 256, O_KV0S = O_KV0P + (size_t)BATCH * 128 * 512, O_KV1P = O_KV0S + (size_t)DEC_BATCH * 128 * 512,
    O_KV1S = O_KV1P + (size_t)BATCH * 512 * 512, O_KV2P = O_KV1S + (size_t)DEC_BATCH * 512 * 512, O_KV2S = O_KV2P + (size_t)BATCH * 2048 * 512,
    O_CP = O_KV2S + (size_t)DEC_BATCH * 2048 * 512, O_CS = O_CP + (size_t)BATCH * 2 * 512, O_DV = O_CS + (size_t)DEC_BATCH * 2 * 512,
    O_END = O_DV + (size_t)DEC_BATCH * 4 * 512;
static_assert(O_END == 72372224, "output size");
constexpr size_t al256(size_t x) { return (x + 255) & ~(size_t)255; }
constexpr size_t WS_CTL = 0, WS_CTL_BYTES = 1u << 20;
constexpr size_t WS_WEIN = WS_CTL + WS_CTL_BYTES;
constexpr size_t WS_WEOUT = WS_WEIN + (size_t)E_IN * D * 2;
constexpr size_t WS_WGU0 = WS_WEOUT + (size_t)D * 512 * 2;
constexpr size_t WS_WGU1 = WS_WGU0 + (size_t)2 * FFN * D * 2;
constexpr size_t WS_WDN0 = WS_WGU1 + (size_t)2 * FFN * D * 2;
constexpr size_t WS_WDN1 = WS_WDN0 + (size_t)D * FFN * 2;
constexpr size_t WS_WOIN = WS_WDN1 + (size_t)D * FFN * 2;
constexpr size_t WS_WOOUT = WS_WOIN + (size_t)O_IN * D * 2;
constexpr size_t WS_MOD = WS_WOOUT + (size_t)D * D * 2;
constexpr size_t WS_X = al256(WS_MOD + (size_t)2 * NB * MODW * 4);
constexpr size_t WS_H = WS_X + (size_t)MP * D * 4;
constexpr size_t WS_PROJ = WS_H + (size_t)MP * D * 2;
constexpr size_t WS_MIX = WS_PROJ + (size_t)MP * E_IN * 2;
constexpr size_t WS_ACT = WS_MIX + (size_t)MP * D * 2;
constexpr size_t WS_OG = WS_ACT + (size_t)MP * FFN * 2;
constexpr size_t WS_LSE = WS_OG + (size_t)3 * MR * 256 * 4;
constexpr size_t WS_WSB = al256(WS_LSE + (size_t)3 * MR * 4 * 4);
constexpr size_t WS_END = al256(WS_WSB + (size_t)4 * 128 * 128 * 2);

struct Params { const float* in[N_IN]; float* out; unsigned char* ws; int ph_lo, ph_hi; };
static_assert(sizeof(Params) == 8 * N_IN + 8 + 8 + 8, "Params has no padding");

__device__ const unsigned char BUCKET[3][132] = {
 {0,1,2,3,4,5,6,7,8,9,10,11,12,13,14,15,16,16,16,16,16,16,17,17,17,17,17,17,17,17,18,18,18,18,18,18,18,18,18,18,19,19,19,19,19,19,19,19,19,19,19,19,19,19,20,20,20,20,20,20,20,20,20,20,20,20,20,20,20,20,20,20,20,21,21,21,21,21,21,21,21,21,21,21,21,21,21,21,21,21,21,21,21,21,21,21,21,21,21,22,22,22,22,22,22,22,22,22,22,22,22,22,22,22,22,22,22,22,22,22,22,22,22,22,22,22,22,22,22,0,0,0},
 {0,4,8,12,16,16,17,17,18,18,19,19,19,19,20,20,20,20,20,21,21,21,21,21,21,22,22,22,22,22,22,22,22,22,23,23,23,23,23,23,23,23,23,23,23,23,24,24,24,24,24,24,24,24,24,24,24,24,24,24,24,24,25,25,25,25,25,25,25,25,25,25,25,25,25,25,25,25,25,25,25,25,25,26,26,26,26,26,26,26,26,26,26,26,26,26,26,26,26,26,26,26,26,26,26,26,26,26,26,26,26,26,26,27,27,27,27,27,27,27,27,27,27,27,27,27,27,27,27,0,0,0},
 {0,16,18,19,20,21,21,22,22,23,23,23,24,24,24,24,25,25,25,25,25,26,26,26,26,26,26,26,26,27,27,27,27,27,27,27,27,27,27,28,28,28,28,28,28,28,28,28,28,28,28,28,29,29,29,29,29,29,29,29,29,29,29,29,29,29,29,29,29,29,30,30,30,30,30,30,30,30,30,30,30,30,30,30,30,30,30,30,30,30,30,30,30,30,30,31,31,31,31,31,31,31,31,31,31,31,31,31,31,31,31,31,31,31,31,31,31,31,31,31,31,31,31,31,31,31,31,31,31,0,0,0}};

__device__ __forceinline__ float bf2f(unsigned b) { return __uint_as_float(b << 16); }
__device__ __forceinline__ unsigned f2bf(float f) { unsigned u = __float_as_uint(f); return (u + 0x7fffu + ((u >> 16) & 1u)) >> 16; }
__device__ __forceinline__ unsigned pk2(float lo, float hi) { return f2bf(lo) | (f2bf(hi) << 16); }
__device__ __forceinline__ float wave_sum(float v) {
#pragma unroll
    for (int o = 1; o < 64; o <<= 1) v += __shfl_xor(v, o);
    return v;
}
__device__ __forceinline__ float wave_max(float v) {
#pragma unroll
    for (int o = 1; o < 64; o <<= 1) v = fmaxf(v, __shfl_xor(v, o));
    return v;
}
__device__ __forceinline__ void unpack8(const u32x4 w, float (&f)[8]) {
    f[0] = bf2f(w.x & 0xffffu); f[1] = bf2f(w.x >> 16); f[2] = bf2f(w.y & 0xffffu); f[3] = bf2f(w.y >> 16);
    f[4] = bf2f(w.z & 0xffffu); f[5] = bf2f(w.z >> 16); f[6] = bf2f(w.w & 0xffffu); f[7] = bf2f(w.w >> 16);
}
__device__ __forceinline__ int batch_of(int row) { return row < TP ? (row >> 11) : BATCH + ((row - TP) >> 2); }
#define LDS_WAIT() asm volatile("s_waitcnt lgkmcnt(0)" ::: "memory")

__device__ __forceinline__ void transpose_item(const float* W, int K, int N, bf16* WT, bool ilv, LAS float* scr, int item, int lane) {
    const int nblk = N / 32, kb = item / nblk, nb = item % nblk, k0 = 64 * kb, n0 = 32 * nb;
    float tv[32];
#pragma unroll
    for (int i = 0; i < 32; ++i) tv[i] = W[(size_t)(k0 + 2 * i + (lane >> 5)) * N + n0 + (lane & 31)];
#pragma unroll
    for (int i = 0; i < 32; ++i) scr[(2 * i + (lane >> 5)) * 33 + (lane & 31)] = tv[i];
    LDS_WAIT();
    const int c = lane & 7;
#pragma unroll
    for (int j = 0; j < 4; ++j) { const int n = (lane >> 3) + 8 * j; const LAS float* s = scr + (8 * c) * 33 + n;
        u32x4 o; o.x = pk2(s[0 * 33], s[1 * 33]); o.y = pk2(s[2 * 33], s[3 * 33]); o.z = pk2(s[4 * 33], s[5 * 33]); o.w = pk2(s[6 * 33], s[7 * 33]);
        const int col = n0 + n; const int orow = ilv ? (col < FFN ? 2 * col : 2 * (col - FFN) + 1) : col;
        *(u32x4*)(WT + (size_t)orow * K + k0 + 8 * c) = o; }
    LDS_WAIT();
}

__device__ __forceinline__ void adaln_item(const Params& p, LAS unsigned char* lds, int it) {
    int tid = threadIdx.x; asm volatile("" : "+v"(tid));
    const int lane = tid & 63, wave = tid >> 6;
    const int l = it / 96, j0 = (it % 96) * 64;
    LAS float* s = (LAS float*)lds;
    const float* cp = p.in[I_CP]; const float* cs = p.in[I_CS];
    float* mod = (float*)(p.ws + WS_MOD);
    float acc[NB];
#pragma unroll
    for (int n = 0; n < NB; ++n) acc[n] = 0.f;
    for (int kh = 0; kh < 2; ++kh) {
        __syncthreads();
        for (int idx = tid; idx < NB * 512; idx += NTHR) { const int n = idx >> 9, k = idx & 511;
            const float c = n < BATCH ? cp[n * D + kh * 512 + k] : cs[(n - BATCH) * D + kh * 512 + k];
            s[idx] = c / (1.0f + expf(-c)); }
        __syncthreads();
        const float* wp = p.in[I_ADAW] + ((size_t)l * D + kh * 512 + wave * 64) * MODW + j0 + lane;
#pragma unroll 1
        for (int kb = 0; kb < 4; ++kb) {
            float wv[16];
#pragma unroll
            for (int q = 0; q < 16; ++q) wv[q] = wp[(size_t)(16 * kb + q) * MODW];
#pragma unroll
            for (int n = 0; n < NB; ++n) {
#pragma unroll
                for (int q4 = 0; q4 < 4; ++q4) { const f32x4 sv = *(const LAS f32x4*)(s + n * 512 + wave * 64 + 16 * kb + 4 * q4);
                    acc[n] += (sv.x * wv[4 * q4] + sv.y * wv[4 * q4 + 1]) + (sv.z * wv[4 * q4 + 2] + sv.w * wv[4 * q4 + 3]); } }
        }
    }
    __syncthreads();
    LAS float* red = (LAS float*)lds;
#pragma unroll
    for (int n = 0; n < NB; ++n) red[(wave * NB + n) * 64 + lane] = acc[n];
    __syncthreads();
    for (int idx = tid; idx < NB * 64; idx += NTHR) { const int n = idx >> 6, j = idx & 63; float t = 0.f;
#pragma unroll
        for (int w = 0; w < NWAVES; ++w) t += red[(w * NB + n) * 64 + j];
        mod[((size_t)l * NB + n) * MODW + j0 + j] = t + p.in[I_ADAB][l * MODW + j0 + j]; }
    __syncthreads();
}

__device__ __forceinline__ void phase0(const Params& p, LAS unsigned char* lds) {
    const int tid = threadIdx.x, lane = tid & 63, wave = tid >> 6;
    for (int it = blockIdx.x; it < 192; it += gridDim.x) adaln_item(p, lds, it);
    __syncthreads();
    {
        LAS float* scr = (LAS float*)(lds + wave * 16384);
        const int gw = blockIdx.x * NWAVES + wave, NGW = gridDim.x * NWAVES;
        constexpr int I0 = (D / 64) * (E_IN / 32), I1 = (512 / 64) * (D / 32), I2 = (D / 64) * (2 * FFN / 32), I3 = (FFN / 64) * (D / 32), I4 = (D / 64) * (O_IN / 32), I5 = (D / 64) * (D / 32);
        constexpr int NIT = I0 + I1 + 2 * I2 + 2 * I3 + I4 + I5;
        for (int it = gw; it < NIT; it += NGW) {
            int r = it;
            if (r < I0) { transpose_item(p.in[I_EWIN], D, E_IN, (bf16*)(p.ws + WS_WEIN), false, scr, r, lane); continue; } r -= I0;
            if (r < I1) { transpose_item(p.in[I_EWOUT], 512, D, (bf16*)(p.ws + WS_WEOUT), false, scr, r, lane); continue; } r -= I1;
            if (r < I2) { transpose_item(p.in[I_WGU], D, 2 * FFN, (bf16*)(p.ws + WS_WGU0), true, scr, r, lane); continue; } r -= I2;
            if (r < I2) { transpose_item(p.in[I_WGU] + (size_t)D * 2 * FFN, D, 2 * FFN, (bf16*)(p.ws + WS_WGU1), true, scr, r, lane); continue; } r -= I2;
            if (r < I3) { transpose_item(p.in[I_WDN], FFN, D, (bf16*)(p.ws + WS_WDN0), false, scr, r, lane); continue; } r -= I3;
            if (r < I3) { transpose_item(p.in[I_WDN] + (size_t)FFN * D, FFN, D, (bf16*)(p.ws + WS_WDN1), false, scr, r, lane); continue; } r -= I3;
            if (r < I4) { transpose_item(p.in[I_OWIN], D, O_IN, (bf16*)(p.ws + WS_WOIN), false, scr, r, lane); continue; } r -= I4;
            transpose_item(p.in[I_OWOUT], D, D, (bf16*)(p.ws + WS_WOOUT), false, scr, r, lane);
        }
    }
    {
        bf16* wsb = (bf16*)(p.ws + WS_WSB);
        for (int idx = blockIdx.x * NTHR + tid; idx < 4 * 128 * 128; idx += gridDim.x * NTHR) { const int ii = (idx >> 7) & 127, jj = idx & 127;
            wsb[idx] = (bf16)(jj <= ii ? f2bf(p.in[I_DSW][idx]) : 0u); }
    }
    {
        const size_t gt = (size_t)blockIdx.x * NTHR + tid, NGT = (size_t)gridDim.x * NTHR;
#pragma unroll
        for (int g = 0; g < 3; ++g) {
            const int Wb = 128 << (2 * g);
            const f32x4* src = (const f32x4*)p.in[I_KV0 + g];
            f32x4* dst = (f32x4*)(p.out + (g == 0 ? O_KV0S : g == 1 ? O_KV1S : O_KV2S));
            const unsigned cnt = (unsigned)(Wb - 4) * 128u, total = (unsigned)DEC_BATCH * cnt;
            for (unsigned i0 = (unsigned)gt; i0 < total; i0 += 8u * (unsigned)NGT) {
                f32x4 v[8]; unsigned di[8];
#pragma unroll
                for (int u = 0; u < 8; ++u) { const unsigned i = i0 + u * (unsigned)NGT; const unsigned ic = i < total ? i : total - 1u; const unsigned n = ic / cnt;
                    di[u] = ic + n * 512u; v[u] = __builtin_nontemporal_load(src + di[u] + 512u); }
#pragma unroll
                for (int u = 0; u < 8; ++u) if (i0 + u * (unsigned)NGT < total) __builtin_nontemporal_store(v[u], dst + di[u]);
            }
        }
    }
}

template <bool FINAL>
__device__ __forceinline__ void norm_phase(const float* xp, const float* xs, const float* g, const float* shift, const float* scale, bf16* H, float* outp, float* outs) {
    const int tid = threadIdx.x, lane = tid & 63, wave = tid >> 6;
    const int gw = blockIdx.x * NWAVES + wave, NGW = gridDim.x * NWAVES;
    constexpr int NR = FINAL ? MR : MP;
    f32x4 gv[4];
#pragma unroll
    for (int j = 0; j < 4; ++j) gv[j] = ((const f32x4*)g)[lane + 64 * j];
    for (int row0 = gw; row0 < NR; row0 += 2 * NGW) {
        f32x4 v[2][4], sh[2][4], sc[2][4]; int rows[2]; bool real[2];
#pragma unroll
        for (int u = 0; u < 2; ++u) { const int row = row0 + u * NGW; rows[u] = row; real[u] = row < MR;
            const int rc = real[u] ? row : MR - 1;
            const float* xr = rc < TP ? xp + (size_t)rc * D : xs + (size_t)(rc - TP) * D;
#pragma unroll
            for (int j = 0; j < 4; ++j) v[u][j] = ((const f32x4*)xr)[lane + 64 * j];
            if (!FINAL) { const int nb = batch_of(rc);
#pragma unroll
                for (int j = 0; j < 4; ++j) { sh[u][j] = ((const f32x4*)(shift + (size_t)nb * MODW))[lane + 64 * j]; sc[u][j] = ((const f32x4*)(scale + (size_t)nb * MODW))[lane + 64 * j]; } } }
#pragma unroll
        for (int u = 0; u < 2; ++u) { const int row = rows[u];
            if (row >= NR) continue;
            float ss = 0.f;
#pragma unroll
            for (int j = 0; j < 4; ++j) ss += (v[u][j].x * v[u][j].x + v[u][j].y * v[u][j].y) + (v[u][j].z * v[u][j].z + v[u][j].w * v[u][j].w);
            const float rstd = 1.0f / sqrtf(wave_sum(ss) * (1.0f / D) + EPS);
            if (FINAL) {
                float* o = row < TP ? outp + (size_t)row * D : outs + (size_t)(row - TP) * D;
#pragma unroll
                for (int j = 0; j < 4; ++j) ((f32x4*)o)[lane + 64 * j] = v[u][j] * rstd * gv[j];
            } else {
#pragma unroll
                for (int j = 0; j < 4; ++j) { f32x4 y = v[u][j] * rstd * gv[j] * (sc[u][j] + 1.0f) + sh[u][j];
                    if (!real[u]) y = (f32x4){0.f, 0.f, 0.f, 0.f};
                    *(u32x2*)(H + (size_t)row * D + 4 * lane + 256 * j) = (u32x2){pk2(y.x, y.y), pk2(y.z, y.w)}; }
            }
        }
    }
}

#ifndef DBG_P3DUP
#define DBG_P3DUP 0
#endif
constexpr int QCOL = 512, KCOL = 1280, VCOL = 2048;
constexpr int VT_PITCH = 264;
constexpr int K_PITCH = 72;
constexpr int P_PITCH = 168;
constexpr int AT_PW = 16 * P_PITCH * 2;
constexpr int AT_K = 0, AT_P = 0, AT_VT = 43008, AT_BIAS = AT_VT + 64 * VT_PITCH * 2;
static_assert(256 * K_PITCH * 2 <= AT_VT && NWAVES * AT_PW <= AT_VT && AT_BIAS + 132 * 4 <= 131072, "attention LDS");

__device__ __forceinline__ void attn_unit(const Params& p, LAS unsigned char* lds, int u) {
    int tid = threadIdx.x; asm volatile("" : "+v"(tid));
    const int lane = tid & 63, wave = tid >> 6, fr = lane & 15, fq = lane >> 4;
    const int b = u / 192, v_ = u % 192, g = v_ / 64, w_ = v_ % 64, h = w_ / 16, x_ = w_ % 16;
    const int dl = 2 * g, d = 1 << dl, nblk = 16 >> dl, r = x_ / nblk, i = x_ % nblk;
    const bf16* PROJ = (const bf16*)(p.ws + WS_PROJ);
    LAS bf16* Vt = (LAS bf16*)(lds + AT_VT);
    LAS bf16* Kl = (LAS bf16*)(lds + AT_K);
    LAS bf16* Pw = (LAS bf16*)(lds + AT_P + wave * AT_PW);
    LAS float* biasl = (LAS float*)(lds + AT_BIAS);
    const size_t rowbase = (size_t)b * SEQ;
    u32x4 wv[4], wk[4]; bf16x8 qa[2];
    const int kl = tid & 255, half = tid >> 8;
    {
        const int mk = 128 * (i - 1) + kl; const int mkc = mk < 0 ? 0 : mk;
        const bf16* rp = PROJ + (rowbase + (size_t)mkc * d + r) * E_IN + g * 256 + h * 64 + 32 * half;
#pragma unroll
        for (int c = 0; c < 4; ++c) { wv[c] = *(const u32x4*)(rp + VCOL + 8 * c); wk[c] = *(const u32x4*)(rp + KCOL + 8 * c); }
        const int mq = 128 * i + 16 * wave + fr;
        const bf16* qp = PROJ + (rowbase + (size_t)mq * d + r) * E_IN + QCOL + g * 256 + h * 64 + 8 * fq;
        qa[0] = *(const bf16x8*)qp; qa[1] = *(const bf16x8*)(qp + 32);
    }
    if (tid < 129) biasl[tid] = p.in[I_RB][BUCKET[g][tid] * 12 + g * 4 + h];
#pragma unroll
    for (int c = 0; c < 4; ++c) {
        *(LAS u32x4*)(Kl + kl * K_PITCH + 32 * half + 8 * c) = wk[c];
        const unsigned ww[4] = {wv[c].x, wv[c].y, wv[c].z, wv[c].w};
#pragma unroll
        for (int e = 0; e < 4; ++e) { const int dd = 32 * half + 8 * c + 2 * e;
            Vt[dd * VT_PITCH + kl] = (bf16)(ww[e] & 0xffffu); Vt[(dd + 1) * VT_PITCH + kl] = (bf16)(ww[e] >> 16); } }
    __syncthreads();
    const int kt0 = 2 * (wave >> 1);
    f32x4 sacc[10];
#pragma unroll
    for (int t = 0; t < 10; ++t) {
        const LAS bf16* kp = Kl + (16 * (kt0 + t) + fr) * K_PITCH + 8 * fq;
        const bf16x8 k0 = *(const LAS bf16x8*)kp, k1 = *(const LAS bf16x8*)(kp + 32);
        sacc[t] = __builtin_amdgcn_mfma_f32_16x16x32_bf16(qa[0], k0, (f32x4){0.f, 0.f, 0.f, 0.f}, 0, 0, 0);
        sacc[t] = __builtin_amdgcn_mfma_f32_16x16x32_bf16(qa[1], k1, sacc[t], 0, 0, 0);
    }
    float mx[4] = {-INFINITY, -INFINITY, -INFINITY, -INFINITY};
#pragma unroll
    for (int t = 0; t < 10; ++t) {
        const bool tile_ok = (i > 0) || (kt0 + t >= 8);
#pragma unroll
        for (int rg = 0; rg < 4; ++rg) {
            const int rel = 16 * (wave & 1) + 4 * fq + rg + 128 - 16 * t - fr;
            const bool ok = tile_ok && rel >= 0 && rel <= 128;
            const float sv = ok ? sacc[t][rg] * 0.125f + biasl[ok ? rel : 0] : -INFINITY;
            sacc[t][rg] = sv; mx[rg] = fmaxf(mx[rg], sv);
        }
    }
#pragma unroll
    for (int rg = 0; rg < 4; ++rg) {
#pragma unroll
        for (int o = 1; o < 16; o <<= 1) mx[rg] = fmaxf(mx[rg], __shfl_xor(mx[rg], o));
    }
    __syncthreads();
    float ls[4] = {0.f, 0.f, 0.f, 0.f};
#pragma unroll
    for (int t = 0; t < 10; ++t) {
#pragma unroll
        for (int rg = 0; rg < 4; ++rg) {
            const float e = __builtin_amdgcn_exp2f((sacc[t][rg] - mx[rg]) * 1.4426950408889634f);
            ls[rg] += e;
            Pw[(4 * fq + rg) * P_PITCH + 16 * t + fr] = (bf16)f2bf(e);
        }
    }
#pragma unroll
    for (int rg = 0; rg < 4; ++rg) {
#pragma unroll
        for (int o = 1; o < 16; o <<= 1) ls[rg] += __shfl_xor(ls[rg], o);
    }
    __syncthreads();
    f32x4 oacc[4];
#pragma unroll
    for (int nd = 0; nd < 4; ++nd) oacc[nd] = (f32x4){0.f, 0.f, 0.f, 0.f};
#pragma unroll
    for (int ks = 0; ks < 5; ++ks) {
        const bf16x8 pa = *(const LAS bf16x8*)(Pw + fr * P_PITCH + 32 * ks + 8 * fq);
#pragma unroll
        for (int nd = 0; nd < 4; ++nd) {
            const bf16x8 vb = *(const LAS bf16x8*)(Vt + (16 * nd + fr) * VT_PITCH + 16 * kt0 + 32 * ks + 8 * fq);
            oacc[nd] = __builtin_amdgcn_mfma_f32_16x16x32_bf16(pa, vb, oacc[nd], 0, 0, 0);
        }
    }
    float* OG = (float*)(p.ws + WS_OG) + (size_t)g * MR * 256;
    float* LSE = (float*)(p.ws + WS_LSE) + (size_t)g * MR * 4;
#pragma unroll
    for (int rg = 0; rg < 4; ++rg) {
        const int mq = 128 * i + 16 * wave + 4 * fq + rg; const size_t row = rowbase + (size_t)mq * d + r;
        const float inv = 1.0f / ls[rg];
#pragma unroll
        for (int nd = 0; nd < 4; ++nd) OG[row * 256 + h * 64 + 16 * nd + fr] = oacc[nd][rg] * inv;
        if (fr == 0) LSE[row * 4 + h] = mx[rg] + logf(ls[rg]);
    }
    __syncthreads();
}

constexpr int CA_GLU = 0, CA_Y = 62 * 256 * 4;
__device__ __forceinline__ void conva_item(const Params& p, LAS unsigned char* lds, bool sample, int bn, int t0) {
    int tid = threadIdx.x; asm volatile("" : "+v"(tid));
    const int lane = tid & 63, wave = tid >> 6;
    const bf16* PROJ = (const bf16*)(p.ws + WS_PROJ);
    bf16* MIX = (bf16*)(p.ws + WS_MIX);
    LAS float* glu = (LAS float*)(lds + CA_GLU); LAS float* ys = (LAS float*)(lds + CA_Y);
    const int c = tid & 255, th = tid >> 8;
    const int RR = sample ? 34 : 62, NT = sample ? 4 : 32;
    {
        u32x4 ra[4], rg[4]; f32x4 s0[4], s1[4];
#pragma unroll
        for (int q = 0; q < 4; ++q) { const int v = tid + q * NTHR; const int rr = v >> 5, cv = (v & 31) * 8;
            ra[q] = (u32x4){0u, 0u, 0u, 0u}; rg[q] = ra[q]; s0[q] = (f32x4){0.f, 0.f, 0.f, 0.f}; s1[q] = s0[q];
            if (rr < RR) {
                if (sample && rr < 30) { const float* sp = p.in[I_SA] + ((size_t)bn * 30 + rr) * 256 + cv; s0[q] = *(const f32x4*)sp; s1[q] = *(const f32x4*)(sp + 4); }
                else { const int t = sample ? rr - 30 : t0 - 30 + rr; const int tc = t < 0 ? 0 : t;
                    const bf16* pr = PROJ + (sample ? (size_t)(TP + 4 * bn + tc) : (size_t)bn * SEQ + tc) * E_IN + cv;
                    ra[q] = *(const u32x4*)pr; rg[q] = *(const u32x4*)(pr + 256); } } }
#pragma unroll
        for (int q = 0; q < 4; ++q) { const int v = tid + q * NTHR; const int rr = v >> 5, cv = (v & 31) * 8;
            if (rr < RR) {
                f32x4 o0 = s0[q], o1 = s1[q];
                if (!(sample && rr < 30)) { const int t = sample ? rr - 30 : t0 - 30 + rr;
                    float a[8], gt[8]; unpack8(ra[q], a); unpack8(rg[q], gt);
                    float y[8];
#pragma unroll
                    for (int e = 0; e < 8; ++e) y[e] = t < 0 ? 0.f : a[e] / (1.0f + expf(-gt[e]));
                    o0 = (f32x4){y[0], y[1], y[2], y[3]}; o1 = (f32x4){y[4], y[5], y[6], y[7]}; }
                *(LAS f32x4*)(glu + rr * 256 + cv) = o0; *(LAS f32x4*)(glu + rr * 256 + cv + 4) = o1; } }
    }
    __syncthreads();
    if (sample) { float* o = p.out + O_AS + (size_t)bn * 30 * 256; for (int j = th; j < 30; j += 2) o[j * 256 + c] = glu[(j + 4) * 256 + c]; }
    else if (t0 == SEQ - 32) { float* o = p.out + O_AP + (size_t)bn * 30 * 256; for (int j = th; j < 30; j += 2) o[j * 256 + c] = glu[(j + 32) * 256 + c]; }
    {
        float win[46];
#pragma unroll
        for (int q = 0; q < 46; ++q) { const int rr = 16 * th + q; win[q] = rr < RR ? glu[rr * 256 + c] : 0.f; }
        float y[16]; const float bb = p.in[I_ACB][c];
#pragma unroll
        for (int q = 0; q < 16; ++q) y[q] = bb;
#pragma unroll
        for (int k = 0; k < 31; ++k) { const float wk = p.in[I_ACW][k * 256 + c];
#pragma unroll
            for (int q = 0; q < 16; ++q) y[q] += wk * win[q + k]; }
#pragma unroll
        for (int q = 0; q < 16; ++q) ys[(16 * th + q) * 256 + c] = y[q];
    }
    __syncthreads();
    const f32x4 lg = ((const f32x4*)p.in[I_ALG])[lane], lb = ((const f32x4*)p.in[I_ALB])[lane];
#pragma unroll
    for (int q = 0; q < 4; ++q) { const int tl = 4 * wave + q;
        if (tl < NT) {
            const f32x4 v = *(const LAS f32x4*)(ys + tl * 256 + 4 * lane);
            const float mu = wave_sum((v.x + v.y) + (v.z + v.w)) * (1.0f / 256.0f);
            const f32x4 dv = v - mu;
            const float var = wave_sum((dv.x * dv.x + dv.y * dv.y) + (dv.z * dv.z + dv.w * dv.w)) * (1.0f / 256.0f);
            const float rstd = 1.0f / sqrtf(var + EPS);
            f32x4 y = dv * rstd * lg + lb;
            y.x = y.x / (1.0f + expf(-y.x)); y.y = y.y / (1.0f + expf(-y.y)); y.z = y.z / (1.0f + expf(-y.z)); y.w = y.w / (1.0f + expf(-y.w));
            const size_t row = sample ? (size_t)(TP + 4 * bn + tl) : (size_t)bn * SEQ + t0 + tl;
            *(u32x2*)(MIX + row * 512 + 4 * lane) = (u32x2){pk2(y.x, y.y), pk2(y.z, y.w)};
        } }
    __syncthreads();
}

constexpr int SA_NEW = 0, SA_Q = 4 * 2 * 256 * 4, SA_P = SA_Q + 4 * 256 * 4;
__device__ __forceinline__ void sattn_item(const Params& p, LAS unsigned char* lds, int n, int g) {
    int tid = threadIdx.x; asm volatile("" : "+v"(tid));
    const int lane = tid & 63, wave = tid >> 6;
    const bf16* PROJ = (const bf16*)(p.ws + WS_PROJ);
    const int dl = 2 * g, d = 1 << dl, Wb = 128 << dl;
    const float* cache = p.in[I_KV0 + g] + (size_t)n * Wb * 512;
    float* kvout = p.out + (g == 0 ? O_KV0S : g == 1 ? O_KV1S : O_KV2S) + (size_t)n * Wb * 512;
    LAS float* newkv = (LAS float*)(lds + SA_NEW); LAS float* qs = (LAS float*)(lds + SA_Q); LAS float* pw = (LAS float*)(lds + SA_P) + wave * 192;
    for (int idx = tid; idx < 4 * 3 * 256; idx += NTHR) { const int s = idx / 768, rem = idx % 768, which = rem >> 8, col = rem & 255;
        const float v = bf2f(PROJ[(size_t)(TP + 4 * n + s) * E_IN + QCOL + (which * 3 + g) * 256 + col]);
        if (which == 0) qs[s * 256 + col] = v;
        else { newkv[(s * 2 + which - 1) * 256 + col] = v; kvout[((size_t)(Wb - 4 + s) * 2 + which - 1) * 256 + col] = v; } }
    __syncthreads();
    float* OG = (float*)(p.ws + WS_OG) + (size_t)g * MR * 256;
    float* LSE = (float*)(p.ws + WS_LSE) + (size_t)g * MR * 4;
    for (int pr = 2 * wave; pr < 2 * wave + 2; ++pr) {
        const int s = pr >> 2, h = pr & 3, jn = s >> dl;
        const LAS float* qp = qs + s * 256 + h * 64;
        float sc[3];
#pragma unroll
        for (int rd = 0; rd < 3; ++rd) {
            const int j = rd * 64 + lane, jc = j < 128 ? j : 128; int idx = Wb + s - jc * d; idx = idx < Wb ? idx : Wb - 1;
            const float* kp = cache + ((size_t)idx * 2 + 0) * 256 + h * 64;
            float dot = 0.f;
#pragma unroll
            for (int e = 0; e < 16; ++e) { const f32x4 kv = *(const f32x4*)(kp + 4 * e), qv = *(const LAS f32x4*)(qp + 4 * e); dot += (kv.x * qv.x + kv.y * qv.y) + (kv.z * qv.z + kv.w * qv.w); }
            sc[rd] = dot;
        }
        if (lane <= jn) {
            const LAS float* kp = newkv + ((s - lane * d) * 2 + 0) * 256 + h * 64; float dot = 0.f;
#pragma unroll
            for (int e = 0; e < 16; ++e) { const f32x4 kv = *(const LAS f32x4*)(kp + 4 * e), qv = *(const LAS f32x4*)(qp + 4 * e); dot += (kv.x * qv.x + kv.y * qv.y) + (kv.z * qv.z + kv.w * qv.w); }
            sc[0] = dot;
        }
#pragma unroll
        for (int rd = 0; rd < 3; ++rd) { const int j = rd * 64 + lane; sc[rd] = j <= 128 ? sc[rd] * 0.125f + p.in[I_RB][BUCKET[g][j < 128 ? j : 128] * 12 + g * 4 + h] : -INFINITY; }
        const float m = wave_max(fmaxf(fmaxf(sc[0], sc[1]), sc[2]));
        float e3[3]; float l = 0.f;
#pragma unroll
        for (int rd = 0; rd < 3; ++rd) { e3[rd] = expf(sc[rd] - m); l += e3[rd]; }
        l = wave_sum(l);
        const float inv = 1.0f / l;
#pragma unroll
        for (int rd = 0; rd < 3; ++rd) pw[rd * 64 + lane] = e3[rd] * inv;
        LDS_WAIT();
        const int kq = lane >> 4, d4 = 4 * (lane & 15);
        f32x4 o = (f32x4){0.f, 0.f, 0.f, 0.f};
#pragma unroll 8
        for (int it = 0; it < 32; ++it) {
            const int j = jn + 1 + kq + 4 * it, jc = j < 128 ? j : 128;
            const float pj = j <= 128 ? pw[jc] : 0.f;
            const f32x4 vv = *(const f32x4*)(cache + ((size_t)(Wb + s - jc * d) * 2 + 1) * 256 + h * 64 + d4);
            o += vv * pj;
        }
        if (kq == 0) for (int j = 0; j <= jn; ++j) o += *(const LAS f32x4*)(newkv + ((s - j * d) * 2 + 1) * 256 + h * 64 + d4) * pw[j];
#pragma unroll
        for (int c = 0; c < 4; ++c) { o[c] += __shfl_xor(o[c], 16); o[c] += __shfl_xor(o[c], 32); }
        const size_t row = (size_t)(TP + 4 * n + s);
        if (lane < 16) *(f32x4*)(OG + row * 256 + h * 64 + d4) = o;
        if (lane == 0) LSE[row * 4 + h] = m + logf(l);
        LDS_WAIT();
    }
    __syncthreads();
}

__device__ __forceinline__ void phase3(const Params& p, LAS unsigned char* lds) {
    constexpr int N_ATT = BATCH * 192, N_CA = TP / 32, N_SA = DEC_BATCH * 3, N_CS = DEC_BATCH;
    for (int it = blockIdx.x; it < N_ATT + N_CA + N_SA + N_CS; it += gridDim.x) {
        int r = it;
        if (r < N_SA) { for (int q_ = 0; q_ <= (DBG_P3DUP & 1); ++q_) sattn_item(p, lds, r / 3, r % 3); continue; } r -= N_SA;
        if (r < N_ATT) { for (int q_ = 0; q_ <= ((DBG_P3DUP >> 1) & 1); ++q_) attn_unit(p, lds, r); continue; } r -= N_ATT;
        if (r < N_CA) { for (int q_ = 0; q_ <= ((DBG_P3DUP >> 2) & 1); ++q_) conva_item(p, lds, false, r / 64, (r % 64) * 32); continue; } r -= N_CA;
        conva_item(p, lds, true, r, 0);
    }
    const bf16* PROJ = (const bf16*)(p.ws + WS_PROJ);
    const size_t gt = (size_t)blockIdx.x * NTHR + threadIdx.x, NGT = (size_t)gridDim.x * NTHR;
#pragma unroll
    for (int g = 0; g < 3; ++g) {
        const int W = 128 << (2 * g);
        float* o = p.out + (g == 0 ? O_KV0P : g == 1 ? O_KV1P : O_KV2P);
        const size_t total = (size_t)BATCH * W * 64;
        for (size_t i0 = gt; i0 < total; i0 += 4 * NGT) {
            u32x4 w[4];
#pragma unroll
            for (int u = 0; u < 4; ++u) { const size_t i = i0 + u * NGT < total ? i0 + u * NGT : total - 1;
                const int vec = (int)(i & 31), which = (int)((i >> 5) & 1); const size_t bj = i >> 6; int j = (int)(bj % W), b = (int)(bj / W); asm volatile("" : "+v"(j), "+v"(b));
                w[u] = *(const u32x4*)(PROJ + ((size_t)b * SEQ + (SEQ - W + j)) * E_IN + QCOL + ((1 + which) * 3 + g) * 256 + 8 * vec); }
#pragma unroll
            for (int u = 0; u < 4; ++u) { const size_t i = i0 + u * NGT;
                if (i < total) { float f[8]; unpack8(w[u], f); float* op = o + i * 8;
                    __builtin_nontemporal_store((f32x4){f[0], f[1], f[2], f[3]}, (f32x4*)op); __builtin_nontemporal_store((f32x4){f[4], f[5], f[6], f[7]}, (f32x4*)(op + 4)); } }
        }
    }
}

__device__ __forceinline__ void phase4(const Params& p) {
    const int tid = threadIdx.x, lane = tid & 63, wave = tid >> 6;
    const int gw = blockIdx.x * NWAVES + wave, NGW = gridDim.x * NWAVES;
    const float* OG = (const float*)(p.ws + WS_OG); const float* LSE = (const float*)(p.ws + WS_LSE);
    bf16* MIX = (bf16*)(p.ws + WS_MIX);
    const int h = lane >> 4;
    for (int row0 = gw; row0 < MP; row0 += 2 * NGW) {
        float l0[2], l1[2], l2[2]; f32x4 o0[2], o1[2], o2[2];
#pragma unroll
        for (int u = 0; u < 2; ++u) { const int row = row0 + u * NGW; const size_t rc = row < MR ? row : MR - 1;
            l0[u] = LSE[rc * 4 + h]; l1[u] = LSE[((size_t)MR + rc) * 4 + h]; l2[u] = LSE[((size_t)2 * MR + rc) * 4 + h];
            o0[u] = *(const f32x4*)(OG + rc * 256 + 4 * lane); o1[u] = *(const f32x4*)(OG + ((size_t)MR + rc) * 256 + 4 * lane); o2[u] = *(const f32x4*)(OG + ((size_t)2 * MR + rc) * 256 + 4 * lane); }
#pragma unroll
        for (int u = 0; u < 2; ++u) { const int row = row0 + u * NGW;
            if (row >= MP) continue;
            if (row >= MR) { *(u32x4*)(MIX + (size_t)row * 512 + 8 * lane) = (u32x4){0u, 0u, 0u, 0u}; continue; }
            const float m = fmaxf(fmaxf(l0[u], l1[u]), l2[u]);
            const float e0 = expf(l0[u] - m), e1 = expf(l1[u] - m), e2 = expf(l2[u] - m), inv = 1.0f / (e0 + e1 + e2);
            const f32x4 a = (o0[u] * e0 + o1[u] * e1 + o2[u] * e2) * inv;
            *(u32x2*)(MIX + (size_t)row * 512 + 256 + 4 * lane) = (u32x2){pk2(a.x, a.y), pk2(a.z, a.w)}; }
    }
}

#ifndef DBG_DUP
#define DBG_DUP 0
#endif

__device__ __forceinline__ void mixc_rows(const Params& p) {
    const bf16* PJ = (const bf16*)(p.ws + WS_PROJ);
    bf16* MIX = (bf16*)(p.ws + WS_MIX);
    const size_t gt = (size_t)blockIdx.x * NTHR + threadIdx.x, NGT = (size_t)gridDim.x * NTHR;
    for (size_t i = gt; i < (size_t)MP * 64; i += NGT) {
        const int row = (int)(i >> 6), c0 = (int)(i & 63) * 8;
        if (row >= MR) { *(u32x4*)(MIX + (size_t)row * D + c0) = (u32x4){0u, 0u, 0u, 0u}; *(u32x4*)(MIX + (size_t)row * D + 512 + c0) = (u32x4){0u, 0u, 0u, 0u}; continue; }
        const bool smp = row >= TP; const int t = smp ? ((row - TP) & 3) : (row & 2047); const int n = smp ? ((row - TP) >> 2) : (row >> 11);
        float ci[3][8];
#pragma unroll
        for (int k = 0; k < 3; ++k) { const int tt = t - 2 + k;
            if (tt >= 0) { float a[8], b[8]; unpack8(*(const u32x4*)(PJ + (size_t)(row - 2 + k) * O_IN + 512 + c0), a); unpack8(*(const u32x4*)(PJ + (size_t)(row - 2 + k) * O_IN + 1024 + c0), b);
#pragma unroll
                for (int e = 0; e < 8; ++e) ci[k][e] = a[e] * b[e]; }
            else if (smp) { const float* sp = p.in[I_SC] + ((size_t)n * 2 + (tt + 2)) * 512 + c0;
#pragma unroll
                for (int e = 0; e < 8; ++e) ci[k][e] = sp[e]; }
            else {
#pragma unroll
                for (int e = 0; e < 8; ++e) ci[k][e] = 0.f; } }
        float bg[8]; unpack8(*(const u32x4*)(PJ + (size_t)row * O_IN + c0), bg);
        float y[8];
#pragma unroll
        for (int e = 0; e < 8; ++e) { const float* w = p.in[I_CCW] + c0 + e;
            y[e] = bg[e] * (w[0] * ci[0][e] + w[512] * ci[1][e] + w[1024] * ci[2][e] + p.in[I_CCB][c0 + e]); }
        *(u32x4*)(MIX + (size_t)row * D + c0) = (u32x4){pk2(y[0], y[1]), pk2(y[2], y[3]), pk2(y[4], y[5]), pk2(y[6], y[7])};
        float* so = nullptr;
        if (smp) { if (t >= 2) so = p.out + O_CS + ((size_t)n * 2 + (t - 2)) * 512 + c0; }
        else if (t >= SEQ - 2) so = p.out + O_CP + ((size_t)n * 2 + (t - (SEQ - 2))) * 512 + c0;
        if (so) { *(f32x4*)so = (f32x4){ci[2][0], ci[2][1], ci[2][2], ci[2][3]}; *(f32x4*)(so + 4) = (f32x4){ci[2][4], ci[2][5], ci[2][6], ci[2][7]}; }
    }
}

constexpr int MD_PITCH = 136;
constexpr int MD_VT = 0, MD_WS = 128 * MD_PITCH * 2, MD_ST = 2 * 128 * MD_PITCH * 2;
__device__ __forceinline__ void mixd_item(const Params& p, LAS unsigned char* lds, int b, int ck, int g) {
    int tid = threadIdx.x; asm volatile("" : "+v"(tid));
    const int lane = tid & 63, wave = tid >> 6, fr = lane & 15, fq = lane >> 4;
    const bf16* PJ = (const bf16*)(p.ws + WS_PROJ);
    bf16* MIX = (bf16*)(p.ws + WS_MIX);
    LAS bf16* vT = (LAS bf16*)(lds + MD_VT); LAS bf16* Wl = (LAS bf16*)(lds + MD_WS); LAS float* st = (LAS float*)(lds + MD_ST);
    const size_t row0 = (size_t)b * SEQ + (size_t)ck * 128;
    {
        const bf16* wsb = (const bf16*)(p.ws + WS_WSB) + (size_t)g * 128 * 128;
        u32x4 w[4];
#pragma unroll
        for (int q = 0; q < 4; ++q) { const int v = tid + q * NTHR; w[q] = *(const u32x4*)(wsb + (size_t)v * 8); }
        u32x4 raw[16];
#pragma unroll
        for (int q = 0; q < 16; ++q) raw[q] = *(const u32x4*)(PJ + (row0 + 16 * wave + q) * O_IN + 2048 + 8 * lane);
#pragma unroll
        for (int q = 0; q < 4; ++q) { const int v = tid + q * NTHR; *(LAS u32x4*)(Wl + (v >> 4) * MD_PITCH + (v & 15) * 8) = w[q]; }
#pragma unroll
        for (int q = 0; q < 16; ++q) {
            float f[8]; unpack8(raw[q], f);
            float s = 0.f;
#pragma unroll
            for (int e = 0; e < 8; ++e) s += f[e];
            const float mu = wave_sum(s) * (1.0f / 512.0f); float s2 = 0.f;
#pragma unroll
            for (int e = 0; e < 8; ++e) { const float dlt = f[e] - mu; s2 += dlt * dlt; }
            const float var = wave_sum(s2) * (1.0f / 512.0f);
            if (lane == 0) { st[2 * (16 * wave + q)] = mu; st[2 * (16 * wave + q) + 1] = 1.0f / sqrtf(var + EPS); } }
    }
    __syncthreads();
    {
        const int j = tid & 127, cq = tid >> 7; const float mu = st[2 * j], rs = st[2 * j + 1];
        u32x4 raw[4];
#pragma unroll
        for (int c8 = 0; c8 < 4; ++c8) raw[c8] = *(const u32x4*)(PJ + (row0 + j) * O_IN + 2048 + g * 128 + 32 * cq + 8 * c8);
#pragma unroll
        for (int c8 = 0; c8 < 4; ++c8) { const int cc = 32 * cq + 8 * c8;
            float f[8]; unpack8(raw[c8], f);
            const f32x4 g0 = *(const f32x4*)(p.in[I_DLG] + g * 128 + cc), g1 = *(const f32x4*)(p.in[I_DLG] + g * 128 + cc + 4);
            const f32x4 b0 = *(const f32x4*)(p.in[I_DLB] + g * 128 + cc), b1 = *(const f32x4*)(p.in[I_DLB] + g * 128 + cc + 4);
            const float gg[8] = {g0.x, g0.y, g0.z, g0.w, g1.x, g1.y, g1.z, g1.w}, bb[8] = {b0.x, b0.y, b0.z, b0.w, b1.x, b1.y, b1.z, b1.w};
#pragma unroll
            for (int e = 0; e < 8; ++e) vT[(cc + e) * MD_PITCH + j] = (bf16)f2bf((f[e] - mu) * rs * gg[e] + bb[e]); }
    }
    __syncthreads();
    f32x4 acc[8];
#pragma unroll
    for (int nc = 0; nc < 8; ++nc) acc[nc] = (f32x4){0.f, 0.f, 0.f, 0.f};
#pragma unroll
    for (int ks = 0; ks < 4; ++ks) {
        const bf16x8 a = *(const LAS bf16x8*)(Wl + (16 * wave + fr) * MD_PITCH + 32 * ks + 8 * fq);
#pragma unroll
        for (int nc = 0; nc < 8; ++nc) { const bf16x8 bb = *(const LAS bf16x8*)(vT + (16 * nc + fr) * MD_PITCH + 32 * ks + 8 * fq);
            acc[nc] = __builtin_amdgcn_mfma_f32_16x16x32_bf16(a, bb, acc[nc], 0, 0, 0); }
    }
#pragma unroll
    for (int rg = 0; rg < 4; ++rg) { const int ii = 16 * wave + 4 * fq + rg; const float bsv = p.in[I_DSB][g * 128 + ii];
        const bf16* up = PJ + (row0 + ii) * O_IN + 1536 + g * 128; bf16* op = MIX + (row0 + ii) * D + 512 + g * 128;
        float uu[8];
#pragma unroll
        for (int nc = 0; nc < 8; ++nc) uu[nc] = bf2f(up[16 * nc + fr]);
#pragma unroll
        for (int nc = 0; nc < 8; ++nc) op[16 * nc + fr] = (bf16)f2bf(uu[nc] * (acc[nc][rg] + bsv)); }
    __syncthreads();
}
__device__ __forceinline__ void mixd_sample(const Params& p, LAS unsigned char* lds, int n) {
    int tid = threadIdx.x; asm volatile("" : "+v"(tid));
    const int lane = tid & 63, wave = tid >> 6;
    const bf16* PJ = (const bf16*)(p.ws + WS_PROJ);
    bf16* MIX = (bf16*)(p.ws + WS_MIX);
    LAS float* red = (LAS float*)lds;
    float x[4], v[4];
#pragma unroll
    for (int s = 0; s < 4; ++s) x[s] = bf2f(PJ[(size_t)(TP + 4 * n + s) * O_IN + 2048 + tid]);
    __syncthreads();
#pragma unroll
    for (int s = 0; s < 4; ++s) { const float t = wave_sum(x[s]); if (lane == 0) red[s * 8 + wave] = t; }
    __syncthreads();
    float mu[4];
#pragma unroll
    for (int s = 0; s < 4; ++s) { float t = 0.f;
#pragma unroll
        for (int w = 0; w < 8; ++w) t += red[s * 8 + w];
        mu[s] = t * (1.0f / 512.0f); }
    __syncthreads();
#pragma unroll
    for (int s = 0; s < 4; ++s) { const float dlt = x[s] - mu[s]; const float t = wave_sum(dlt * dlt); if (lane == 0) red[s * 8 + wave] = t; }
    __syncthreads();
    const float lg = p.in[I_DLG][tid], lb = p.in[I_DLB][tid];
#pragma unroll
    for (int s = 0; s < 4; ++s) { float t = 0.f;
#pragma unroll
        for (int w = 0; w < 8; ++w) t += red[s * 8 + w];
        v[s] = (x[s] - mu[s]) * (1.0f / sqrtf(t * (1.0f / 512.0f) + EPS)) * lg + lb;
        p.out[O_DV + ((size_t)n * 4 + s) * 512 + tid] = v[s]; }
    const int g = tid >> 7;
    const float* wsg = p.in[I_DSW] + (size_t)g * 128 * 128;
#pragma unroll
    for (int i = 0; i < 4; ++i) { float m = p.in[I_DSB][g * 128 + i];
#pragma unroll
        for (int j = 0; j <= i; ++j) m += wsg[i * 128 + j] * v[j];
        const float u = bf2f(PJ[(size_t)(TP + 4 * n + i) * O_IN + 1536 + tid]);
        MIX[(size_t)(TP + 4 * n + i) * D + 512 + tid] = (bf16)f2bf(u * m); }
    __syncthreads();
}
__device__ __forceinline__ void phase11(const Params& p, LAS unsigned char* lds) {
    constexpr int N_D = BATCH * 16 * 4, N_DS = DEC_BATCH;
    for (int it = blockIdx.x; it < N_D + N_DS; it += gridDim.x) {
        if (it < N_D) mixd_item(p, lds, it / 64, (it >> 2) & 15, it & 3); else mixd_sample(p, lds, it - N_D);
    }
    mixc_rows(p);
}

#define XB_TMO      128
#define XB_XCNT(j)  (256  + 64 * (j))
#define XB_XSUB(j)  (1280 + 64 * (j))
#define XB_XGEN(j)  (2304 + 64 * (j))
#define XB_TOP      3328
#define XB_TOPGEN   3392
#define XCD_BAR_WORDS 3456
#define XB_SPIN_CAP (1u << 18)

__device__ __forceinline__ unsigned xb_ld(unsigned* p)              { return __hip_atomic_load(p, __ATOMIC_RELAXED, __HIP_MEMORY_SCOPE_AGENT); }
__device__ __forceinline__ unsigned xb_add(unsigned* p, unsigned v) { return __hip_atomic_fetch_add(p, v, __ATOMIC_RELAXED, __HIP_MEMORY_SCOPE_AGENT); }
__device__ __forceinline__ unsigned xb_xcc_id() { return (unsigned)__builtin_amdgcn_s_getreg((3 << 11) | 20) & 0xFu; }
#define XB_SPIN(cond, bar) do { unsigned _sp = 0; while (cond) { __builtin_amdgcn_s_sleep(1); \
    if ((++_sp & 255u) == 0u) { if (xb_ld(&(bar)[XB_TMO])) break; if (_sp > XB_SPIN_CAP) { atomicAdd(&(bar)[XB_TMO], 1u); break; } } } } while (0)

struct XcdBarrier {
    unsigned* bar; unsigned x;
    volatile LAS unsigned* st;
};

__device__ __forceinline__ XcdBarrier xcd_barrier_post(unsigned* bar, volatile LAS unsigned* st) {
    XcdBarrier b; b.bar = bar; b.x = xb_xcc_id(); b.st = st;
    if (threadIdx.x == 0) (void)xb_add(&bar[XB_XCNT(b.x)], 1u);
    return b;
}
__device__ __forceinline__ void xcd_barrier_complete(unsigned* bar, unsigned x, unsigned& nloc, unsigned& nx) {
    const unsigned G = gridDim.x * gridDim.y * gridDim.z;
    unsigned sum, cnt, mine, sp = 0u;
    for (;;) {
        sum = 0u; cnt = 0u; mine = 0u;
#pragma unroll
        for (unsigned j = 0; j < 16; ++j) { const unsigned c = xb_ld(&bar[XB_XCNT(j)]); sum += c; cnt += (c > 0u) ? 1u : 0u; mine = (j == x) ? c : mine; }
        if (sum == G) break;
        __builtin_amdgcn_s_sleep(1);
        if ((++sp & 255u) == 0u) { if (xb_ld(&bar[XB_TMO])) break; if (sp > XB_SPIN_CAP) { atomicAdd(&bar[XB_TMO], 1u); break; } }
    }
    nloc = mine > 0u ? mine : 1u; nx = cnt > 0u ? cnt : 1u;
}

__device__ __forceinline__ void xcd_barrier(const XcdBarrier& b) {
    asm volatile("s_waitcnt vmcnt(0)" ::: "memory");
    __syncthreads();
    if (threadIdx.x == 0) {
        unsigned* bar = b.bar;
        __builtin_amdgcn_s_waitcnt(0);
        unsigned nloc = b.st[0], nx = b.st[1];
        if (nloc == 0u) { xcd_barrier_complete(bar, b.x, nloc, nx); b.st[0] = nloc; b.st[1] = nx; }
        const unsigned old = xb_add(&bar[XB_XSUB(b.x)], 1u);
        const unsigned gen = old / nloc;
        if (old + 1u == (gen + 1u) * nloc) {
            __builtin_amdgcn_fence(__ATOMIC_RELEASE, "agent");
            asm volatile("s_waitcnt vmcnt(0)" ::: "memory");
            const unsigned og = xb_add(&bar[XB_TOP], 1u);
            const unsigned tg = og / nx;
            if (og + 1u == (tg + 1u) * nx) xb_add(&bar[XB_TOPGEN], 1u);
            else XB_SPIN(xb_ld(&bar[XB_TOPGEN]) == tg, bar);
            __builtin_amdgcn_fence(__ATOMIC_ACQUIRE, "agent");
            xb_add(&bar[XB_XGEN(b.x)], 1u);
            asm volatile("s_waitcnt vmcnt(0)" ::: "memory");
        } else {
            XB_SPIN(xb_ld(&bar[XB_XGEN(b.x)]) == gen, bar);
            __builtin_amdgcn_fence(__ATOMIC_ACQUIRE, "agent");
            asm volatile("s_waitcnt vmcnt(0)" ::: "memory");
        }
    }
    __syncthreads();
}

template <bool COOP>
__global__ void __launch_bounds__(NTHR, 2) fwd_kernel(Params p) {
    extern __shared__ __attribute__((aligned(16))) unsigned char lds_raw[];
    LAS unsigned char* lds = (LAS unsigned char*)lds_raw;
    unsigned char* ws = p.ws;
    float* mod = (float*)(ws + WS_MOD);
    float* X = (float*)(ws + WS_X);
    bf16* H = (bf16*)(ws + WS_H); bf16* PROJ = (bf16*)(ws + WS_PROJ); bf16* MIX = (bf16*)(ws + WS_MIX); bf16* ACT = (bf16*)(ws + WS_ACT);
    const int lo = p.ph_lo, hi = p.ph_hi;
    XcdBarrier bar; bar.bar = (unsigned*)(ws + WS_CTL) + CW_BAR; bar.x = 0; bar.st = nullptr;
    if (COOP) {
        for (int u = threadIdx.x; u < (LDS_BYTES - LDSCTL_OFF) / 4; u += NTHR) ((LAS unsigned*)(lds + LDSCTL_OFF))[u] = 0u;
        __syncthreads();
        bar = xcd_barrier_post((unsigned*)(ws + WS_CTL) + CW_BAR, (volatile LAS unsigned*)(lds + LDSCTL_OFF + 320) + 8);
    }
#define IN(k) (lo <= (k) && (k) < hi)
#define SEAM(k) do { if (COOP) { if ((k) + 1 < hi) xcd_barrier(bar); } } while (0)
#define GEMM_PHASE(EpiT, Aptr, Wptr, Mrows, Ncols, Kdim, ...) do { pg8::Gemm g_{(const pg8::bf16_t*)(Aptr), (const pg8::bf16_t*)(Wptr), Mrows, Ncols, Kdim}; \
        pg8::StaticOrder S_; S_.init(Mrows, Ncols, (int)gridDim.x, (int)blockIdx.x); pg8::EpiT E_{__VA_ARGS__}; \
        pg8::gemm_phase<pg8::EpiT, pg8::StaticOrder, true, true>(lds, g_, S_, E_); } while (0)

    if (IN(0)) for (int rep_ = 0; rep_ <= ((DBG_DUP >> 0) & 1); ++rep_) { phase0(p, lds); SEAM(0); }
    if (IN(1)) for (int rep_ = 0; rep_ <= ((DBG_DUP >> 1) & 1); ++rep_) { norm_phase<false>(p.in[I_XP], p.in[I_XS], p.in[I_NMG], mod + 0 * D, mod + 1 * D, H, nullptr, nullptr); SEAM(1); }
    if (IN(2)) for (int rep_ = 0; rep_ <= ((DBG_DUP >> 2) & 1); ++rep_) { GEMM_PHASE(EpiStoreBf16, H, ws + WS_WEIN, MP, E_IN, D, (pg8::bf16_t*)PROJ, E_IN, 1 << 30); SEAM(2); }
    if (IN(3)) for (int rep_ = 0; rep_ <= ((DBG_DUP >> 3) & 1); ++rep_) { phase3(p, lds); SEAM(3); }
    if (IN(4)) for (int rep_ = 0; rep_ <= ((DBG_DUP >> 4) & 1); ++rep_) { phase4(p); SEAM(4); }
    if (IN(5)) for (int rep_ = 0; rep_ <= ((DBG_DUP >> 5) & 1); ++rep_) { GEMM_PHASE(EpiResid, MIX, ws + WS_WEOUT, MP, D, 512, p.in[I_XP], p.in[I_XS], X, mod + 2 * D); SEAM(5); }
    if (IN(6)) for (int rep_ = 0; rep_ <= ((DBG_DUP >> 6) & 1); ++rep_) { norm_phase<false>(X, X + (size_t)TP * D, p.in[I_NFG], mod + 3 * D, mod + 4 * D, H, nullptr, nullptr); SEAM(6); }
    if (IN(7)) for (int rep_ = 0; rep_ <= ((DBG_DUP >> 7) & 1); ++rep_) { GEMM_PHASE(EpiSwiGLU, H, ws + WS_WGU0, MP, 2 * FFN, D, (pg8::bf16_t*)ACT, FFN); SEAM(7); }
    if (IN(8)) for (int rep_ = 0; rep_ <= ((DBG_DUP >> 8) & 1); ++rep_) { GEMM_PHASE(EpiResid, ACT, ws + WS_WDN0, MP, D, FFN, X, X + (size_t)TP * D, X, mod + 5 * D); SEAM(8); }
    const float* mod1 = mod + (size_t)NB * MODW;
    if (IN(9)) for (int rep_ = 0; rep_ <= ((DBG_DUP >> 9) & 1); ++rep_) { norm_phase<false>(X, X + (size_t)TP * D, p.in[I_NMG] + D, mod1 + 0 * D, mod1 + 1 * D, H, nullptr, nullptr); SEAM(9); }
    if (IN(10)) for (int rep_ = 0; rep_ <= ((DBG_DUP >> 10) & 1); ++rep_) { GEMM_PHASE(EpiStoreBf16, H, ws + WS_WOIN, MP, O_IN, D, (pg8::bf16_t*)PROJ, O_IN, 6); SEAM(10); }
    if (IN(11)) for (int rep_ = 0; rep_ <= ((DBG_DUP >> 11) & 1); ++rep_) { phase11(p, lds); SEAM(11); }
    if (IN(12)) for (int rep_ = 0; rep_ <= ((DBG_DUP >> 12) & 1); ++rep_) { GEMM_PHASE(EpiResid, MIX, ws + WS_WOOUT, MP, D, D, X, X + (size_t)TP * D, X, mod1 + 2 * D); SEAM(12); }
    if (IN(13)) for (int rep_ = 0; rep_ <= ((DBG_DUP >> 13) & 1); ++rep_) { norm_phase<false>(X, X + (size_t)TP * D, p.in[I_NFG] + D, mod1 + 3 * D, mod1 + 4 * D, H, nullptr, nullptr); SEAM(13); }
    if (IN(14)) for (int rep_ = 0; rep_ <= ((DBG_DUP >> 14) & 1); ++rep_) { GEMM_PHASE(EpiSwiGLU, H, ws + WS_WGU1, MP, 2 * FFN, D, (pg8::bf16_t*)ACT, FFN); SEAM(14); }
    if (IN(15)) for (int rep_ = 0; rep_ <= ((DBG_DUP >> 15) & 1); ++rep_) { GEMM_PHASE(EpiResid, ACT, ws + WS_WDN1, MP, D, FFN, X, X + (size_t)TP * D, X, mod1 + 5 * D); SEAM(15); }
    if (IN(16)) for (int rep_ = 0; rep_ <= ((DBG_DUP >> 16) & 1); ++rep_) { norm_phase<true>(X, X + (size_t)TP * D, p.in[I_FNG], nullptr, nullptr, nullptr, p.out + O_YP, p.out + O_YS); }
#undef IN
#undef SEAM
#undef GEMM_PHASE
}

#ifndef DBG_PH_HI
#define DBG_PH_HI NPHASE
#endif
#ifndef MK_MULTI
#define MK_MULTI 1
#endif
extern "C" void kernel_launch(void* const* d_in, const int* in_sizes, int n_in, void* d_out, int out_size, void* d_ws, size_t ws_size, hipStream_t stream) {
    static int grid = 0;
    if (grid == 0) {
        if (n_in != N_IN || out_size != (int)O_END || ws_size < WS_END) { fprintf(stderr, "kernel_launch: unexpected shapes: n_in %d out %d ws %zu (need %zu)\n", n_in, out_size, ws_size, (size_t)WS_END); grid = -1; return; }
        int dev = 0, cus = 0, per_cu = 0;
        if (hipGetDevice(&dev) != hipSuccess || hipDeviceGetAttribute(&cus, hipDeviceAttributeMultiprocessorCount, dev) != hipSuccess) { grid = -1; return; }
        hipFuncSetAttribute((const void*)fwd_kernel<true>, hipFuncAttributeMaxDynamicSharedMemorySize, LDS_BYTES);
        hipFuncSetAttribute((const void*)fwd_kernel<false>, hipFuncAttributeMaxDynamicSharedMemorySize, LDS_BYTES);
        if (hipOccupancyMaxActiveBlocksPerMultiprocessor(&per_cu, (const void*)fwd_kernel<true>, NTHR, LDS_BYTES) != hipSuccess || per_cu < 1) { fprintf(stderr, "kernel_launch: occupancy query says %d blocks per CU\n", per_cu); per_cu = 1; }
        (void)hipGetLastError();
        grid = cus;
    }
    if (grid < 0) return;
    Params prm{};
    for (int i = 0; i < N_IN; ++i) prm.in[i] = (const float*)d_in[i];
    prm.out = (float*)d_out; prm.ws = (unsigned char*)d_ws;
#if MK_MULTI
    for (int ph = 0; ph < DBG_PH_HI; ++ph) { prm.ph_lo = ph; prm.ph_hi = ph + 1;
        hipLaunchKernelGGL(fwd_kernel<false>, dim3(grid), dim3(NTHR), LDS_BYTES, stream, prm); }
#else
    prm.ph_lo = 0; prm.ph_hi = NPHASE;
    if (hipMemsetAsync((char*)d_ws + WS_CTL, 0, CTL_ZERO_BYTES, stream) != hipSuccess) { fprintf(stderr, "kernel_launch: memset of the control words failed\n"); return; }
    void* args[] = {&prm};
    hipError_t e = hipLaunchCooperativeKernel((const void*)fwd_kernel<true>, dim3(grid), dim3(NTHR), args, LDS_BYTES, stream);
    if (e != hipSuccess) fprintf(stderr, "cooperative launch failed: %s (grid %d)\n", hipGetErrorString(e), grid);
#endif
}
```

```cpp
#define MK_MULTI 0
#include <hip/hip_runtime.h>
#include <hip/hip_cooperative_groups.h>
#include <cstdio>
#include <cstdint>
namespace cg = cooperative_groups;

constexpr int D = 1024, BATCH = 8, SEQ = 2048, DEC_BATCH = 32, DEC_SEQ = 4, NB = BATCH + DEC_BATCH;
constexpr int TP = BATCH * SEQ;
constexpr int TS = DEC_BATCH * DEC_SEQ;
constexpr int MR = TP + TS;
constexpr int MP = 16640;
constexpr int E_IN = 2816, O_IN = 2560, FFN = 2816, MODW = 6 * D;
constexpr float EPS = 1e-6f;
namespace pg8 {
#define PG8_LAS __attribute__((address_space(3)))
typedef unsigned short bf16_t;
typedef short bf16x8 __attribute__((ext_vector_type(8)));
typedef float f32x4 __attribute__((ext_vector_type(4)));
typedef unsigned u32x4 __attribute__((ext_vector_type(4)));
constexpr int BM = 256, BK = 64, HALF = 128, HTB = HALF * BK * 2  , STAGE_BYTES = 8 * HTB, NXCD = 8, WGM = 8;

__host__ __device__ __forceinline__ int lds_byte(int r, int c) { const int st = (r >> 4) * 2 + (c >> 5), rr = r & 15, cc = c & 31, ob = rr * 64 + cc * 2; return st * 1024 + (ob ^ (((ob >> 9) & 1) << 5)); }
__host__ __device__ __forceinline__ void stage_rc(int b, int& R, int& C) { const int st = b / 1024, sb = b % 1024, swz = sb ^ (((sb >> 9) & 1) << 5); R = (st >> 1) * 16 + swz / 64; C = (st & 1) * 32 + (swz % 64) / 2; }
__host__ __device__ __forceinline__ int perm32(int rho) { const int n = rho >> 4, i = rho & 15; return 8 * (i >> 2) + 4 * n + (i & 3); }

struct Unit { int pm, pn; };
struct Gemm { const bf16_t* A; const bf16_t* Bt; int M, N, K; };

struct StaticOrder {
    int nM, nN, nwg, G, c;
    __host__ __device__ void init(int M, int N, int G_, int c_) { nM = M / BM; nN = N / BM; nwg = nM * nN; G = G_; c = c_; }
    __host__ __device__ bool next(int i, Unit& u) const {
        const long L = (long)i * G + c; if (L >= nwg) return false;
        int wgid = (int)L; { const int q = nwg / NXCD, r = nwg % NXCD, xcd = wgid % NXCD, off = wgid / NXCD; wgid = (xcd < r ? xcd * (q + 1) : r * (q + 1) + (xcd - r) * q) + off; }
        const int nig = WGM * nN, gid = wgid / nig, fm = gid * WGM, gsz = (nM - fm) < WGM ? (nM - fm) : WGM;
        u.pm = fm + ((wgid % nig) % gsz); u.pn = (wgid % nig) / gsz; return true;
    }
    __device__ __forceinline__ void a_ready(const Unit&) const {}
    __device__ __forceinline__ void done(const Unit&) const {}
};

__device__ __forceinline__ unsigned cvt_pk_bf16(float lo, float hi) { unsigned r; asm volatile("v_cvt_pk_bf16_f32 %0, %1, %2" : "=v"(r) : "v"(lo), "v"(hi)); return r; }
typedef float f32x2 __attribute__((ext_vector_type(2)));
__device__ __forceinline__ f32x2 gelu_pk(f32x2 v) {
    const f32x2 av = __builtin_elementwise_abs(v), d = av * 0.2316418882f + 1.0f;
    f32x2 t; t.x = __builtin_amdgcn_rcpf(d.x); t.y = __builtin_amdgcn_rcpf(d.y);
    f32x2 q = t * 0.5307027145f + (-0.7265760135f); q = q * t + 0.7107068705f; q = q * t + (-0.142248368f); q = q * t + 0.127414796f; q = q * t;
    const f32x2 s = (v * v) * (-0.72134752044f);
    f32x2 e; e.x = __builtin_amdgcn_exp2f(s.x); e.y = __builtin_amdgcn_exp2f(s.y);
    const f32x2 m = v * (q * e), r = v - m;
    f32x2 o; o.x = v.x < 0.f ? m.x : r.x; o.y = v.y < 0.f ? m.y : r.y; return o;
}

template <int ACT  > struct EpiBf16 {
    static constexpr bool PERM = true, AFTER_DRAIN = false; static_assert(ACT == 0 || ACT == 1, "EpiBf16: ACT is 0 (none) or 1 (gelu_pk)");
    bf16_t* O; int ldc; const float* bias; int split_cols; size_t split_stride; float scale0;
    __device__ __forceinline__ void operator()(const f32x4 (&acc)[2][2][4][2], const Unit& u, int wr, int wc, int fr, int fq) const {
        const int row0 = u.pm * BM + wr * 64 + fr; int colt = u.pn * BM; bf16_t* base = O;
        float sc = 1.f; if (split_cols) { const int t = colt / split_cols; base += (size_t)t * split_stride; colt -= t * split_cols; if (t == 0) sc = scale0; }
        const int col0 = colt + wc * 32 + 8 * fq, bcol0 = u.pn * BM + wc * 32 + 8 * fq;
        f32x4 bv[2][2];
#pragma unroll
        for (int bj = 0; bj < 2; ++bj)
#pragma unroll
            for (int n = 0; n < 2; ++n) bv[bj][n] = bias ? *(const f32x4*)(bias + bcol0 + bj * HALF + 4 * n) : (f32x4){0.f, 0.f, 0.f, 0.f};
#pragma unroll
        for (int ai = 0; ai < 2; ++ai)
#pragma unroll
            for (int m = 0; m < 4; ++m) { bf16_t* rowp = base + (size_t)(row0 + ai * HALF + m * 16) * ldc + col0;
#pragma unroll
                for (int bj = 0; bj < 2; ++bj) { f32x4 v0 = acc[ai][bj][m][0] + bv[bj][0], v1 = acc[ai][bj][m][1] + bv[bj][1];
                    if (ACT == 1) { f32x2 a = gelu_pk((f32x2){v0[0], v0[1]}), b = gelu_pk((f32x2){v0[2], v0[3]}), c = gelu_pk((f32x2){v1[0], v1[1]}), d = gelu_pk((f32x2){v1[2], v1[3]});
                        v0 = (f32x4){a.x, a.y, b.x, b.y}; v1 = (f32x4){c.x, c.y, d.x, d.y}; }
                    v0 = v0 * sc; v1 = v1 * sc; u32x4 w; w.x = cvt_pk_bf16(v0[0], v0[1]); w.y = cvt_pk_bf16(v0[2], v0[3]); w.z = cvt_pk_bf16(v1[0], v1[1]); w.w = cvt_pk_bf16(v1[2], v1[3]);
                    *(u32x4*)(rowp + bj * HALF) = w; } }
    }
};

__device__ __forceinline__ float gelu_tanh_f(float x) {
    const float y = 1.5957691216057308f * (x + 0.044715f * x * x * x);
    return x * __builtin_amdgcn_rcpf(1.0f + __builtin_amdgcn_exp2f(-1.4426950408889634f * y));
}
__device__ __forceinline__ float silu_f(float x) { return x * __builtin_amdgcn_rcpf(1.0f + __builtin_amdgcn_exp2f(-1.4426950408889634f * x)); }

struct EpiStoreBf16 {
    static constexpr bool PERM = true, AFTER_DRAIN = false;
    bf16_t* O; int ldc; int gelu_from;
    __device__ __forceinline__ void operator()(const f32x4 (&acc)[2][2][4][2], const Unit& u, int wr, int wc, int fr, int fq) const {
        const int row0 = u.pm * BM + wr * 64 + fr, col0 = u.pn * BM + wc * 32 + 8 * fq;
        const bool g = u.pn >= gelu_from;
#pragma unroll
        for (int ai = 0; ai < 2; ++ai)
#pragma unroll
            for (int m = 0; m < 4; ++m) { bf16_t* rowp = O + (size_t)(row0 + ai * HALF + m * 16) * ldc + col0;
#pragma unroll
                for (int bj = 0; bj < 2; ++bj) { f32x4 v0 = acc[ai][bj][m][0], v1 = acc[ai][bj][m][1];
                    if (g) {
#pragma unroll
                        for (int j = 0; j < 4; ++j) { v0[j] = gelu_tanh_f(v0[j]); v1[j] = gelu_tanh_f(v1[j]); } }
                    u32x4 w; w.x = cvt_pk_bf16(v0[0], v0[1]); w.y = cvt_pk_bf16(v0[2], v0[3]); w.z = cvt_pk_bf16(v1[0], v1[1]); w.w = cvt_pk_bf16(v1[2], v1[3]);
                    *(u32x4*)(rowp + bj * HALF) = w; } }
    }
};
struct EpiSwiGLU {
    static constexpr bool PERM = true, AFTER_DRAIN = false;
    bf16_t* O; int ldc;
    __device__ __forceinline__ void operator()(const f32x4 (&acc)[2][2][4][2], const Unit& u, int wr, int wc, int fr, int fq) const {
        const int row0 = u.pm * BM + wr * 64 + fr, col0 = (u.pn * BM + wc * 32 + 8 * fq) >> 1;
#pragma unroll
        for (int ai = 0; ai < 2; ++ai)
#pragma unroll
            for (int m = 0; m < 4; ++m) { bf16_t* rowp = O + (size_t)(row0 + ai * HALF + m * 16) * ldc + col0;
#pragma unroll
                for (int bj = 0; bj < 2; ++bj) { const f32x4 v0 = acc[ai][bj][m][0], v1 = acc[ai][bj][m][1];
                    const float a0 = silu_f(v0[0]) * v0[1], a1 = silu_f(v0[2]) * v0[3], a2 = silu_f(v1[0]) * v1[1], a3 = silu_f(v1[2]) * v1[3];
                    typedef unsigned u32x2 __attribute__((ext_vector_type(2)));
                    u32x2 w; w.x = cvt_pk_bf16(a0, a1); w.y = cvt_pk_bf16(a2, a3);
                    *(u32x2*)(rowp + bj * (HALF / 2)) = w; } }
    }
};
struct EpiResid {
    static constexpr bool PERM = false, AFTER_DRAIN = false;
    const float* xin_p; const float* xin_s; float* xout; const float* gate;
    __device__ __forceinline__ void operator()(const f32x4 (&acc)[2][2][4][2], const Unit& u, int wr, int wc, int fr, int fq) const {
        const int row0 = u.pm * BM + wr * 64 + fr, col0 = u.pn * BM + wc * 32 + 4 * fq;
#pragma unroll
        for (int ai = 0; ai < 2; ++ai)
#pragma unroll
            for (int m = 0; m < 4; ++m) { const int row = row0 + ai * HALF + m * 16;
                if (row < MR) {
                    const int nb = row < TP ? (row >> 11) : BATCH + ((row - TP) >> 2);
                    const float* gp = gate + (size_t)nb * MODW + col0;
                    const float* xi = (row < TP ? xin_p + (size_t)row * D : xin_s + (size_t)(row - TP) * D) + col0;
                    float* xo = xout + (size_t)row * D + col0;
#pragma unroll
                    for (int bj = 0; bj < 2; ++bj)
#pragma unroll
                        for (int n = 0; n < 2; ++n) { const int off = bj * HALF + n * 16;
                            const f32x4 gv = *(const f32x4*)(gp + off), xv = *(const f32x4*)(xi + off);
                            *(f32x4*)(xo + off) = xv + gv * acc[ai][bj][m][n]; } } }
    }
};
template <class Epi, class Sched, bool ALIGN_EPI = false, bool SP2 = false>
__device__ __forceinline__ void gemm_phase(PG8_LAS unsigned char* lds, const Gemm g, const Sched& S, const Epi& E) {
    const int tid = threadIdx.x, wid = __builtin_amdgcn_readfirstlane(tid >> 6), lane = tid & 63, wr = wid >> 2, wc = wid & 3, fr = lane & 15, fq = lane >> 4;
    const int K = g.K, nt = K / BK;
    unsigned voffA[2], voffB[2];
#pragma unroll
    for (int i = 0; i < 2; ++i) { int R, C; stage_rc(tid * 16 + i * 8192, R, C); const int Rb = Epi::PERM ? ((R & ~31) + perm32(R & 31)) : R;
        voffA[i] = (unsigned)(R * K + C) * 2u; voffB[i] = (unsigned)(Rb * K + C) * 2u; }
    const size_t kstep = (size_t)(BK * 2);
    const size_t hstep = (size_t)HALF * K * 2;
    const size_t tstep = 2 * hstep;
    const unsigned ldsw = (unsigned)wid * 1024u;
    const int aoff = lds_byte(wr * 64 + fr, fq * 8), boff = lds_byte(wc * 32 + fr, fq * 8);
#define PG8_SA(b, h) (((b) * 2 + (h)) * HTB)
#define PG8_SB(b, h) ((4 + (b) * 2 + (h)) * HTB)
#define PG8_STAGE(bufoff, gbase, voff) do { _Pragma("unroll") for (int _i = 0; _i < 2; ++_i) \
        __builtin_amdgcn_global_load_lds((const unsigned*)((const char*)(gbase) + (voff)[_i]), (PG8_LAS unsigned*)(lds + (bufoff) + ldsw + _i * 8192), 16, 0, 0); } while (0)
#define PG8_LDA(dst, b, h) do { _Pragma("unroll") for (int m = 0; m < 4; ++m) _Pragma("unroll") for (int k = 0; k < 2; ++k) dst[m][k] = *(const PG8_LAS bf16x8*)(lds + PG8_SA(b, h) + aoff + m * 2048 + k * 1024); } while (0)
#define PG8_LDB(dst, b, h) do { _Pragma("unroll") for (int n = 0; n < 2; ++n) _Pragma("unroll") for (int k = 0; k < 2; ++k) dst[n][k] = *(const PG8_LAS bf16x8*)(lds + PG8_SB(b, h) + boff + n * 2048 + k * 1024); } while (0)
#define PG8_MMA(ai, bj, At, Bt) do { __builtin_amdgcn_s_setprio(1); _Pragma("unroll") for (int m = 0; m < 4; ++m) _Pragma("unroll") for (int n = 0; n < 2; ++n) _Pragma("unroll") for (int k = 0; k < 2; ++k) \
        acc[ai][bj][m][n] = __builtin_amdgcn_mfma_f32_16x16x32_bf16(Bt[n][k], At[m][k], acc[ai][bj][m][n], 0, 0, 0); __builtin_amdgcn_s_setprio(0); } while (0)
#define PG8_WAIT_V(n) asm volatile("s_waitcnt vmcnt(" #n ")" ::: "memory")
#define PG8_WAIT_L(n) asm volatile("s_waitcnt lgkmcnt(" #n ")" ::: "memory")
#define PG8_BAR __builtin_amdgcn_s_barrier()
#define PG8_SCHED __builtin_amdgcn_sched_barrier(0)
    Unit cur, nxt; int ui = 0;
    if (!S.next(0, cur)) return;
    f32x4 acc[2][2][4][2];
#pragma unroll
    for (int a = 0; a < 2; ++a)
#pragma unroll
        for (int b = 0; b < 2; ++b)
#pragma unroll
            for (int m = 0; m < 4; ++m)
#pragma unroll
                for (int n = 0; n < 2; ++n) acc[a][b][m][n] = (f32x4){0.f, 0.f, 0.f, 0.f};
    bf16x8 At[4][2], B0[2][2], B1[2][2];
    const char* cA = (const char*)g.A + (size_t)cur.pm * tstep; const char* cB = (const char*)g.Bt + (size_t)cur.pn * tstep;
    S.a_ready(cur);
    if constexpr (SP2) {
        PG8_STAGE(PG8_SB(0, 0), cB, voffB); PG8_STAGE(PG8_SB(0, 1), cB + hstep, voffB); PG8_STAGE(PG8_SA(0, 0), cA, voffA); PG8_STAGE(PG8_SA(0, 1), cA + hstep, voffA);
        if (wr == 1) PG8_BAR;
        PG8_WAIT_V(2); PG8_BAR;
        PG8_STAGE(PG8_SB(1, 0), cB + kstep, voffB); PG8_STAGE(PG8_SA(1, 0), cA + kstep, voffA); PG8_STAGE(PG8_SB(1, 1), cB + hstep + kstep, voffB);
        PG8_WAIT_V(6); PG8_BAR;
    } else {
        PG8_STAGE(PG8_SB(0, 0), cB, voffB); PG8_STAGE(PG8_SA(0, 0), cA, voffA); PG8_STAGE(PG8_SB(0, 1), cB + hstep, voffB); PG8_STAGE(PG8_SA(0, 1), cA + hstep, voffA);
        if (wr == 1) PG8_BAR;
        PG8_WAIT_V(4); PG8_BAR;
        PG8_STAGE(PG8_SB(1, 0), cB + kstep, voffB); PG8_STAGE(PG8_SA(1, 0), cA + kstep, voffA); PG8_STAGE(PG8_SB(1, 1), cB + hstep + kstep, voffB);
        PG8_WAIT_V(6); PG8_BAR;
    }
    for (;;) {
        const bool has_next = S.next(ui + 1, nxt);
        const char* nA = has_next ? (const char*)g.A + (size_t)nxt.pm * tstep : cA; const char* nB = has_next ? (const char*)g.Bt + (size_t)nxt.pn * tstep : cB;
        for (int t = 0; t < nt; t += 2) {
            const bool last = (t == nt - 2);
            const char* a1 = cA + (size_t)(t + 1) * kstep;
            const char* a2 = last ? nA : cA + (size_t)(t + 2) * kstep; const char* b2 = last ? nB : cB + (size_t)(t + 2) * kstep;
            const char* a3 = a2 + kstep; const char* b3 = b2 + kstep;
            if (last && has_next) S.a_ready(nxt);
            if constexpr (SP2) {
            PG8_LDB(B0, 0, 0); PG8_LDB(B1, 0, 1); PG8_SCHED; PG8_LDA(At, 0, 0); PG8_STAGE(PG8_SA(1, 1), a1 + hstep, voffA);
            PG8_WAIT_V(8); PG8_WAIT_L(0); PG8_BAR; PG8_MMA(0, 0, At, B0); PG8_MMA(0, 1, At, B1); PG8_BAR; PG8_SCHED;
            PG8_LDA(At, 0, 1); PG8_STAGE(PG8_SB(0, 0), b2, voffB); PG8_STAGE(PG8_SB(0, 1), b2 + hstep, voffB); PG8_STAGE(PG8_SA(0, 0), a2, voffA);
            PG8_WAIT_V(8); PG8_WAIT_L(0); PG8_BAR; PG8_MMA(1, 0, At, B0); PG8_MMA(1, 1, At, B1); PG8_BAR; PG8_SCHED;
            PG8_LDB(B0, 1, 0); PG8_LDB(B1, 1, 1); PG8_SCHED; PG8_LDA(At, 1, 0); PG8_STAGE(PG8_SA(0, 1), a2 + hstep, voffA);
            PG8_WAIT_V(8); PG8_WAIT_L(0); PG8_BAR; PG8_MMA(0, 0, At, B0); PG8_MMA(0, 1, At, B1); PG8_BAR; PG8_SCHED;
            PG8_LDA(At, 1, 1); PG8_STAGE(PG8_SB(1, 0), b3, voffB); PG8_STAGE(PG8_SB(1, 1), b3 + hstep, voffB); PG8_STAGE(PG8_SA(1, 0), a3, voffA);
            PG8_WAIT_V(8); PG8_WAIT_L(0); PG8_BAR; PG8_MMA(1, 0, At, B0); PG8_MMA(1, 1, At, B1); PG8_BAR; PG8_SCHED;
            } else {
            PG8_LDB(B0, 0, 0); PG8_SCHED; PG8_LDA(At, 0, 0); PG8_STAGE(PG8_SA(1, 1), a1 + hstep, voffA);
            PG8_WAIT_L(8); PG8_BAR; PG8_WAIT_L(0); PG8_MMA(0, 0, At, B0); PG8_BAR; PG8_SCHED;
            PG8_LDB(B1, 0, 1); PG8_STAGE(PG8_SB(0, 0), b2, voffB);
            PG8_BAR; PG8_WAIT_L(0); PG8_MMA(0, 1, At, B1); PG8_BAR;
            PG8_LDA(At, 0, 1); PG8_STAGE(PG8_SA(0, 0), a2, voffA);
            PG8_BAR; PG8_WAIT_L(0); PG8_MMA(1, 0, At, B0); PG8_BAR; PG8_SCHED;
            PG8_STAGE(PG8_SB(0, 1), b2 + hstep, voffB);
            PG8_WAIT_V(6); PG8_BAR; PG8_MMA(1, 1, At, B1); PG8_BAR;
            PG8_LDB(B0, 1, 0); PG8_SCHED; PG8_LDA(At, 1, 0); PG8_STAGE(PG8_SA(0, 1), a2 + hstep, voffA);
            PG8_WAIT_L(8); PG8_BAR; PG8_WAIT_L(0); PG8_MMA(0, 0, At, B0); PG8_BAR; PG8_SCHED;
            PG8_LDB(B1, 1, 1); PG8_STAGE(PG8_SB(1, 0), b3, voffB);
            PG8_BAR; PG8_WAIT_L(0); PG8_MMA(0, 1, At, B1); PG8_BAR;
            PG8_LDA(At, 1, 1); PG8_STAGE(PG8_SA(1, 0), a3, voffA);
            PG8_BAR; PG8_WAIT_L(0); PG8_MMA(1, 0, At, B0); PG8_BAR; PG8_SCHED;
            PG8_STAGE(PG8_SB(1, 1), b3 + hstep, voffB);
            PG8_WAIT_V(6); PG8_BAR; PG8_MMA(1, 1, At, B1); PG8_BAR;
            }
        }
        if constexpr (ALIGN_EPI) { if (wr == 0) PG8_BAR; }
        if constexpr (!Epi::AFTER_DRAIN) { E(acc, cur, wr, wc, fr, fq); S.done(cur); }
        if (!has_next) break;
#pragma unroll
        for (int a = 0; a < 2; ++a)
#pragma unroll
            for (int b = 0; b < 2; ++b)
#pragma unroll
                for (int m = 0; m < 4; ++m)
#pragma unroll
                    for (int n = 0; n < 2; ++n) acc[a][b][m][n] = (f32x4){0.f, 0.f, 0.f, 0.f};
        cur = nxt; cA = nA; cB = nB; ++ui;
        if constexpr (ALIGN_EPI) { if (wr == 1) PG8_BAR; }
    }
    PG8_WAIT_V(0);
    if constexpr (!ALIGN_EPI) { if (wr == 0) PG8_BAR; }
    PG8_BAR;
    if constexpr (Epi::AFTER_DRAIN) { E.fused(acc, cur, wr, wc, fr, fq, lds, wid, lane); S.done(cur); }
#undef PG8_SA
#undef PG8_SB
#undef PG8_STAGE
#undef PG8_LDA
#undef PG8_LDB
#undef PG8_MMA
#undef PG8_WAIT_V
#undef PG8_WAIT_L
#undef PG8_BAR
#undef PG8_SCHED
}
}

#define GAS __attribute__((address_space(1)))
#define LAS __attribute__((address_space(3)))
typedef unsigned short bf16;
typedef float f32x4 __attribute__((ext_vector_type(4)));
typedef short bf16x8 __attribute__((ext_vector_type(8)));
typedef unsigned u32x4 __attribute__((ext_vector_type(4)));
typedef unsigned u32x2 __attribute__((ext_vector_type(2)));

constexpr int NWAVES = 8, NTHR = 512;
constexpr int LDS_BYTES = 147456;
constexpr int NPHASE = 17;
constexpr int LDSCTL_OFF = 131072;
constexpr int CW_BAR = 4096;
constexpr size_t CTL_ZERO_BYTES = 65536;

enum { I_XP = 0, I_XS, I_CP, I_CS, I_SA, I_KV0, I_KV1, I_KV2, I_SC, I_RB, I_ADAW, I_ADAB, I_NMG, I_NFG, I_WGU, I_WDN, I_FNG, I_EWIN, I_ACW, I_ACB,
       I_ALG, I_ALB, I_EWOUT, I_OWIN, I_CCW, I_CCB, I_DLG, I_DLB, I_DSW, I_DSB, I_OWOUT, N_IN };
constexpr size_t O_YP = 0, O_YS = O_YP + (size_t)TP * D, O_AP = O_YS + (size_t)TS * D, O_AS = O_AP + (size_t)BATCH * 30 * 256,
    O_KV0P = O_AS + (size_t)DEC_BATCH * 30 * 256, O_KV0S = O_KV0P + (size_t)BATCH * 128 * 512, O_KV1P = O_KV0S + (size_t)DEC_BATCH * 128 * 512,
    O_KV1S = O_KV1P + (size_t)BATCH * 512 * 512, O_KV2P = O_KV1S + (size_t)DEC_BATCH * 512 * 512, O_KV2S = O_KV2P + (size_t)BATCH * 2048 * 512,
    O_CP = O_KV2S + (size_t)DEC_BATCH * 2048 * 512, O_CS = O_CP + (size_t)BATCH * 2 * 512, O_DV = O_CS + (size_t)DEC_BATCH * 2 * 512,
    O_END = O_DV + (size_t)DEC_BATCH * 4 * 512;
static_assert(O_END == 72372224, "output size");
constexpr size_t al256(size_t x) { return (x + 255) & ~(size_t)255; }
constexpr size_t WS_CTL = 0, WS_CTL_BYTES = 1u << 20;
constexpr size_t WS_WEIN = WS_CTL + WS_CTL_BYTES;
constexpr size_t WS_WEOUT = WS_WEIN + (size_t)E_IN * D * 2;
constexpr size_t WS_WGU0 = WS_WEOUT + (size_t)D * 512 * 2;
constexpr size_t WS_WGU1 = WS_WGU0 + (size_t)2 * FFN * D * 2;
constexpr size_t WS_WDN0 = WS_WGU1 + (size_t)2 * FFN * D * 2;
constexpr size_t WS_WDN1 = WS_WDN0 + (size_t)D * FFN * 2;
constexpr size_t WS_WOIN = WS_WDN1 + (size_t)D * FFN * 2;
constexpr size_t WS_WOOUT = WS_WOIN + (size_t)O_IN * D * 2;
constexpr size_t WS_MOD = WS_WOOUT + (size_t)D * D * 2;
constexpr size_t WS_X = al256(WS_MOD + (size_t)2 * NB * MODW * 4);
constexpr size_t WS_H = WS_X + (size_t)MP * D * 4;
constexpr size_t WS_PROJ = WS_H + (size_t)MP * D * 2;
constexpr size_t WS_MIX = WS_PROJ + (size_t)MP * E_IN * 2;
constexpr size_t WS_ACT = WS_MIX + (size_t)MP * D * 2;
constexpr size_t WS_OG = WS_ACT + (size_t)MP * FFN * 2;
constexpr size_t WS_LSE = WS_OG + (size_t)3 * MR * 256 * 4;
constexpr size_t WS_WSB = al256(WS_LSE + (size_t)3 * MR * 4 * 4);
constexpr size_t WS_END = al256(WS_WSB + (size_t)4 * 128 * 128 * 2);

struct Params { const float* in[N_IN]; float* out; unsigned char* ws; int ph_lo, ph_hi; };
static_assert(sizeof(Params) == 8 * N_IN + 8 + 8 + 8, "Params has no padding");

__device__ const unsigned char BUCKET[3][132] = {
 {0,1,2,3,4,5,6,7,8,9,10,11,12,13,14,15,16,16,16,16,16,16,17,17,17,17,17,17,17,17,18,18,18,18,18,18,18,18,18,18,19,19,19,19,19,19,19,19,19,19,19,19,19,19,20,20,20,20,20,20,20,20,20,20,20,20,20,20,20,20,20,20,20,21,21,21,21,21,21,21,21,21,21,21,21,21,21,21,21,21,21,21,21,21,21,21,21,21,21,22,22,22,22,22,22,22,22,22,22,22,22,22,22,22,22,22,22,22,22,22,22,22,22,22,22,22,22,22,22,0,0,0},
 {0,4,8,12,16,16,17,17,18,18,19,19,19,19,20,20,20,20,20,21,21,21,21,21,21,22,22,22,22,22,22,22,22,22,23,23,23,23,23,23,23,23,23,23,23,23,24,24,24,24,24,24,24,24,24,24,24,24,24,24,24,24,25,25,25,25,25,25,25,25,25,25,25,25,25,25,25,25,25,25,25,25,25,26,26,26,26,26,26,26,26,26,26,26,26,26,26,26,26,26,26,26,26,26,26,26,26,26,26,26,26,26,26,27,27,27,27,27,27,27,27,27,27,27,27,27,27,27,27,0,0,0},
 {0,16,18,19,20,21,21,22,22,23,23,23,24,24,24,24,25,25,25,25,25,26,26,26,26,26,26,26,26,27,27,27,27,27,27,27,27,27,27,28,28,28,28,28,28,28,28,28,28,28,28,28,29,29,29,29,29,29,29,29,29,29,29,29,29,29,29,29,29,29,30,30,30,30,30,30,30,30,30,30,30,30,30,30,30,30,30,30,30,30,30,30,30,30,30,31,31,31,31,31,31,31,31,31,31,31,31,31,31,31,31,31,31,31,31,31,31,31,31,31,31,31,31,31,31,31,31,31,31,0,0,0}};

__device__ __forceinline__ float bf2f(unsigned b) { return __uint_as_float(b << 16); }
__device__ __forceinline__ unsigned f2bf(float f) { unsigned u = __float_as_uint(f); return (u + 0x7fffu + ((u >> 16) & 1u)) >> 16; }
__device__ __forceinline__ unsigned pk2(float lo, float hi) { return f2bf(lo) | (f2bf(hi) << 16); }
__device__ __forceinline__ float wave_sum(float v) {
#pragma unroll
    for (int o = 1; o < 64; o <<= 1) v += __shfl_xor(v, o);
    return v;
}
__device__ __forceinline__ float wave_max(float v) {
#pragma unroll
    for (int o = 1; o < 64; o <<= 1) v = fmaxf(v, __shfl_xor(v, o));
    return v;
}
__device__ __forceinline__ void unpack8(const u32x4 w, float (&f)[8]) {
    f[0] = bf2f(w.x & 0xffffu); f[1] = bf2f(w.x >> 16); f[2] = bf2f(w.y & 0xffffu); f[3] = bf2f(w.y >> 16);
    f[4] = bf2f(w.z & 0xffffu); f[5] = bf2f(w.z >> 16); f[6] = bf2f(w.w & 0xffffu); f[7] = bf2f(w.w >> 16);
}
__device__ __forceinline__ int batch_of(int row) { return row < TP ? (row >> 11) : BATCH + ((row - TP) >> 2); }
#define LDS_WAIT() asm volatile("s_waitcnt lgkmcnt(0)" ::: "memory")

__device__ __forceinline__ void transpose_item(const float* W, int K, int N, bf16* WT, bool ilv, LAS float* scr, int item, int lane) {
    const int nblk = N / 32, kb = item / nblk, nb = item % nblk, k0 = 64 * kb, n0 = 32 * nb;
    float tv[32];
#pragma unroll
    for (int i = 0; i < 32; ++i) tv[i] = W[(size_t)(k0 + 2 * i + (lane >> 5)) * N + n0 + (lane & 31)];
#pragma unroll
    for (int i = 0; i < 32; ++i) scr[(2 * i + (lane >> 5)) * 33 + (lane & 31)] = tv[i];
    LDS_WAIT();
    const int c = lane & 7;
#pragma unroll
    for (int j = 0; j < 4; ++j) { const int n = (lane >> 3) + 8 * j; const LAS float* s = scr + (8 * c) * 33 + n;
        u32x4 o; o.x = pk2(s[0 * 33], s[1 * 33]); o.y = pk2(s[2 * 33], s[3 * 33]); o.z = pk2(s[4 * 33], s[5 * 33]); o.w = pk2(s[6 * 33], s[7 * 33]);
        const int col = n0 + n; const int orow = ilv ? (col < FFN ? 2 * col : 2 * (col - FFN) + 1) : col;
        *(u32x4*)(WT + (size_t)orow * K + k0 + 8 * c) = o; }
    LDS_WAIT();
}

__device__ __forceinline__ void adaln_item(const Params& p, LAS unsigned char* lds, int it) {
    int tid = threadIdx.x; asm volatile("" : "+v"(tid));
    const int lane = tid & 63, wave = tid >> 6;
    const int l = it / 96, j0 = (it % 96) * 64;
    LAS float* s = (LAS float*)lds;
    const float* cp = p.in[I_CP]; const float* cs = p.in[I_CS];
    float* mod = (float*)(p.ws + WS_MOD);
    float acc[NB];
#pragma unroll
    for (int n = 0; n < NB; ++n) acc[n] = 0.f;
    for (int kh = 0; kh < 2; ++kh) {
        __syncthreads();
        for (int idx = tid; idx < NB * 512; idx += NTHR) { const int n = idx >> 9, k = idx & 511;
            const float c = n < BATCH ? cp[n * D + kh * 512 + k] : cs[(n - BATCH) * D + kh * 512 + k];
            s[idx] = c / (1.0f + expf(-c)); }
        __syncthreads();
        const float* wp = p.in[I_ADAW] + ((size_t)l * D + kh * 512 + wave * 64) * MODW + j0 + lane;
#pragma unroll 1
        for (int kb = 0; kb < 4; ++kb) {
            float wv[16];
#pragma unroll
            for (int q = 0; q < 16; ++q) wv[q] = wp[(size_t)(16 * kb + q) * MODW];
#pragma unroll
            for (int n = 0; n < NB; ++n) {
#pragma unroll
                for (int q4 = 0; q4 < 4; ++q4) { const f32x4 sv = *(const LAS f32x4*)(s + n * 512 + wave * 64 + 16 * kb + 4 * q4);
                    acc[n] += (sv.x * wv[4 * q4] + sv.y * wv[4 * q4 + 1]) + (sv.z * wv[4 * q4 + 2] + sv.w * wv[4 * q4 + 3]); } }
        }
    }
    __syncthreads();
    LAS float* red = (LAS float*)lds;
#pragma unroll
    for (int n = 0; n < NB; ++n) red[(wave * NB + n) * 64 + lane] = acc[n];
    __syncthreads();
    for (int idx = tid; idx < NB * 64; idx += NTHR) { const int n = idx >> 6, j = idx & 63; float t = 0.f;
#pragma unroll
        for (int w = 0; w < NWAVES; ++w) t += red[(w * NB + n) * 64 + j];
        mod[((size_t)l * NB + n) * MODW + j0 + j] = t + p.in[I_ADAB][l * MODW + j0 + j]; }
    __syncthreads();
}

__device__ __forceinline__ void phase0(const Params& p, LAS unsigned char* lds) {
    const int tid = threadIdx.x, lane = tid & 63, wave = tid >> 6;
    for (int it = blockIdx.x; it < 192; it += gridDim.x) adaln_item(p, lds, it);
    __syncthreads();
    {
        LAS float* scr = (LAS float*)(lds + wave * 16384);
        const int gw = blockIdx.x * NWAVES + wave, NGW = gridDim.x * NWAVES;
        constexpr int I0 = (D / 64) * (E_IN / 32), I1 = (512 / 64) * (D / 32), I2 = (D / 64) * (2 * FFN / 32), I3 = (FFN / 64) * (D / 32), I4 = (D / 64) * (O_IN / 32), I5 = (D / 64) * (D / 32);
        constexpr int NIT = I0 + I1 + 2 * I2 + 2 * I3 + I4 + I5;
        for (int it = gw; it < NIT; it += NGW) {
            int r = it;
            if (r < I0) { transpose_item(p.in[I_EWIN], D, E_IN, (bf16*)(p.ws + WS_WEIN), false, scr, r, lane); continue; } r -= I0;
            if (r < I1) { transpose_item(p.in[I_EWOUT], 512, D, (bf16*)(p.ws + WS_WEOUT), false, scr, r, lane); continue; } r -= I1;
            if (r < I2) { transpose_item(p.in[I_WGU], D, 2 * FFN, (bf16*)(p.ws + WS_WGU0), true, scr, r, lane); continue; } r -= I2;
            if (r < I2) { transpose_item(p.in[I_WGU] + (size_t)D * 2 * FFN, D, 2 * FFN, (bf16*)(p.ws + WS_WGU1), true, scr, r, lane); continue; } r -= I2;
            if (r < I3) { transpose_item(p.in[I_WDN], FFN, D, (bf16*)(p.ws + WS_WDN0), false, scr, r, lane); continue; } r -= I3;
            if (r < I3) { transpose_item(p.in[I_WDN] + (size_t)FFN * D, FFN, D, (bf16*)(p.ws + WS_WDN1), false, scr, r, lane); continue; } r -= I3;
            if (r < I4) { transpose_item(p.in[I_OWIN], D, O_IN, (bf16*)(p.ws + WS_WOIN), false, scr, r, lane); continue; } r -= I4;
            transpose_item(p.in[I_OWOUT], D, D, (bf16*)(p.ws + WS_WOOUT), false, scr, r, lane);
        }
    }
    {
        float* Xs = (float*)(p.ws + WS_X) + (size_t)TP * D;
        for (int idx = blockIdx.x * NTHR + tid; idx < TS * D / 4; idx += gridDim.x * NTHR) ((f32x4*)Xs)[idx] = ((const f32x4*)p.in[I_XS])[idx];
    }
    {
        bf16* wsb = (bf16*)(p.ws + WS_WSB);
        for (int idx = blockIdx.x * NTHR + tid; idx < 4 * 128 * 128; idx += gridDim.x * NTHR) { const int ii = (idx >> 7) & 127, jj = idx & 127;
            wsb[idx] = (bf16)(jj <= ii ? f2bf(p.in[I_DSW][idx]) : 0u); }
    }
    {
        const size_t gt = (size_t)blockIdx.x * NTHR + tid, NGT = (size_t)gridDim.x * NTHR;
#pragma unroll
        for (int g = 0; g < 3; ++g) {
            const int Wb = 128 << (2 * g);
            const f32x4* src = (const f32x4*)p.in[I_KV0 + g];
            f32x4* dst = (f32x4*)(p.out + (g == 0 ? O_KV0S : g == 1 ? O_KV1S : O_KV2S));
            const unsigned cnt = (unsigned)(Wb - 4) * 128u, total = (unsigned)DEC_BATCH * cnt;
            for (unsigned i0 = (unsigned)gt; i0 < total; i0 += 8u * (unsigned)NGT) {
                f32x4 v[8]; unsigned di[8];
#pragma unroll
                for (int u = 0; u < 8; ++u) { const unsigned i = i0 + u * (unsigned)NGT; const unsigned ic = i < total ? i : total - 1u; const unsigned n = ic / cnt;
                    di[u] = ic + n * 512u; v[u] = __builtin_nontemporal_load(src + di[u] + 512u); }
#pragma unroll
                for (int u = 0; u < 8; ++u) if (i0 + u * (unsigned)NGT < total) __builtin_nontemporal_store(v[u], dst + di[u]);
            }
        }
    }
}

template <bool FINAL>
__device__ __forceinline__ void norm_phase(const float* xp, const float* xs, const float* g, const float* shift, const float* scale, bf16* H, float* outp, float* outs) {
    const int tid = threadIdx.x, lane = tid & 63, wave = tid >> 6;
    const int gw = blockIdx.x * NWAVES + wave, NGW = gridDim.x * NWAVES;
    constexpr int NR = FINAL ? MR : MP;
    f32x4 gv[4];
#pragma unroll
    for (int j = 0; j < 4; ++j) gv[j] = ((const f32x4*)g)[lane + 64 * j];
    for (int row0 = gw; row0 < NR; row0 += 2 * NGW) {
        f32x4 v[2][4], sh[2][4], sc[2][4]; int rows[2]; bool real[2];
#pragma unroll
        for (int u = 0; u < 2; ++u) { const int row = row0 + u * NGW; rows[u] = row; real[u] = row < MR;
            const int rc = real[u] ? row : MR - 1;
            const float* xr = rc < TP ? xp + (size_t)rc * D : xs + (size_t)(rc - TP) * D;
#pragma unroll
            for (int j = 0; j < 4; ++j) v[u][j] = ((const f32x4*)xr)[lane + 64 * j];
            if (!FINAL) { const int nb = batch_of(rc);
#pragma unroll
                for (int j = 0; j < 4; ++j) { sh[u][j] = ((const f32x4*)(shift + (size_t)nb * MODW))[lane + 64 * j]; sc[u][j] = ((const f32x4*)(scale + (size_t)nb * MODW))[lane + 64 * j]; } } }
#pragma unroll
        for (int u = 0; u < 2; ++u) { const int row = rows[u];
            if (row >= NR) continue;
            float ss = 0.f;
#pragma unroll
            for (int j = 0; j < 4; ++j) ss += (v[u][j].x * v[u][j].x + v[u][j].y * v[u][j].y) + (v[u][j].z * v[u][j].z + v[u][j].w * v[u][j].w);
            const float rstd = 1.0f / sqrtf(wave_sum(ss) * (1.0f / D) + EPS);
            if (FINAL) {
                float* o = row < TP ? outp + (size_t)row * D : outs + (size_t)(row - TP) * D;
#pragma unroll
                for (int j = 0; j < 4; ++j) ((f32x4*)o)[lane + 64 * j] = v[u][j] * rstd * gv[j];
            } else {
#pragma unroll
                for (int j = 0; j < 4; ++j) { f32x4 y = v[u][j] * rstd * gv[j] * (sc[u][j] + 1.0f) + sh[u][j];
                    if (!real[u]) y = (f32x4){0.f, 0.f, 0.f, 0.f};
                    *(u32x2*)(H + (size_t)row * D + 4 * lane + 256 * j) = (u32x2){pk2(y.x, y.y), pk2(y.z, y.w)}; }
            }
        }
    }
}

#ifndef DBG_P3DUP
#define DBG_P3DUP 0
#endif
constexpr int QCOL = 512, KCOL = 1280, VCOL = 2048;
constexpr int VT_PITCH = 264;
constexpr int K_PITCH = 72;
constexpr int P_PITCH = 168;
constexpr int AT_PW = 16 * P_PITCH * 2;
constexpr int AT_K = 0, AT_P = 0, AT_VT = 43008, AT_BIAS = AT_VT + 64 * VT_PITCH * 2;
static_assert(256 * K_PITCH * 2 <= AT_VT && NWAVES * AT_PW <= AT_VT && AT_BIAS + 132 * 4 <= 131072, "attention LDS");

__device__ __forceinline__ void attn_unit(const Params& p, LAS unsigned char* lds, int u) {
    int tid = threadIdx.x; asm volatile("" : "+v"(tid));
    const int lane = tid & 63, wave = tid >> 6, fr = lane & 15, fq = lane >> 4;
    const int b = u / 192, v_ = u % 192, g = v_ / 64, w_ = v_ % 64, h = w_ / 16, x_ = w_ % 16;
    const int dl = 2 * g, d = 1 << dl, nblk = 16 >> dl, r = x_ / nblk, i = x_ % nblk;
    const bf16* PROJ = (const bf16*)(p.ws + WS_PROJ);
    LAS bf16* Vt = (LAS bf16*)(lds + AT_VT);
    LAS bf16* Kl = (LAS bf16*)(lds + AT_K);
    LAS bf16* Pw = (LAS bf16*)(lds + AT_P + wave * AT_PW);
    LAS float* biasl = (LAS float*)(lds + AT_BIAS);
    const size_t rowbase = (size_t)b * SEQ;
    u32x4 wv[4], wk[4]; bf16x8 qa[2];
    const int kl = tid & 255, half = tid >> 8;
    {
        const int mk = 128 * (i - 1) + kl; const int mkc = mk < 0 ? 0 : mk;
        const bf16* rp = PROJ + (rowbase + (size_t)mkc * d + r) * E_IN + g * 256 + h * 64 + 32 * half;
#pragma unroll
        for (int c = 0; c < 4; ++c) { wv[c] = *(const u32x4*)(rp + VCOL + 8 * c); wk[c] = *(const u32x4*)(rp + KCOL + 8 * c); }
        const int mq = 128 * i + 16 * wave + fr;
        const bf16* qp = PROJ + (rowbase + (size_t)mq * d + r) * E_IN + QCOL + g * 256 + h * 64 + 8 * fq;
        qa[0] = *(const bf16x8*)qp; qa[1] = *(const bf16x8*)(qp + 32);
    }
    if (tid < 129) biasl[tid] = p.in[I_RB][BUCKET[g][tid] * 12 + g * 4 + h];
#pragma unroll
    for (int c = 0; c < 4; ++c) {
        *(LAS u32x4*)(Kl + kl * K_PITCH + 32 * half + 8 * c) = wk[c];
        const unsigned ww[4] = {wv[c].x, wv[c].y, wv[c].z, wv[c].w};
#pragma unroll
        for (int e = 0; e < 4; ++e) { const int dd = 32 * half + 8 * c + 2 * e;
            Vt[dd * VT_PITCH + kl] = (bf16)(ww[e] & 0xffffu); Vt[(dd + 1) * VT_PITCH + kl] = (bf16)(ww[e] >> 16); } }
    __syncthreads();
    const int kt0 = 2 * (wave >> 1);
    f32x4 sacc[10];
#pragma unroll
    for (int t = 0; t < 10; ++t) {
        const LAS bf16* kp = Kl + (16 * (kt0 + t) + fr) * K_PITCH + 8 * fq;
        const bf16x8 k0 = *(const LAS bf16x8*)kp, k1 = *(const LAS bf16x8*)(kp + 32);
        sacc[t] = __builtin_amdgcn_mfma_f32_16x16x32_bf16(qa[0], k0, (f32x4){0.f, 0.f, 0.f, 0.f}, 0, 0, 0);
        sacc[t] = __builtin_amdgcn_mfma_f32_16x16x32_bf16(qa[1], k1, sacc[t], 0, 0, 0);
    }
    float mx[4] = {-INFINITY, -INFINITY, -INFINITY, -INFINITY};
#pragma unroll
    for (int t = 0; t < 10; ++t) {
        const bool tile_ok = (i > 0) || (kt0 + t >= 8);
#pragma unroll
        for (int rg = 0; rg < 4; ++rg) {
            const int rel = 16 * (wave & 1) + 4 * fq + rg + 128 - 16 * t - fr;
            const bool ok = tile_ok && rel >= 0 && rel <= 128;
            const float sv = ok ? sacc[t][rg] * 0.125f + biasl[ok ? rel : 0] : -INFINITY;
            sacc[t][rg] = sv; mx[rg] = fmaxf(mx[rg], sv);
        }
    }
#pragma unroll
    for (int rg = 0; rg < 4; ++rg) {
#pragma unroll
        for (int o = 1; o < 16; o <<= 1) mx[rg] = fmaxf(mx[rg], __shfl_xor(mx[rg], o));
    }
    __syncthreads();
    float ls[4] = {0.f, 0.f, 0.f, 0.f};
#pragma unroll
    for (int t = 0; t < 10; ++t) {
#pragma unroll
        for (int rg = 0; rg < 4; ++rg) {
            const float e = __builtin_amdgcn_exp2f((sacc[t][rg] - mx[rg]) * 1.4426950408889634f);
            ls[rg] += e;
            Pw[(4 * fq + rg) * P_PITCH + 16 * t + fr] = (bf16)f2bf(e);
        }
    }
#pragma unroll
    for (int rg = 0; rg < 4; ++rg) {
#pragma unroll
        for (int o = 1; o < 16; o <<= 1) ls[rg] += __shfl_xor(ls[rg], o);
    }
    __syncthreads();
    f32x4 oacc[4];
#pragma unroll
    for (int nd = 0; nd < 4; ++nd) oacc[nd] = (f32x4){0.f, 0.f, 0.f, 0.f};
#pragma unroll
    for (int ks = 0; ks < 5; ++ks) {
        const bf16x8 pa = *(const LAS bf16x8*)(Pw + fr * P_PITCH + 32 * ks + 8 * fq);
#pragma unroll
        for (int nd = 0; nd < 4; ++nd) {
            const bf16x8 vb = *(const LAS bf16x8*)(Vt + (16 * nd + fr) * VT_PITCH + 16 * kt0 + 32 * ks + 8 * fq);
            oacc[nd] = __builtin_amdgcn_mfma_f32_16x16x32_bf16(pa, vb, oacc[nd], 0, 0, 0);
        }
    }
    float* OG = (float*)(p.ws + WS_OG) + (size_t)g * MR * 256;
    float* LSE = (float*)(p.ws + WS_LSE) + (size_t)g * MR * 4;
#pragma unroll
    for (int rg = 0; rg < 4; ++rg) {
        const int mq = 128 * i + 16 * wave + 4 * fq + rg; const size_t row = rowbase + (size_t)mq * d + r;
        const float inv = 1.0f / ls[rg];
#pragma unroll
        for (int nd = 0; nd < 4; ++nd) OG[row * 256 + h * 64 + 16 * nd + fr] = oacc[nd][rg] * inv;
        if (fr == 0) LSE[row * 4 + h] = mx[rg] + logf(ls[rg]);
    }
    __syncthreads();
}

constexpr int CA_GLU = 0, CA_Y = 62 * 256 * 4;
__device__ __forceinline__ void conva_item(const Params& p, LAS unsigned char* lds, bool sample, int bn, int t0) {
    int tid = threadIdx.x; asm volatile("" : "+v"(tid));
    const int lane = tid & 63, wave = tid >> 6;
    const bf16* PROJ = (const bf16*)(p.ws + WS_PROJ);
    bf16* MIX = (bf16*)(p.ws + WS_MIX);
    LAS float* glu = (LAS float*)(lds + CA_GLU); LAS float* ys = (LAS float*)(lds + CA_Y);
    const int c = tid & 255, th = tid >> 8;
    const int RR = sample ? 34 : 62, NT = sample ? 4 : 32;
    {
        u32x4 ra[4], rg[4]; f32x4 s0[4], s1[4];
#pragma unroll
        for (int q = 0; q < 4; ++q) { const int v = tid + q * NTHR; const int rr = v >> 5, cv = (v & 31) * 8;
            ra[q] = (u32x4){0u, 0u, 0u, 0u}; rg[q] = ra[q]; s0[q] = (f32x4){0.f, 0.f, 0.f, 0.f}; s1[q] = s0[q];
            if (rr < RR) {
                if (sample && rr < 30) { const float* sp = p.in[I_SA] + ((size_t)bn * 30 + rr) * 256 + cv; s0[q] = *(const f32x4*)sp; s1[q] = *(const f32x4*)(sp + 4); }
                else { const int t = sample ? rr - 30 : t0 - 30 + rr; const int tc = t < 0 ? 0 : t;
                    const bf16* pr = PROJ + (sample ? (size_t)(TP + 4 * bn + tc) : (size_t)bn * SEQ + tc) * E_IN + cv;
                    ra[q] = *(const u32x4*)pr; rg[q] = *(const u32x4*)(pr + 256); } } }
#pragma unroll
        for (int q = 0; q < 4; ++q) { const int v = tid + q * NTHR; const int rr = v >> 5, cv = (v & 31) * 8;
            if (rr < RR) {
                f32x4 o0 = s0[q], o1 = s1[q];
                if (!(sample && rr < 30)) { const int t = sample ? rr - 30 : t0 - 30 + rr;
                    float a[8], gt[8]; unpack8(ra[q], a); unpack8(rg[q], gt);
                    float y[8];
#pragma unroll
                    for (int e = 0; e < 8; ++e) y[e] = t < 0 ? 0.f : a[e] / (1.0f + expf(-gt[e]));
                    o0 = (f32x4){y[0], y[1], y[2], y[3]}; o1 = (f32x4){y[4], y[5], y[6], y[7]}; }
                *(LAS f32x4*)(glu + rr * 256 + cv) = o0; *(LAS f32x4*)(glu + rr * 256 + cv + 4) = o1; } }
    }
    __syncthreads();
    if (sample) { float* o = p.out + O_AS + (size_t)bn * 30 * 256; for (int j = th; j < 30; j += 2) o[j * 256 + c] = glu[(j + 4) * 256 + c]; }
    else if (t0 == SEQ - 32) { float* o = p.out + O_AP + (size_t)bn * 30 * 256; for (int j = th; j < 30; j += 2) o[j * 256 + c] = glu[(j + 32) * 256 + c]; }
    {
        float win[46];
#pragma unroll
        for (int q = 0; q < 46; ++q) { const int rr = 16 * th + q; win[q] = rr < RR ? glu[rr * 256 + c] : 0.f; }
        float y[16]; const float bb = p.in[I_ACB][c];
#pragma unroll
        for (int q = 0; q < 16; ++q) y[q] = bb;
#pragma unroll
        for (int k = 0; k < 31; ++k) { const float wk = p.in[I_ACW][k * 256 + c];
#pragma unroll
            for (int q = 0; q < 16; ++q) y[q] += wk * win[q + k]; }
#pragma unroll
        for (int q = 0; q < 16; ++q) ys[(16 * th + q) * 256 + c] = y[q];
    }
    __syncthreads();
    const f32x4 lg = ((const f32x4*)p.in[I_ALG])[lane], lb = ((const f32x4*)p.in[I_ALB])[lane];
#pragma unroll
    for (int q = 0; q < 4; ++q) { const int tl = 4 * wave + q;
        if (tl < NT) {
            const f32x4 v = *(const LAS f32x4*)(ys + tl * 256 + 4 * lane);
            const float mu = wave_sum((v.x + v.y) + (v.z + v.w)) * (1.0f / 256.0f);
            const f32x4 dv = v - mu;
            const float var = wave_sum((dv.x * dv.x + dv.y * dv.y) + (dv.z * dv.z + dv.w * dv.w)) * (1.0f / 256.0f);
            const float rstd = 1.0f / sqrtf(var + EPS);
            f32x4 y = dv * rstd * lg + lb;
            y.x = y.x / (1.0f + expf(-y.x)); y.y = y.y / (1.0f + expf(-y.y)); y.z = y.z / (1.0f + expf(-y.z)); y.w = y.w / (1.0f + expf(-y.w));
            const size_t row = sample ? (size_t)(TP + 4 * bn + tl) : (size_t)bn * SEQ + t0 + tl;
            *(u32x2*)(MIX + row * 512 + 4 * lane) = (u32x2){pk2(y.x, y.y), pk2(y.z, y.w)};
        } }
    __syncthreads();
}

constexpr int SA_NEW = 0, SA_Q = 4 * 2 * 256 * 4, SA_P = SA_Q + 4 * 256 * 4;
__device__ __forceinline__ void sattn_item(const Params& p, LAS unsigned char* lds, int n, int g) {
    int tid = threadIdx.x; asm volatile("" : "+v"(tid));
    const int lane = tid & 63, wave = tid >> 6;
    const bf16* PROJ = (const bf16*)(p.ws + WS_PROJ);
    const int dl = 2 * g, d = 1 << dl, Wb = 128 << dl;
    const float* cache = p.in[I_KV0 + g] + (size_t)n * Wb * 512;
    float* kvout = p.out + (g == 0 ? O_KV0S : g == 1 ? O_KV1S : O_KV2S) + (size_t)n * Wb * 512;
    LAS float* newkv = (LAS float*)(lds + SA_NEW); LAS float* qs = (LAS float*)(lds + SA_Q); LAS float* pw = (LAS float*)(lds + SA_P) + wave * 192;
    for (int idx = tid; idx < 4 * 3 * 256; idx += NTHR) { const int s = idx / 768, rem = idx % 768, which = rem >> 8, col = rem & 255;
        const float v = bf2f(PROJ[(size_t)(TP + 4 * n + s) * E_IN + QCOL + (which * 3 + g) * 256 + col]);
        if (which == 0) qs[s * 256 + col] = v;
        else { newkv[(s * 2 + which - 1) * 256 + col] = v; kvout[((size_t)(Wb - 4 + s) * 2 + which - 1) * 256 + col] = v; } }
    __syncthreads();
    float* OG = (float*)(p.ws + WS_OG) + (size_t)g * MR * 256;
    float* LSE = (float*)(p.ws + WS_LSE) + (size_t)g * MR * 4;
    for (int pr = 2 * wave; pr < 2 * wave + 2; ++pr) {
        const int s = pr >> 2, h = pr & 3, jn = s >> dl;
        const LAS float* qp = qs + s * 256 + h * 64;
        float sc[3];
#pragma unroll
        for (int rd = 0; rd < 3; ++rd) {
            const int j = rd * 64 + lane, jc = j < 128 ? j : 128; int idx = Wb + s - jc * d; idx = idx < Wb ? idx : Wb - 1;
            const float* kp = cache + ((size_t)idx * 2 + 0) * 256 + h * 64;
            float dot = 0.f;
#pragma unroll
            for (int e = 0; e < 16; ++e) { const f32x4 kv = *(const f32x4*)(kp + 4 * e), qv = *(const LAS f32x4*)(qp + 4 * e); dot += (kv.x * qv.x + kv.y * qv.y) + (kv.z * qv.z + kv.w * qv.w); }
            sc[rd] = dot;
        }
        if (lane <= jn) {
            const LAS float* kp = newkv + ((s - lane * d) * 2 + 0) * 256 + h * 64; float dot = 0.f;
#pragma unroll
            for (int e = 0; e < 16; ++e) { const f32x4 kv = *(const LAS f32x4*)(kp + 4 * e), qv = *(const LAS f32x4*)(qp + 4 * e); dot += (kv.x * qv.x + kv.y * qv.y) + (kv.z * qv.z + kv.w * qv.w); }
            sc[0] = dot;
        }
#pragma unroll
        for (int rd = 0; rd < 3; ++rd) { const int j = rd * 64 + lane; sc[rd] = j <= 128 ? sc[rd] * 0.125f + p.in[I_RB][BUCKET[g][j < 128 ? j : 128] * 12 + g * 4 + h] : -INFINITY; }
        const float m = wave_max(fmaxf(fmaxf(sc[0], sc[1]), sc[2]));
        float e3[3]; float l = 0.f;
#pragma unroll
        for (int rd = 0; rd < 3; ++rd) { e3[rd] = expf(sc[rd] - m); l += e3[rd]; }
        l = wave_sum(l);
        const float inv = 1.0f / l;
#pragma unroll
        for (int rd = 0; rd < 3; ++rd) pw[rd * 64 + lane] = e3[rd] * inv;
        LDS_WAIT();
        const int kq = lane >> 4, d4 = 4 * (lane & 15);
        f32x4 o = (f32x4){0.f, 0.f, 0.f, 0.f};
#pragma unroll 8
        for (int it = 0; it < 32; ++it) {
            const int j = jn + 1 + kq + 4 * it, jc = j < 128 ? j : 128;
            const float pj = j <= 128 ? pw[jc] : 0.f;
            const f32x4 vv = *(const f32x4*)(cache + ((size_t)(Wb + s - jc * d) * 2 + 1) * 256 + h * 64 + d4);
            o += vv * pj;
        }
        if (kq == 0) for (int j = 0; j <= jn; ++j) o += *(const LAS f32x4*)(newkv + ((s - j * d) * 2 + 1) * 256 + h * 64 + d4) * pw[j];
#pragma unroll
        for (int c = 0; c < 4; ++c) { o[c] += __shfl_xor(o[c], 16); o[c] += __shfl_xor(o[c], 32); }
        const size_t row = (size_t)(TP + 4 * n + s);
        if (lane < 16) *(f32x4*)(OG + row * 256 + h * 64 + d4) = o;
        if (lane == 0) LSE[row * 4 + h] = m + logf(l);
        LDS_WAIT();
    }
    __syncthreads();
}

__device__ __forceinline__ void phase3(const Params& p, LAS unsigned char* lds) {
    constexpr int N_ATT = BATCH * 192, N_CA = TP / 32, N_SA = DEC_BATCH * 3, N_CS = DEC_BATCH;
    for (int it = blockIdx.x; it < N_ATT + N_CA + N_SA + N_CS; it += gridDim.x) {
        int r = it;
        if (r < N_SA) { for (int q_ = 0; q_ <= (DBG_P3DUP & 1); ++q_) sattn_item(p, lds, r / 3, r % 3); continue; } r -= N_SA;
        if (r < N_ATT) { for (int q_ = 0; q_ <= ((DBG_P3DUP >> 1) & 1); ++q_) attn_unit(p, lds, r); continue; } r -= N_ATT;
        if (r < N_CA) { for (int q_ = 0; q_ <= ((DBG_P3DUP >> 2) & 1); ++q_) conva_item(p, lds, false, r / 64, (r % 64) * 32); continue; } r -= N_CA;
        conva_item(p, lds, true, r, 0);
    }
    const bf16* PROJ = (const bf16*)(p.ws + WS_PROJ);
    const size_t gt = (size_t)blockIdx.x * NTHR + threadIdx.x, NGT = (size_t)gridDim.x * NTHR;
#pragma unroll
    for (int g = 0; g < 3; ++g) {
        const int W = 128 << (2 * g);
        float* o = p.out + (g == 0 ? O_KV0P : g == 1 ? O_KV1P : O_KV2P);
        const size_t total = (size_t)BATCH * W * 64;
        for (size_t i0 = gt; i0 < total; i0 += 4 * NGT) {
            u32x4 w[4];
#pragma unroll
            for (int u = 0; u < 4; ++u) { const size_t i = i0 + u * NGT < total ? i0 + u * NGT : total - 1;
                const int vec = (int)(i & 31), which = (int)((i >> 5) & 1); const size_t bj = i >> 6; int j = (int)(bj % W), b = (int)(bj / W); asm volatile("" : "+v"(j), "+v"(b));
                w[u] = *(const u32x4*)(PROJ + ((size_t)b * SEQ + (SEQ - W + j)) * E_IN + QCOL + ((1 + which) * 3 + g) * 256 + 8 * vec); }
#pragma unroll
            for (int u = 0; u < 4; ++u) { const size_t i = i0 + u * NGT;
                if (i < total) { float f[8]; unpack8(w[u], f); float* op = o + i * 8;
                    __builtin_nontemporal_store((f32x4){f[0], f[1], f[2], f[3]}, (f32x4*)op); __builtin_nontemporal_store((f32x4){f[4], f[5], f[6], f[7]}, (f32x4*)(op + 4)); } }
        }
    }
}

__device__ __forceinline__ void phase4(const Params& p) {
    const int tid = threadIdx.x, lane = tid & 63, wave = tid >> 6;
    const int gw = blockIdx.x * NWAVES + wave, NGW = gridDim.x * NWAVES;
    const float* OG = (const float*)(p.ws + WS_OG); const float* LSE = (const float*)(p.ws + WS_LSE);
    bf16* MIX = (bf16*)(p.ws + WS_MIX);
    const int h = lane >> 4;
    for (int row0 = gw; row0 < MP; row0 += 2 * NGW) {
        float l0[2], l1[2], l2[2]; f32x4 o0[2], o1[2], o2[2];
#pragma unroll
        for (int u = 0; u < 2; ++u) { const int row = row0 + u * NGW; const size_t rc = row < MR ? row : MR - 1;
            l0[u] = LSE[rc * 4 + h]; l1[u] = LSE[((size_t)MR + rc) * 4 + h]; l2[u] = LSE[((size_t)2 * MR + rc) * 4 + h];
            o0[u] = *(const f32x4*)(OG + rc * 256 + 4 * lane); o1[u] = *(const f32x4*)(OG + ((size_t)MR + rc) * 256 + 4 * lane); o2[u] = *(const f32x4*)(OG + ((size_t)2 * MR + rc) * 256 + 4 * lane); }
#pragma unroll
        for (int u = 0; u < 2; ++u) { const int row = row0 + u * NGW;
            if (row >= MP) continue;
            if (row >= MR) { *(u32x4*)(MIX + (size_t)row * 512 + 8 * lane) = (u32x4){0u, 0u, 0u, 0u}; continue; }
            const float m = fmaxf(fmaxf(l0[u], l1[u]), l2[u]);
            const float e0 = expf(l0[u] - m), e1 = expf(l1[u] - m), e2 = expf(l2[u] - m), inv = 1.0f / (e0 + e1 + e2);
            const f32x4 a = (o0[u] * e0 + o1[u] * e1 + o2[u] * e2) * inv;
            *(u32x2*)(MIX + (size_t)row * 512 + 256 + 4 * lane) = (u32x2){pk2(a.x, a.y), pk2(a.z, a.w)}; }
    }
}

#ifndef DBG_DUP
#define DBG_DUP 0
#endif

__device__ __forceinline__ void mixc_rows(const Params& p) {
    const bf16* PJ = (const bf16*)(p.ws + WS_PROJ);
    bf16* MIX = (bf16*)(p.ws + WS_MIX);
    const size_t gt = (size_t)blockIdx.x * NTHR + threadIdx.x, NGT = (size_t)gridDim.x * NTHR;
    for (size_t i = gt; i < (size_t)MP * 64; i += NGT) {
        const int row = (int)(i >> 6), c0 = (int)(i & 63) * 8;
        if (row >= MR) { *(u32x4*)(MIX + (size_t)row * D + c0) = (u32x4){0u, 0u, 0u, 0u}; *(u32x4*)(MIX + (size_t)row * D + 512 + c0) = (u32x4){0u, 0u, 0u, 0u}; continue; }
        const bool smp = row >= TP; const int t = smp ? ((row - TP) & 3) : (row & 2047); const int n = smp ? ((row - TP) >> 2) : (row >> 11);
        float ci[3][8];
#pragma unroll
        for (int k = 0; k < 3; ++k) { const int tt = t - 2 + k;
            if (tt >= 0) { float a[8], b[8]; unpack8(*(const u32x4*)(PJ + (size_t)(row - 2 + k) * O_IN + 512 + c0), a); unpack8(*(const u32x4*)(PJ + (size_t)(row - 2 + k) * O_IN + 1024 + c0), b);
#pragma unroll
                for (int e = 0; e < 8; ++e) ci[k][e] = a[e] * b[e]; }
            else if (smp) { const float* sp = p.in[I_SC] + ((size_t)n * 2 + (tt + 2)) * 512 + c0;
#pragma unroll
                for (int e = 0; e < 8; ++e) ci[k][e] = sp[e]; }
            else {
#pragma unroll
                for (int e = 0; e < 8; ++e) ci[k][e] = 0.f; } }
        float bg[8]; unpack8(*(const u32x4*)(PJ + (size_t)row * O_IN + c0), bg);
        float y[8];
#pragma unroll
        for (int e = 0; e < 8; ++e) { const float* w = p.in[I_CCW] + c0 + e;
            y[e] = bg[e] * (w[0] * ci[0][e] + w[512] * ci[1][e] + w[1024] * ci[2][e] + p.in[I_CCB][c0 + e]); }
        *(u32x4*)(MIX + (size_t)row * D + c0) = (u32x4){pk2(y[0], y[1]), pk2(y[2], y[3]), pk2(y[4], y[5]), pk2(y[6], y[7])};
        float* so = nullptr;
        if (smp) { if (t >= 2) so = p.out + O_CS + ((size_t)n * 2 + (t - 2)) * 512 + c0; }
        else if (t >= SEQ - 2) so = p.out + O_CP + ((size_t)n * 2 + (t - (SEQ - 2))) * 512 + c0;
        if (so) { *(f32x4*)so = (f32x4){ci[2][0], ci[2][1], ci[2][2], ci[2][3]}; *(f32x4*)(so + 4) = (f32x4){ci[2][4], ci[2][5], ci[2][6], ci[2][7]}; }
    }
}

constexpr int MD_PITCH = 136;
constexpr int MD_VT = 0, MD_WS = 128 * MD_PITCH * 2, MD_ST = 2 * 128 * MD_PITCH * 2;
__device__ __forceinline__ void mixd_item(const Params& p, LAS unsigned char* lds, int b, int ck, int g) {
    int tid = threadIdx.x; asm volatile("" : "+v"(tid));
    const int lane = tid & 63, wave = tid >> 6, fr = lane & 15, fq = lane >> 4;
    const bf16* PJ = (const bf16*)(p.ws + WS_PROJ);
    bf16* MIX = (bf16*)(p.ws + WS_MIX);
    LAS bf16* vT = (LAS bf16*)(lds + MD_VT); LAS bf16* Wl = (LAS bf16*)(lds + MD_WS); LAS float* st = (LAS float*)(lds + MD_ST);
    const size_t row0 = (size_t)b * SEQ + (size_t)ck * 128;
    {
        const bf16* wsb = (const bf16*)(p.ws + WS_WSB) + (size_t)g * 128 * 128;
        u32x4 w[4];
#pragma unroll
        for (int q = 0; q < 4; ++q) { const int v = tid + q * NTHR; w[q] = *(const u32x4*)(wsb + (size_t)v * 8); }
        u32x4 raw[16];
#pragma unroll
        for (int q = 0; q < 16; ++q) raw[q] = *(const u32x4*)(PJ + (row0 + 16 * wave + q) * O_IN + 2048 + 8 * lane);
#pragma unroll
        for (int q = 0; q < 4; ++q) { const int v = tid + q * NTHR; *(LAS u32x4*)(Wl + (v >> 4) * MD_PITCH + (v & 15) * 8) = w[q]; }
#pragma unroll
        for (int q = 0; q < 16; ++q) {
            float f[8]; unpack8(raw[q], f);
            float s = 0.f;
#pragma unroll
            for (int e = 0; e < 8; ++e) s += f[e];
            const float mu = wave_sum(s) * (1.0f / 512.0f); float s2 = 0.f;
#pragma unroll
            for (int e = 0; e < 8; ++e) { const float dlt = f[e] - mu; s2 += dlt * dlt; }
            const float var = wave_sum(s2) * (1.0f / 512.0f);
            if (lane == 0) { st[2 * (16 * wave + q)] = mu; st[2 * (16 * wave + q) + 1] = 1.0f / sqrtf(var + EPS); } }
    }
    __syncthreads();
    {
        const int j = tid & 127, cq = tid >> 7; const float mu = st[2 * j], rs = st[2 * j + 1];
        u32x4 raw[4];
#pragma unroll
        for (int c8 = 0; c8 < 4; ++c8) raw[c8] = *(const u32x4*)(PJ + (row0 + j) * O_IN + 2048 + g * 128 + 32 * cq + 8 * c8);
#pragma unroll
        for (int c8 = 0; c8 < 4; ++c8) { const int cc = 32 * cq + 8 * c8;
            float f[8]; unpack8(raw[c8], f);
            const f32x4 g0 = *(const f32x4*)(p.in[I_DLG] + g * 128 + cc), g1 = *(const f32x4*)(p.in[I_DLG] + g * 128 + cc + 4);
            const f32x4 b0 = *(const f32x4*)(p.in[I_DLB] + g * 128 + cc), b1 = *(const f32x4*)(p.in[I_DLB] + g * 128 + cc + 4);
            const float gg[8] = {g0.x, g0.y, g0.z, g0.w, g1.x, g1.y, g1.z, g1.w}, bb[8] = {b0.x, b0.y, b0.z, b0.w, b1.x, b1.y, b1.z, b1.w};
#pragma unroll
            for (int e = 0; e < 8; ++e) vT[(cc + e) * MD_PITCH + j] = (bf16)f2bf((f[e] - mu) * rs * gg[e] + bb[e]); }
    }
    __syncthreads();
    f32x4 acc[8];
#pragma unroll
    for (int nc = 0; nc < 8; ++nc) acc[nc] = (f32x4){0.f, 0.f, 0.f, 0.f};
#pragma unroll
    for (int ks = 0; ks < 4; ++ks) {
        const bf16x8 a = *(const LAS bf16x8*)(Wl + (16 * wave + fr) * MD_PITCH + 32 * ks + 8 * fq);
#pragma unroll
        for (int nc = 0; nc < 8; ++nc) { const bf16x8 bb = *(const LAS bf16x8*)(vT + (16 * nc + fr) * MD_PITCH + 32 * ks + 8 * fq);
            acc[nc] = __builtin_amdgcn_mfma_f32_16x16x32_bf16(a, bb, acc[nc], 0, 0, 0); }
    }
#pragma unroll
    for (int rg = 0; rg < 4; ++rg) { const int ii = 16 * wave + 4 * fq + rg; const float bsv = p.in[I_DSB][g * 128 + ii];
        const bf16* up = PJ + (row0 + ii) * O_IN + 1536 + g * 128; bf16* op = MIX + (row0 + ii) * D + 512 + g * 128;
        float uu[8];
#pragma unroll
        for (int nc = 0; nc < 8; ++nc) uu[nc] = bf2f(up[16 * nc + fr]);
#pragma unroll
        for (int nc = 0; nc < 8; ++nc) op[16 * nc + fr] = (bf16)f2bf(uu[nc] * (acc[nc][rg] + bsv)); }
    __syncthreads();
}
__device__ __forceinline__ void mixd_sample(const Params& p, LAS unsigned char* lds, int n) {
    int tid = threadIdx.x; asm volatile("" : "+v"(tid));
    const int lane = tid & 63, wave = tid >> 6;
    const bf16* PJ = (const bf16*)(p.ws + WS_PROJ);
    bf16* MIX = (bf16*)(p.ws + WS_MIX);
    LAS float* red = (LAS float*)lds;
    float x[4], v[4];
#pragma unroll
    for (int s = 0; s < 4; ++s) x[s] = bf2f(PJ[(size_t)(TP + 4 * n + s) * O_IN + 2048 + tid]);
    __syncthreads();
#pragma unroll
    for (int s = 0; s < 4; ++s) { const float t = wave_sum(x[s]); if (lane == 0) red[s * 8 + wave] = t; }
    __syncthreads();
    float mu[4];
#pragma unroll
    for (int s = 0; s < 4; ++s) { float t = 0.f;
#pragma unroll
        for (int w = 0; w < 8; ++w) t += red[s * 8 + w];
        mu[s] = t * (1.0f / 512.0f); }
    __syncthreads();
#pragma unroll
    for (int s = 0; s < 4; ++s) { const float dlt = x[s] - mu[s]; const float t = wave_sum(dlt * dlt); if (lane == 0) red[s * 8 + wave] = t; }
    __syncthreads();
    const float lg = p.in[I_DLG][tid], lb = p.in[I_DLB][tid];
#pragma unroll
    for (int s = 0; s < 4; ++s) { float t = 0.f;
#pragma unroll
        for (int w = 0; w < 8; ++w) t += red[s * 8 + w];
        v[s] = (x[s] - mu[s]) * (1.0f / sqrtf(t * (1.0f / 512.0f) + EPS)) * lg + lb;
        p.out[O_DV + ((size_t)n * 4 + s) * 512 + tid] = v[s]; }
    const int g = tid >> 7;
    const float* wsg = p.in[I_DSW] + (size_t)g * 128 * 128;
#pragma unroll
    for (int i = 0; i < 4; ++i) { float m = p.in[I_DSB][g * 128 + i];
#pragma unroll
        for (int j = 0; j <= i; ++j) m += wsg[i * 128 + j] * v[j];
        const float u = bf2f(PJ[(size_t)(TP + 4 * n + i) * O_IN + 1536 + tid]);
        MIX[(size_t)(TP + 4 * n + i) * D + 512 + tid] = (bf16)f2bf(u * m); }
    __syncthreads();
}
__device__ __forceinline__ void phase11(const Params& p, LAS unsigned char* lds) {
    constexpr int N_D = BATCH * 16 * 4, N_DS = DEC_BATCH;
    for (int it = blockIdx.x; it < N_D + N_DS; it += gridDim.x) {
        if (it < N_D) mixd_item(p, lds, it / 64, (it >> 2) & 15, it & 3); else mixd_sample(p, lds, it - N_D);
    }
    mixc_rows(p);
}

template <int K>
__device__ __forceinline__ void sample_gemm_n1024(const bf16* A, const bf16* Wt, float* X, const float* gate, int unit) {
    int tid = threadIdx.x; asm volatile("" : "+v"(tid));
    const int lane = tid & 63, wave = tid >> 6, fr = lane & 15, fq = lane >> 4;
    const int cs = unit & 63, ksl = unit >> 6;
    constexpr int KS = K / 4, NSTEP = KS / 32;
    const bf16* ap = A + (size_t)(TP + 16 * wave + fr) * K + ksl * KS + 8 * fq;
    const bf16* bp = Wt + (size_t)(16 * cs + fr) * K + ksl * KS + 8 * fq;
    f32x4 acc = (f32x4){0.f, 0.f, 0.f, 0.f};
#pragma unroll
    for (int s0 = 0; s0 < NSTEP; s0 += 8) {
        bf16x8 a[8], b[8];
#pragma unroll
        for (int j = 0; j < 8; ++j) if (s0 + j < NSTEP) { a[j] = *(const bf16x8*)(ap + 32 * (s0 + j)); b[j] = *(const bf16x8*)(bp + 32 * (s0 + j)); }
#pragma unroll
        for (int j = 0; j < 8; ++j) if (s0 + j < NSTEP) acc = __builtin_amdgcn_mfma_f32_16x16x32_bf16(a[j], b[j], acc, 0, 0, 0);
    }
#pragma unroll
    for (int rg = 0; rg < 4; ++rg) { const int row = 16 * wave + 4 * fq + rg, col = 16 * cs + fr;
        atomicAdd(X + (size_t)(TP + row) * D + col, gate[(size_t)(BATCH + (row >> 2)) * MODW + col] * acc[rg]); }
}

#define XB_TMO      128
#define XB_XCNT(j)  (256  + 64 * (j))
#define XB_XSUB(j)  (1280 + 64 * (j))
#define XB_XGEN(j)  (2304 + 64 * (j))
#define XB_TOP      3328
#define XB_TOPGEN   3392
#define XCD_BAR_WORDS 3456
#define XB_SPIN_CAP (1u << 18)

__device__ __forceinline__ unsigned xb_ld(unsigned* p)              { return __hip_atomic_load(p, __ATOMIC_RELAXED, __HIP_MEMORY_SCOPE_AGENT); }
__device__ __forceinline__ unsigned xb_add(unsigned* p, unsigned v) { return __hip_atomic_fetch_add(p, v, __ATOMIC_RELAXED, __HIP_MEMORY_SCOPE_AGENT); }
__device__ __forceinline__ unsigned xb_xcc_id() { return (unsigned)__builtin_amdgcn_s_getreg((3 << 11) | 20) & 0xFu; }
#define XB_SPIN(cond, bar) do { unsigned _sp = 0; while (cond) { __builtin_amdgcn_s_sleep(1); \
    if ((++_sp & 255u) == 0u) { if (xb_ld(&(bar)[XB_TMO])) break; if (_sp > XB_SPIN_CAP) { atomicAdd(&(bar)[XB_TMO], 1u); break; } } } } while (0)

struct XcdBarrier {
    unsigned* bar; unsigned x;
    volatile LAS unsigned* st;
};

__device__ __forceinline__ XcdBarrier xcd_barrier_post(unsigned* bar, volatile LAS unsigned* st) {
    XcdBarrier b; b.bar = bar; b.x = xb_xcc_id(); b.st = st;
    if (threadIdx.x == 0) (void)xb_add(&bar[XB_XCNT(b.x)], 1u);
    return b;
}
__device__ __forceinline__ void xcd_barrier_complete(unsigned* bar, unsigned x, unsigned& nloc, unsigned& nx) {
    const unsigned G = gridDim.x * gridDim.y * gridDim.z;
    unsigned sum, cnt, mine, sp = 0u;
    for (;;) {
        sum = 0u; cnt = 0u; mine = 0u;
#pragma unroll
        for (unsigned j = 0; j < 16; ++j) { const unsigned c = xb_ld(&bar[XB_XCNT(j)]); sum += c; cnt += (c > 0u) ? 1u : 0u; mine = (j == x) ? c : mine; }
        if (sum == G) break;
        __builtin_amdgcn_s_sleep(1);
        if ((++sp & 255u) == 0u) { if (xb_ld(&bar[XB_TMO])) break; if (sp > XB_SPIN_CAP) { atomicAdd(&bar[XB_TMO], 1u); break; } }
    }
    nloc = mine > 0u ? mine : 1u; nx = cnt > 0u ? cnt : 1u;
}

__device__ __forceinline__ void xcd_barrier(const XcdBarrier& b) {
    asm volatile("s_waitcnt vmcnt(0)" ::: "memory");
    __syncthreads();
    if (threadIdx.x == 0) {
        unsigned* bar = b.bar;
        __builtin_amdgcn_s_waitcnt(0);
        unsigned nloc = b.st[0], nx = b.st[1];
        if (nloc == 0u) { xcd_barrier_complete(bar, b.x, nloc, nx); b.st[0] = nloc; b.st[1] = nx; }
        const unsigned old = xb_add(&bar[XB_XSUB(b.x)], 1u);
        const unsigned gen = old / nloc;
        if (old + 1u == (gen + 1u) * nloc) {
            __builtin_amdgcn_fence(__ATOMIC_RELEASE, "agent");
            asm volatile("s_waitcnt vmcnt(0)" ::: "memory");
            const unsigned og = xb_add(&bar[XB_TOP], 1u);
            const unsigned tg = og / nx;
            if (og + 1u == (tg + 1u) * nx) xb_add(&bar[XB_TOPGEN], 1u);
            else XB_SPIN(xb_ld(&bar[XB_TOPGEN]) == tg, bar);
            __builtin_amdgcn_fence(__ATOMIC_ACQUIRE, "agent");
            xb_add(&bar[XB_XGEN(b.x)], 1u);
            asm volatile("s_waitcnt vmcnt(0)" ::: "memory");
        } else {
            XB_SPIN(xb_ld(&bar[XB_XGEN(b.x)]) == gen, bar);
            __builtin_amdgcn_fence(__ATOMIC_ACQUIRE, "agent");
            asm volatile("s_waitcnt vmcnt(0)" ::: "memory");
        }
    }
    __syncthreads();
}

template <bool COOP>
__global__ void __launch_bounds__(NTHR, 2) fwd_kernel(Params p) {
    extern __shared__ __attribute__((aligned(16))) unsigned char lds_raw[];
    LAS unsigned char* lds = (LAS unsigned char*)lds_raw;
    unsigned char* ws = p.ws;
    float* mod = (float*)(ws + WS_MOD);
    float* X = (float*)(ws + WS_X);
    bf16* H = (bf16*)(ws + WS_H); bf16* PROJ = (bf16*)(ws + WS_PROJ); bf16* MIX = (bf16*)(ws + WS_MIX); bf16* ACT = (bf16*)(ws + WS_ACT);
    const int lo = p.ph_lo, hi = p.ph_hi;
    XcdBarrier bar; bar.bar = (unsigned*)(ws + WS_CTL) + CW_BAR; bar.x = 0; bar.st = nullptr;
    if (COOP) {
        for (int u = threadIdx.x; u < (LDS_BYTES - LDSCTL_OFF) / 4; u += NTHR) ((LAS unsigned*)(lds + LDSCTL_OFF))[u] = 0u;
        __syncthreads();
        bar = xcd_barrier_post((unsigned*)(ws + WS_CTL) + CW_BAR, (volatile LAS unsigned*)(lds + LDSCTL_OFF + 320) + 8);
    }
#define IN(k) (lo <= (k) && (k) < hi)
#define SEAM(k) do { if (COOP) { if ((k) + 1 < hi) xcd_barrier(bar); } } while (0)
#define GEMM_PHASE(EpiT, Aptr, Wptr, Mrows, Ncols, Kdim, ...) do { pg8::Gemm g_{(const pg8::bf16_t*)(Aptr), (const pg8::bf16_t*)(Wptr), Mrows, Ncols, Kdim}; \
        pg8::StaticOrder S_; S_.init(Mrows, Ncols, (int)gridDim.x, (int)blockIdx.x); pg8::EpiT E_{__VA_ARGS__}; \
        pg8::gemm_phase<pg8::EpiT, pg8::StaticOrder, true, true>(lds, g_, S_, E_); } while (0)

    if (IN(0)) for (int rep_ = 0; rep_ <= ((DBG_DUP >> 0) & 1); ++rep_) { phase0(p, lds); SEAM(0); }
    if (IN(1)) for (int rep_ = 0; rep_ <= ((DBG_DUP >> 1) & 1); ++rep_) { norm_phase<false>(p.in[I_XP], p.in[I_XS], p.in[I_NMG], mod + 0 * D, mod + 1 * D, H, nullptr, nullptr); SEAM(1); }
    if (IN(2)) for (int rep_ = 0; rep_ <= ((DBG_DUP >> 2) & 1); ++rep_) { GEMM_PHASE(EpiStoreBf16, H, ws + WS_WEIN, MP, E_IN, D, (pg8::bf16_t*)PROJ, E_IN, 1 << 30); SEAM(2); }
    if (IN(3)) for (int rep_ = 0; rep_ <= ((DBG_DUP >> 3) & 1); ++rep_) { phase3(p, lds); SEAM(3); }
    if (IN(4)) for (int rep_ = 0; rep_ <= ((DBG_DUP >> 4) & 1); ++rep_) { phase4(p); SEAM(4); }
    if (IN(5)) for (int rep_ = 0; rep_ <= ((DBG_DUP >> 5) & 1); ++rep_) { for (int u_ = blockIdx.x; u_ < 256; u_ += gridDim.x) sample_gemm_n1024<512>(MIX, (const bf16*)(ws + WS_WEOUT), X, mod + 2 * D, u_);
        GEMM_PHASE(EpiResid, MIX, ws + WS_WEOUT, TP, D, 512, p.in[I_XP], p.in[I_XS], X, mod + 2 * D); SEAM(5); }
    if (IN(6)) for (int rep_ = 0; rep_ <= ((DBG_DUP >> 6) & 1); ++rep_) { norm_phase<false>(X, X + (size_t)TP * D, p.in[I_NFG], mod + 3 * D, mod + 4 * D, H, nullptr, nullptr); SEAM(6); }
    if (IN(7)) for (int rep_ = 0; rep_ <= ((DBG_DUP >> 7) & 1); ++rep_) { GEMM_PHASE(EpiSwiGLU, H, ws + WS_WGU0, MP, 2 * FFN, D, (pg8::bf16_t*)ACT, FFN); SEAM(7); }
    if (IN(8)) for (int rep_ = 0; rep_ <= ((DBG_DUP >> 8) & 1); ++rep_) { for (int u_ = blockIdx.x; u_ < 256; u_ += gridDim.x) sample_gemm_n1024<FFN>(ACT, (const bf16*)(ws + WS_WDN0), X, mod + 5 * D, u_);
        GEMM_PHASE(EpiResid, ACT, ws + WS_WDN0, TP, D, FFN, X, X + (size_t)TP * D, X, mod + 5 * D); SEAM(8); }
    const float* mod1 = mod + (size_t)NB * MODW;
    if (IN(9)) for (int rep_ = 0; rep_ <= ((DBG_DUP >> 9) & 1); ++rep_) { norm_phase<false>(X, X + (size_t)TP * D, p.in[I_NMG] + D, mod1 + 0 * D, mod1 + 1 * D, H, nullptr, nullptr); SEAM(9); }
    if (IN(10)) for (int rep_ = 0; rep_ <= ((DBG_DUP >> 10) & 1); ++rep_) { GEMM_PHASE(EpiStoreBf16, H, ws + WS_WOIN, MP, O_IN, D, (pg8::bf16_t*)PROJ, O_IN, 6); SEAM(10); }
    if (IN(11)) for (int rep_ = 0; rep_ <= ((DBG_DUP >> 11) & 1); ++rep_) { phase11(p, lds); SEAM(11); }
    if (IN(12)) for (int rep_ = 0; rep_ <= ((DBG_DUP >> 12) & 1); ++rep_) { for (int u_ = blockIdx.x; u_ < 256; u_ += gridDim.x) sample_gemm_n1024<D>(MIX, (const bf16*)(ws + WS_WOOUT), X, mod1 + 2 * D, u_);
        GEMM_PHASE(EpiResid, MIX, ws + WS_WOOUT, TP, D, D, X, X + (size_t)TP * D, X, mod1 + 2 * D); SEAM(12); }
    if (IN(13)) for (int rep_ = 0; rep_ <= ((DBG_DUP >> 13) & 1); ++rep_) { norm_phase<false>(X, X + (size_t)TP * D, p.in[I_NFG] + D, mod1 + 3 * D, mod1 + 4 * D, H, nullptr, nullptr); SEAM(13); }
    if (IN(14)) for (int rep_ = 0; rep_ <= ((DBG_DUP >> 14) & 1); ++rep_) { GEMM_PHASE(EpiSwiGLU, H, ws + WS_WGU1, MP, 2 * FFN, D, (pg8::bf16_t*)ACT, FFN); SEAM(14); }
    if (IN(15)) for (int rep_ = 0; rep_ <= ((DBG_DUP >> 15) & 1); ++rep_) { for (int u_ = blockIdx.x; u_ < 256; u_ += gridDim.x) sample_gemm_n1024<FFN>(ACT, (const bf16*)(ws + WS_WDN1), X, mod1 + 5 * D, u_);
        GEMM_PHASE(EpiResid, ACT, ws + WS_WDN1, TP, D, FFN, X, X + (size_t)TP * D, X, mod1 + 5 * D); SEAM(15); }
    if (IN(16)) for (int rep_ = 0; rep_ <= ((DBG_DUP >> 16) & 1); ++rep_) { norm_phase<true>(X, X + (size_t)TP * D, p.in[I_FNG], nullptr, nullptr, nullptr, p.out + O_YP, p.out + O_YS); }
#undef IN
#undef SEAM
#undef GEMM_PHASE
}

#ifndef DBG_PH_HI
#define DBG_PH_HI NPHASE
#endif
#ifndef MK_MULTI
#define MK_MULTI 1
#endif
extern "C" void kernel_launch(void* const* d_in, const int* in_sizes, int n_in, void* d_out, int out_size, void* d_ws, size_t ws_size, hipStream_t stream) {
    static int grid = 0;
    if (grid == 0) {
        if (n_in != N_IN || out_size != (int)O_END || ws_size < WS_END) { fprintf(stderr, "kernel_launch: unexpected shapes: n_in %d out %d ws %zu (need %zu)\n", n_in, out_size, ws_size, (size_t)WS_END); grid = -1; return; }
        int dev = 0, cus = 0, per_cu = 0;
        if (hipGetDevice(&dev) != hipSuccess || hipDeviceGetAttribute(&cus, hipDeviceAttributeMultiprocessorCount, dev) != hipSuccess) { grid = -1; return; }
        hipFuncSetAttribute((const void*)fwd_kernel<true>, hipFuncAttributeMaxDynamicSharedMemorySize, LDS_BYTES);
        hipFuncSetAttribute((const void*)fwd_kernel<false>, hipFuncAttributeMaxDynamicSharedMemorySize, LDS_BYTES);
        if (hipOccupancyMaxActiveBlocksPerMultiprocessor(&per_cu, (const void*)fwd_kernel<true>, NTHR, LDS_BYTES) != hipSuccess || per_cu < 1) { fprintf(stderr, "kernel_launch: occupancy query says %d blocks per CU\n", per_cu); per_cu = 1; }
        (void)hipGetLastError();
        grid = cus;
    }
    if (grid < 0) return;
    Params prm{};
    for (int i = 0; i < N_IN; ++i) prm.in[i] = (const float*)d_in[i];
    prm.out = (float*)d_out; prm.ws = (unsigned char*)d_ws;
#if MK_MULTI
    for (int ph = 0; ph < DBG_PH_HI; ++ph) { prm.ph_lo = ph; prm.ph_hi = ph + 1;
        hipLaunchKernelGGL(fwd_kernel<false>, dim3(grid), dim3(NTHR), LDS_BYTES, stream, prm); }
#else
    prm.ph_lo = 0; prm.ph_hi = NPHASE;
    if (hipMemsetAsync((char*)d_ws + WS_CTL, 0, CTL_ZERO_BYTES, stream) != hipSuccess) { fprintf(stderr, "kernel_launch: memset of the control words failed\n"); return; }
    void* args[] = {&prm};
    hipError_t e = hipLaunchCooperativeKernel((const void*)fwd_kernel<true>, dim3(grid), dim3(NTHR), args, LDS_BYTES, stream);
    if (e != hipSuccess) fprintf(stderr, "cooperative launch failed: %s (grid %d)\n", hipGetErrorString(e), grid);
#endif
}
```
